# Optimizing an MI355X kernel written in HIP

```python
import math
import jax, jax.numpy as jnp
from jax import lax
import numpy as np

D_MODEL = 1024
BATCH = 16
SEQ = 2048
DEPTH = 4
DEC_BATCH = 4
DEC_SEQ = 8192
PAST_LEN = 128

N_MIXERS = 2
N_ATTN_LAYERS = (DEPTH + 1) // 2
N_RET_LAYERS = DEPTH // 2
PLE_DIM = 256
D_FF = 4 * D_MODEL
A_HEAD_DIM = 64
A_HEADS = D_MODEL // (2 * A_HEAD_DIM)
A_QK = A_HEADS * 2 * A_HEAD_DIM
A_V = A_HEADS * 2 * A_HEAD_DIM
ROPE_THETA = 10000.0
Q_BLOCK = 128
R_HEADS = 4
R_DK = D_MODEL // R_HEADS
R_DV = 2 * D_MODEL // R_HEADS
R_QK = R_HEADS * R_DK
R_V = R_HEADS * R_DV
CHUNK = 128
XPOS_BASE = 10000.0

kernel_name = "hybrid_diffattn_retnet_encoder"


def rms_norm(x, w, eps=1e-6):
    xf = x.astype(jnp.float32)
    y = xf * lax.rsqrt(jnp.mean(xf * xf, axis=-1, keepdims=True) + eps)
    if w is not None:
        y = y * w.astype(jnp.float32)
    return y.astype(x.dtype)


def rope_tables(S, dim, dtype):
    inv_freq = 1.0 / (ROPE_THETA ** (jnp.arange(0, dim, 2, dtype=jnp.float32) / dim))
    ang = jnp.arange(S, dtype=jnp.float32)[:, None] * inv_freq[None, :]
    ang = jnp.concatenate([ang, ang], axis=-1)
    return jnp.cos(ang).astype(dtype), jnp.sin(ang).astype(dtype)


def apply_rope_half(x, cos, sin):
    x1, x2 = jnp.split(x, 2, axis=-1)
    return x * cos + jnp.concatenate([-x2, x1], axis=-1) * sin


def xpos_tables(S, dim, dtype):
    angle = 1.0 / (XPOS_BASE ** jnp.linspace(0.0, 1.0, dim // 2, dtype=jnp.float32))
    angle = jnp.repeat(angle, 2)
    ang = jnp.arange(S, dtype=jnp.float32)[:, None] * angle[None, :]
    return jnp.cos(ang).astype(dtype), jnp.sin(ang).astype(dtype)


def theta_shift(x, cos, sin):
    x1 = x[..., 0::2]
    x2 = x[..., 1::2]
    rot = jnp.stack([-x2, x1], axis=-1).reshape(x.shape)
    return x * cos + rot * sin


def diff_attention(h, w_qkv, w_o, lq1, lk1, lq2, lk2, subln, layer_idx):
    B, S, _ = h.shape
    dt = h.dtype
    qkv = h @ w_qkv
    q, k, v = jnp.split(qkv, [A_QK, 2 * A_QK], axis=-1)
    q = q.reshape(B, S, A_HEADS, 2, A_HEAD_DIM)
    k = k.reshape(B, S, A_HEADS, 2, A_HEAD_DIM)
    v = v.reshape(B, S, A_HEADS, 2 * A_HEAD_DIM)
    cos, sin = rope_tables(S, A_HEAD_DIM, dt)
    cos = cos[:, None, None, :]
    sin = sin[:, None, None, :]
    q = apply_rope_half(q, cos, sin) * (A_HEAD_DIM ** -0.5)
    k = apply_rope_half(k, cos, sin)
    q = q.transpose(0, 2, 3, 1, 4)
    k = k.transpose(0, 2, 3, 1, 4)
    v = v.transpose(0, 2, 1, 3)
    lam_init = 0.8 - 0.6 * math.exp(-0.3 * layer_idx)
    lam = (jnp.exp(jnp.sum(lq1.astype(jnp.float32) * lk1.astype(jnp.float32)))
           - jnp.exp(jnp.sum(lq2.astype(jnp.float32) * lk2.astype(jnp.float32)))
           + lam_init)
    nb = S // Q_BLOCK
    qb = q.reshape(B, A_HEADS, 2, nb, Q_BLOCK, A_HEAD_DIM).transpose(3, 0, 1, 2, 4, 5)

    def block(qi):
        s = jnp.einsum('bhcqd,bhckd->bhcqk', qi, k).astype(jnp.float32)
        pr = jax.nn.softmax(s, axis=-1)
        a = (pr[:, :, 0] - lam * pr[:, :, 1]).astype(v.dtype)
        return jnp.einsum('bhqk,bhkv->bhqv', a, v)

    o = lax.map(block, qb)
    o = o.transpose(1, 0, 3, 2, 4).reshape(B, S, A_HEADS, 2 * A_HEAD_DIM)
    o = rms_norm(o, subln, 1e-5) * (1.0 - lam_init)
    return o.reshape(B, S, A_V) @ w_o


def retention_chunked(q, k, v, lg, inclusive):
    B, H, S, dk = q.shape
    dv = v.shape[-1]
    dt = q.dtype
    n = S // CHUNK
    pos = jnp.arange(CHUNK, dtype=jnp.float32)
    diff = pos[:, None] - pos[None, :]
    mask = (diff >= 0) if inclusive else (diff > 0)
    dmask = jnp.exp(jnp.where(mask[None], diff[None] * lg[:, None, None], -jnp.inf)).astype(dt)
    xi = jnp.exp((pos + 1.0)[None, :] * lg[:, None]).astype(dt)[..., None]
    zeta = jnp.exp((CHUNK - 1.0 - pos)[None, :] * lg[:, None]).astype(dt)[..., None]
    cdecay = jnp.exp(CHUNK * lg).astype(dt)[:, None, None]

    def to_chunks(t):
        return t.reshape(B, H, n, CHUNK, t.shape[-1]).transpose(2, 0, 1, 3, 4)

    def step(R, inp):
        qc, kc, vc = inp
        inner = jnp.einsum('bhqk,bhkv->bhqv', jnp.einsum('bhqd,bhkd->bhqk', qc, kc) * dmask, vc)
        cross = jnp.einsum('bhqd,bhdv->bhqv', qc, R) * xi
        R_new = R * cdecay + jnp.einsum('bhkd,bhkv->bhdv', kc * zeta, vc)
        return R_new, inner + cross

    R0 = jnp.zeros((B, H, dk, dv), dt)
    _, out = lax.scan(step, R0, (to_chunks(q), to_chunks(k), to_chunks(v)))
    return out.transpose(1, 2, 0, 3, 4).reshape(B, H, S, dv)


def retention(h, w_in, w_out, decay):
    B, S, _ = h.shape
    dt = h.dtype
    qkvg = h @ w_in
    q, k, v, g = jnp.split(qkvg, [R_QK, 2 * R_QK, 2 * R_QK + R_V], axis=-1)
    q = q.reshape(B, S, R_HEADS, R_DK)
    k = k.reshape(B, S, R_HEADS, R_DK)
    v = v.reshape(B, S, R_HEADS, R_DV)
    cos, sin = xpos_tables(S, R_DK, dt)
    cos = cos[:, None, :]
    sin = sin[:, None, :]
    q = theta_shift(q, cos, sin).transpose(0, 2, 1, 3)
    k = (theta_shift(k, cos, sin) * (R_DK ** -0.5)).transpose(0, 2, 1, 3)
    v = v.transpose(0, 2, 1, 3)
    lg = -jnp.exp(decay.astype(jnp.float32))
    fwd = retention_chunked(q, k, v, lg[0], True)
    bwd = jnp.flip(retention_chunked(jnp.flip(q, 2), jnp.flip(k, 2), jnp.flip(v, 2), lg[1], False), 2)
    o = (fwd + bwd).transpose(0, 2, 1, 3)
    o = rms_norm(o, None, 1e-6).reshape(B, S, R_V)
    return (jax.nn.silu(g) * o) @ w_out


def encoder_trunk(x, p, norm_pre_mix, norm_post_mix, norm_pre_mlp, norm_post_mlp,
                  attn_w_qkv, attn_w_o, attn_lambda_q1, attn_lambda_k1, attn_lambda_q2,
                  attn_lambda_k2, attn_subln, ret_w_in, ret_w_out, ret_decay,
                  mlp_w_in, mlp_w_out, ple_w_proj, ple_w_gate):
    for i in range(DEPTH):
        j = i // N_MIXERS
        h = rms_norm(x, norm_pre_mix[i])
        if i % N_MIXERS == 0:
            m = diff_attention(h, attn_w_qkv[j], attn_w_o[j], attn_lambda_q1[j], attn_lambda_k1[j],
                               attn_lambda_q2[j], attn_lambda_k2[j], attn_subln[j], i)
        else:
            m = retention(h, ret_w_in[j], ret_w_out[j], ret_decay[j])
        x = x + rms_norm(m, norm_post_mix[i])
        h = rms_norm(x, norm_pre_mlp[i])
        m = jnp.square(jax.nn.relu(h @ mlp_w_in[i])) @ mlp_w_out[i]
        x = x + rms_norm(m, norm_post_mlp[i])
        gate = jax.nn.sigmoid(rms_norm(x, None) @ ple_w_gate[i])
        x = x + (p[i] @ ple_w_proj[i]) * gate
    return x


def setup_inputs(seed: int = 0) -> dict:
    key = jax.random.key(seed)
    ks = jax.random.split(key, 24)
    f32 = jnp.float32

    def nrm(k, shape, scale):
        return jax.random.normal(k, shape, f32) * scale

    def gain(k, shape):
        return 1.0 + 0.01 * jax.random.normal(k, shape, f32)

    base = np.log(-np.log(1.0 - 2.0 ** (-5.0 - np.arange(R_HEADS)))).astype(np.float32)
    ret_decay = jnp.asarray(base)[None, None, :] + 0.05 * jax.random.normal(ks[15], (N_RET_LAYERS, 2, R_HEADS), f32)
    return {
        "x_prompt": nrm(ks[0], (BATCH, SEQ, D_MODEL), 1.0),
        "x_sample": nrm(ks[1], (DEC_BATCH, DEC_SEQ, D_MODEL), 1.0),
        "p_prompt": nrm(ks[2], (DEPTH, BATCH, SEQ, PLE_DIM), 1.0),
        "p_sample": nrm(ks[3], (DEPTH, DEC_BATCH, DEC_SEQ, PLE_DIM), 1.0),
        "norm_pre_mix": gain(ks[4], (DEPTH, D_MODEL)),
        "norm_post_mix": gain(ks[5], (DEPTH, D_MODEL)),
        "norm_pre_mlp": gain(ks[6], (DEPTH, D_MODEL)),
        "norm_post_mlp": gain(ks[7], (DEPTH, D_MODEL)),
        "attn_w_qkv": nrm(ks[8], (N_ATTN_LAYERS, D_MODEL, 2 * A_QK + A_V), D_MODEL ** -0.5),
        "attn_w_o": nrm(ks[9], (N_ATTN_LAYERS, A_V, D_MODEL), A_V ** -0.5),
        "attn_lambda_q1": nrm(ks[10], (N_ATTN_LAYERS, A_HEAD_DIM), 0.1),
        "attn_lambda_k1": nrm(ks[11], (N_ATTN_LAYERS, A_HEAD_DIM), 0.1),
        "attn_lambda_q2": nrm(ks[12], (N_ATTN_LAYERS, A_HEAD_DIM), 0.1),
        "attn_lambda_k2": nrm(ks[13], (N_ATTN_LAYERS, A_HEAD_DIM), 0.1),
        "attn_subln": gain(ks[14], (N_ATTN_LAYERS, 2 * A_HEAD_DIM)),
        "ret_w_in": nrm(ks[16], (N_RET_LAYERS, D_MODEL, 2 * R_QK + 2 * R_V), D_MODEL ** -0.5),
        "ret_w_out": nrm(ks[17], (N_RET_LAYERS, R_V, D_MODEL), R_V ** -0.5),
        "ret_decay": ret_decay,
        "mlp_w_in": nrm(ks[18], (DEPTH, D_MODEL, D_FF), D_MODEL ** -0.5),
        "mlp_w_out": nrm(ks[19], (DEPTH, D_FF, D_MODEL), D_FF ** -0.5),
        "ple_w_proj": nrm(ks[20], (DEPTH, PLE_DIM, D_MODEL), PLE_DIM ** -0.5),
        "ple_w_gate": nrm(ks[21], (DEPTH, D_MODEL, D_MODEL), D_MODEL ** -0.5),
    }


def reference(x_prompt, x_sample, p_prompt, p_sample, norm_pre_mix, norm_post_mix,
              norm_pre_mlp, norm_post_mlp, attn_w_qkv, attn_w_o, attn_lambda_q1,
              attn_lambda_k1, attn_lambda_q2, attn_lambda_k2, attn_subln, ret_w_in,
              ret_w_out, ret_decay, mlp_w_in, mlp_w_out, ple_w_proj, ple_w_gate):
    y_prompt = encoder_trunk(x_prompt, p_prompt, norm_pre_mix, norm_post_mix, norm_pre_mlp,
                             norm_post_mlp, attn_w_qkv, attn_w_o, attn_lambda_q1, attn_lambda_k1,
                             attn_lambda_q2, attn_lambda_k2, attn_subln, ret_w_in, ret_w_out,
                             ret_decay, mlp_w_in, mlp_w_out, ple_w_proj, ple_w_gate)
    y_sample = encoder_trunk(x_sample, p_sample, norm_pre_mix, norm_post_mix, norm_pre_mlp,
                             norm_post_mlp, attn_w_qkv, attn_w_o, attn_lambda_q1, attn_lambda_k1,
                             attn_lambda_q2, attn_lambda_k2, attn_subln, ret_w_in, ret_w_out,
                             ret_decay, mlp_w_in, mlp_w_out, ple_w_proj, ple_w_gate)
    return (y_prompt, y_sample)
```

```cpp
#include <hip/hip_runtime.h>
#include <hip/hip_cooperative_groups.h>
#include <cstdio>
#include <cstdint>
namespace pg8 {
#define PG8_LAS __attribute__((address_space(3)))
typedef unsigned short bf16_t;
typedef short bf16x8 __attribute__((ext_vector_type(8)));
typedef float f32x4 __attribute__((ext_vector_type(4)));
typedef unsigned u32x4 __attribute__((ext_vector_type(4)));
constexpr int BM = 256, BK = 64, HALF = 128, HTB = HALF * BK * 2  , STAGE_BYTES = 8 * HTB, NXCD = 8, WGM = 8;

__host__ __device__ __forceinline__ int lds_byte(int r, int c) { const int st = (r >> 4) * 2 + (c >> 5), rr = r & 15, cc = c & 31, ob = rr * 64 + cc * 2; return st * 1024 + (ob ^ (((ob >> 9) & 1) << 5)); }
__host__ __device__ __forceinline__ void stage_rc(int b, int& R, int& C) { const int st = b / 1024, sb = b % 1024, swz = sb ^ (((sb >> 9) & 1) << 5); R = (st >> 1) * 16 + swz / 64; C = (st & 1) * 32 + (swz % 64) / 2; }
__host__ __device__ __forceinline__ int perm32(int rho) { const int n = rho >> 4, i = rho & 15; return 8 * (i >> 2) + 4 * n + (i & 3); }

struct Unit { int pm, pn; };
struct Gemm { const bf16_t* A; const bf16_t* Bt; int M, N, K; };

struct StaticOrder {
    int nM, nN, nwg, G, c;
    __host__ __device__ void init(int M, int N, int G_, int c_) { nM = M / BM; nN = N / BM; nwg = nM * nN; G = G_; c = c_; }
    __host__ __device__ bool next(int i, Unit& u) const {
        const long L = (long)i * G + c; if (L >= nwg) return false;
        int wgid = (int)L; { const int q = nwg / NXCD, r = nwg % NXCD, xcd = wgid % NXCD, off = wgid / NXCD; wgid = (xcd < r ? xcd * (q + 1) : r * (q + 1) + (xcd - r) * q) + off; }
        const int nig = WGM * nN, gid = wgid / nig, fm = gid * WGM, gsz = (nM - fm) < WGM ? (nM - fm) : WGM;
        u.pm = fm + ((wgid % nig) % gsz); u.pn = (wgid % nig) / gsz; return true;
    }
    __device__ __forceinline__ void a_ready(const Unit&) const {}
    __device__ __forceinline__ void done(const Unit&) const {}
};

__device__ __forceinline__ unsigned cvt_pk_bf16(float lo, float hi) { unsigned r; asm volatile("v_cvt_pk_bf16_f32 %0, %1, %2" : "=v"(r) : "v"(lo), "v"(hi)); return r; }
typedef float f32x2 __attribute__((ext_vector_type(2)));
template <class Epi, class Sched, bool ALIGN_EPI = false, bool SP2 = false>
__device__ __forceinline__ void gemm_phase(PG8_LAS unsigned char* lds, const Gemm g, const Sched& S, const Epi& E, const int wave_id) {
    int tid_l = wave_id * 64 + (int)__builtin_amdgcn_mbcnt_hi(~0u, __builtin_amdgcn_mbcnt_lo(~0u, 0u)); asm volatile("" : "+v"(tid_l));
    const int tid = tid_l, wid = __builtin_amdgcn_readfirstlane(tid >> 6), lane = tid & 63, wr = wid >> 2, wc = wid & 3, fr = lane & 15, fq = lane >> 4;
    const int K = g.K, nt = K / BK;
    unsigned voffA[2], voffB[2];
#pragma unroll
    for (int i = 0; i < 2; ++i) { int R, C; stage_rc(tid * 16 + i * 8192, R, C); const int Rb = Epi::PERM ? ((R & ~31) + perm32(R & 31)) : R;
        voffA[i] = (unsigned)(R * K + C) * 2u; voffB[i] = (unsigned)(Rb * K + C) * 2u; }
    const size_t kstep = (size_t)(BK * 2);
    const size_t hstep = (size_t)HALF * K * 2;
    const size_t tstep = 2 * hstep;
    const unsigned ldsw = (unsigned)wid * 1024u;
    const int aoff = lds_byte(wr * 64 + fr, fq * 8), boff = lds_byte(wc * 32 + fr, fq * 8);
#define PG8_SA(b, h) (((b) * 2 + (h)) * HTB)
#define PG8_SB(b, h) ((4 + (b) * 2 + (h)) * HTB)
#define PG8_STAGE(bufoff, gbase, voff) do { _Pragma("unroll") for (int _i = 0; _i < 2; ++_i) \
        __builtin_amdgcn_global_load_lds((const unsigned*)((const char*)(gbase) + (voff)[_i]), (PG8_LAS unsigned*)(lds + (bufoff) + ldsw + _i * 8192), 16, 0, 0); } while (0)
#define PG8_LDA(dst, b, h) do { _Pragma("unroll") for (int m = 0; m < 4; ++m) _Pragma("unroll") for (int k = 0; k < 2; ++k) dst[m][k] = *(const PG8_LAS bf16x8*)(lds + PG8_SA(b, h) + aoff + m * 2048 + k * 1024); } while (0)
#define PG8_LDB(dst, b, h) do { _Pragma("unroll") for (int n = 0; n < 2; ++n) _Pragma("unroll") for (int k = 0; k < 2; ++k) dst[n][k] = *(const PG8_LAS bf16x8*)(lds + PG8_SB(b, h) + boff + n * 2048 + k * 1024); } while (0)
#define PG8_MMA(ai, bj, At, Bt) do { __builtin_amdgcn_s_setprio(1); _Pragma("unroll") for (int m = 0; m < 4; ++m) _Pragma("unroll") for (int n = 0; n < 2; ++n) _Pragma("unroll") for (int k = 0; k < 2; ++k) \
        acc[ai][bj][m][n] = __builtin_amdgcn_mfma_f32_16x16x32_bf16(Bt[n][k], At[m][k], acc[ai][bj][m][n], 0, 0, 0); __builtin_amdgcn_s_setprio(0); } while (0)
#define PG8_WAIT_V(n) asm volatile("s_waitcnt vmcnt(" #n ")" ::: "memory")
#define PG8_WAIT_L(n) asm volatile("s_waitcnt lgkmcnt(" #n ")" ::: "memory")
#define PG8_BAR __builtin_amdgcn_s_barrier()
#define PG8_SCHED __builtin_amdgcn_sched_barrier(0)
    Unit cur, nxt; int ui = 0;
    if (!S.next(0, cur)) return;
    f32x4 acc[2][2][4][2];
#pragma unroll
    for (int a = 0; a < 2; ++a)
#pragma unroll
        for (int b = 0; b < 2; ++b)
#pragma unroll
            for (int m = 0; m < 4; ++m)
#pragma unroll
                for (int n = 0; n < 2; ++n) acc[a][b][m][n] = (f32x4){0.f, 0.f, 0.f, 0.f};
    bf16x8 At[4][2], B0[2][2], B1[2][2];
    const char* cA = (const char*)g.A + (size_t)cur.pm * tstep; const char* cB = (const char*)g.Bt + (size_t)cur.pn * tstep;
    S.a_ready(cur);
    if constexpr (SP2) {
        PG8_STAGE(PG8_SB(0, 0), cB, voffB); PG8_STAGE(PG8_SB(0, 1), cB + hstep, voffB); PG8_STAGE(PG8_SA(0, 0), cA, voffA); PG8_STAGE(PG8_SA(0, 1), cA + hstep, voffA);
        if (wr == 1) PG8_BAR;
        PG8_WAIT_V(2); PG8_BAR;
        PG8_STAGE(PG8_SB(1, 0), cB + kstep, voffB); PG8_STAGE(PG8_SA(1, 0), cA + kstep, voffA); PG8_STAGE(PG8_SB(1, 1), cB + hstep + kstep, voffB);
        PG8_WAIT_V(6); PG8_BAR;
    } else {
        PG8_STAGE(PG8_SB(0, 0), cB, voffB); PG8_STAGE(PG8_SA(0, 0), cA, voffA); PG8_STAGE(PG8_SB(0, 1), cB + hstep, voffB); PG8_STAGE(PG8_SA(0, 1), cA + hstep, voffA);
        if (wr == 1) PG8_BAR;
        PG8_WAIT_V(4); PG8_BAR;
        PG8_STAGE(PG8_SB(1, 0), cB + kstep, voffB); PG8_STAGE(PG8_SA(1, 0), cA + kstep, voffA); PG8_STAGE(PG8_SB(1, 1), cB + hstep + kstep, voffB);
        PG8_WAIT_V(6); PG8_BAR;
    }
    for (;;) {
        const bool has_next = S.next(ui + 1, nxt);
        const char* nA = has_next ? (const char*)g.A + (size_t)nxt.pm * tstep : cA; const char* nB = has_next ? (const char*)g.Bt + (size_t)nxt.pn * tstep : cB;
        for (int t = 0; t < nt; t += 2) {
            const bool last = (t == nt - 2);
            const char* a1 = cA + (size_t)(t + 1) * kstep;
            const char* a2 = last ? nA : cA + (size_t)(t + 2) * kstep; const char* b2 = last ? nB : cB + (size_t)(t + 2) * kstep;
            const char* a3 = a2 + kstep; const char* b3 = b2 + kstep;
            if (last && has_next) S.a_ready(nxt);
            if constexpr (SP2) {
            PG8_LDB(B0, 0, 0); PG8_LDB(B1, 0, 1); PG8_SCHED; PG8_LDA(At, 0, 0); PG8_STAGE(PG8_SA(1, 1), a1 + hstep, voffA);
            PG8_WAIT_V(8); PG8_WAIT_L(0); PG8_BAR; PG8_MMA(0, 0, At, B0); PG8_MMA(0, 1, At, B1); PG8_BAR; PG8_SCHED;
            PG8_LDA(At, 0, 1); PG8_STAGE(PG8_SB(0, 0), b2, voffB); PG8_STAGE(PG8_SB(0, 1), b2 + hstep, voffB); PG8_STAGE(PG8_SA(0, 0), a2, voffA);
            PG8_WAIT_V(8); PG8_WAIT_L(0); PG8_BAR; PG8_MMA(1, 0, At, B0); PG8_MMA(1, 1, At, B1); PG8_BAR; PG8_SCHED;
            PG8_LDB(B0, 1, 0); PG8_LDB(B1, 1, 1); PG8_SCHED; PG8_LDA(At, 1, 0); PG8_STAGE(PG8_SA(0, 1), a2 + hstep, voffA);
            PG8_WAIT_V(8); PG8_WAIT_L(0); PG8_BAR; PG8_MMA(0, 0, At, B0); PG8_MMA(0, 1, At, B1); PG8_BAR; PG8_SCHED;
            PG8_LDA(At, 1, 1); PG8_STAGE(PG8_SB(1, 0), b3, voffB); PG8_STAGE(PG8_SB(1, 1), b3 + hstep, voffB); PG8_STAGE(PG8_SA(1, 0), a3, voffA);
            PG8_WAIT_V(8); PG8_WAIT_L(0); PG8_BAR; PG8_MMA(1, 0, At, B0); PG8_MMA(1, 1, At, B1); PG8_BAR; PG8_SCHED;
            } else {
            PG8_LDB(B0, 0, 0); PG8_SCHED; PG8_LDA(At, 0, 0); PG8_STAGE(PG8_SA(1, 1), a1 + hstep, voffA);
            PG8_WAIT_L(8); PG8_BAR; PG8_WAIT_L(0); PG8_MMA(0, 0, At, B0); PG8_BAR; PG8_SCHED;
            PG8_LDB(B1, 0, 1); PG8_STAGE(PG8_SB(0, 0), b2, voffB);
            PG8_BAR; PG8_WAIT_L(0); PG8_MMA(0, 1, At, B1); PG8_BAR;
            PG8_LDA(At, 0, 1); PG8_STAGE(PG8_SA(0, 0), a2, voffA);
            PG8_BAR; PG8_WAIT_L(0); PG8_MMA(1, 0, At, B0); PG8_BAR; PG8_SCHED;
            PG8_STAGE(PG8_SB(0, 1), b2 + hstep, voffB);
            PG8_WAIT_V(6); PG8_BAR; PG8_MMA(1, 1, At, B1); PG8_BAR;
            PG8_LDB(B0, 1, 0); PG8_SCHED; PG8_LDA(At, 1, 0); PG8_STAGE(PG8_SA(0, 1), a2 + hstep, voffA);
            PG8_WAIT_L(8); PG8_BAR; PG8_WAIT_L(0); PG8_MMA(0, 0, At, B0); PG8_BAR; PG8_SCHED;
            PG8_LDB(B1, 1, 1); PG8_STAGE(PG8_SB(1, 0), b3, voffB);
            PG8_BAR; PG8_WAIT_L(0); PG8_MMA(0, 1, At, B1); PG8_BAR;
            PG8_LDA(At, 1, 1); PG8_STAGE(PG8_SA(1, 0), a3, voffA);
            PG8_BAR; PG8_WAIT_L(0); PG8_MMA(1, 0, At, B0); PG8_BAR; PG8_SCHED;
            PG8_STAGE(PG8_SB(1, 1), b3 + hstep, voffB);
            PG8_WAIT_V(6); PG8_BAR; PG8_MMA(1, 1, At, B1); PG8_BAR;
            }
        }
        if constexpr (ALIGN_EPI) { if (wr == 0) PG8_BAR; }
        if constexpr (!Epi::AFTER_DRAIN) { E(acc, cur, wr, wc, fr, fq); S.done(cur); }
        if (!has_next) break;
#pragma unroll
        for (int a = 0; a < 2; ++a)
#pragma unroll
            for (int b = 0; b < 2; ++b)
#pragma unroll
                for (int m = 0; m < 4; ++m)
#pragma unroll
                    for (int n = 0; n < 2; ++n) acc[a][b][m][n] = (f32x4){0.f, 0.f, 0.f, 0.f};
        cur = nxt; cA = nA; cB = nB; ++ui;
        if constexpr (ALIGN_EPI) { if (wr == 1) PG8_BAR; }
    }
    PG8_WAIT_V(0);
    if constexpr (!ALIGN_EPI) { if (wr == 0) PG8_BAR; }
    PG8_BAR;
    if constexpr (Epi::AFTER_DRAIN) { E.fused(acc, cur, wr, wc, fr, fq, lds, wid, lane); S.done(cur); }
#undef PG8_SA
#undef PG8_SB
#undef PG8_STAGE
#undef PG8_LDA
#undef PG8_LDB
#undef PG8_MMA
#undef PG8_WAIT_V
#undef PG8_WAIT_L
#undef PG8_BAR
#undef PG8_SCHED
}
}

namespace cg = cooperative_groups;
#define LAS __attribute__((address_space(3)))
typedef unsigned short bf16;
typedef short bf16x8 __attribute__((ext_vector_type(8)));
typedef short s16x4 __attribute__((ext_vector_type(4)));
typedef float f32x2 __attribute__((ext_vector_type(2)));
typedef float f32x4 __attribute__((ext_vector_type(4)));
typedef float f32x16 __attribute__((ext_vector_type(16)));
typedef unsigned u32x2 __attribute__((ext_vector_type(2)));
typedef unsigned u32x4 __attribute__((ext_vector_type(4)));

constexpr int DM = 1024, TG = 32768, FFD = 4096;
constexpr size_t MiB = (size_t)1 << 20;
constexpr size_t WS_CTL = 0, WS_TAB = 1 * MiB, WS_W = 12 * MiB, WS_HB = 136 * MiB, WS_PB = 200 * MiB, WS_OB = 216 * MiB, WS_BIG = 344 * MiB, WS_END = 728 * MiB;
constexpr size_t TAB_RC = 0, TAB_RS = 1 * MiB, TAB_XC = 2 * MiB, TAB_XS = 6 * MiB;
constexpr size_t MEL = 1048576;
constexpr size_t W_QKV = 0, W_O = 6 * MEL, W_RIN = 8 * MEL, W_ROUT = 20 * MEL, W_MIN = 24 * MEL, W_MOUT = 40 * MEL, W_PROJ = 56 * MEL, W_GATE = 57 * MEL;
constexpr float LOG2E = 1.4426950408889634f;
constexpr int LDS_BYTES = 147456;

struct Params { const float* in[22]; float* out; unsigned char* ws; };

__device__ __forceinline__ unsigned cvtpk(float lo, float hi) { typedef __bf16 b2 __attribute__((ext_vector_type(2))); f32x2 v = {lo, hi}; b2 b = __builtin_convertvector(v, b2); return __builtin_bit_cast(unsigned, b); }
__device__ __forceinline__ float bf2f(unsigned short b) { return __uint_as_float(((unsigned)b) << 16); }
__device__ __forceinline__ unsigned short f2bf(float f) { return (unsigned short)(cvtpk(f, 0.f) & 0xffffu); }
__device__ __forceinline__ float shx(float v, int o, int lane) { return __int_as_float(__builtin_amdgcn_ds_bpermute((lane ^ o) << 2, __float_as_int(v))); }
__device__ __forceinline__ float wave_sum(float v, int lane) {
#pragma unroll
    for (int o = 1; o < 64; o <<= 1) v += shx(v, o, lane);
    return v;
}
__device__ __forceinline__ int crow(int r, int hh) { return (r & 3) + 8 * (r >> 2) + 4 * hh; }
__device__ __forceinline__ s16x4 trr(LAS unsigned char* p) { return __builtin_bit_cast(s16x4, __builtin_amdgcn_ds_read_tr16_b64_v4i16((LAS s16x4*)p)); }
__device__ __forceinline__ bf16x8 cat8(s16x4 lo, s16x4 hi) { return (bf16x8){lo[0], lo[1], lo[2], lo[3], hi[0], hi[1], hi[2], hi[3]}; }
__device__ __forceinline__ bf16x8 pack8(const f32x16& v, int b) { u32x4 w; w.x = cvtpk(v[b], v[b + 1]); w.y = cvtpk(v[b + 2], v[b + 3]); w.z = cvtpk(v[b + 4], v[b + 5]); w.w = cvtpk(v[b + 6], v[b + 7]); return __builtin_bit_cast(bf16x8, w); }
#define MFMA32(a, b, c) __builtin_amdgcn_mfma_f32_32x32x16_bf16((a), (b), (c), 0, 0, 0)
__device__ __forceinline__ int tid_of(int wave) { return wave * 64 + (int)__builtin_amdgcn_mbcnt_hi(~0u, __builtin_amdgcn_mbcnt_lo(~0u, 0u)); }
__device__ __forceinline__ float ex2(float x) { return __builtin_amdgcn_exp2f(x); }

__device__ __forceinline__ int qk_perm(int n) { const int d = n & 63; return (n & ~63) | (((d >> 4) & 1) << 5) | ((d >> 5) << 4) | (d & 15); }
__device__ __forceinline__ void conv_item(const float* W, int K, int N, bf16* WT, int permN, LAS float* scr, int item, int lane) {
    const int nblk = N / 32, kb = item / nblk, nb = item % nblk, k0 = 64 * kb, n0 = 32 * nb;
#pragma unroll 8
    for (int i = 0; i < 32; ++i) { const int kk = 2 * i + (lane >> 5); scr[kk * 33 + (lane & 31)] = W[(size_t)(k0 + kk) * N + n0 + (lane & 31)]; }
    asm volatile("s_waitcnt lgkmcnt(0)" ::: "memory");
    const int c = lane & 7;
#pragma unroll
    for (int j = 0; j < 4; ++j) { const int n = (lane >> 3) + 8 * j; const LAS float* s = scr + (8 * c) * 33 + n;
        u32x4 o; o.x = cvtpk(s[0 * 33], s[1 * 33]); o.y = cvtpk(s[2 * 33], s[3 * 33]); o.z = cvtpk(s[4 * 33], s[5 * 33]); o.w = cvtpk(s[6 * 33], s[7 * 33]);
        const int nn = n0 + n, dst = nn < permN ? qk_perm(nn) : nn;
        *(u32x4*)(WT + (size_t)dst * K + k0 + 8 * c) = o; }
    asm volatile("s_waitcnt lgkmcnt(0)" ::: "memory");
}
__device__ __forceinline__ void conv_matrix(const float* W, int K, int N, bf16* WT, int permN, LAS float* scr, int gw, int NGW, const int wave) {
    int lane = tid_of(wave) & 63; asm volatile("" : "+v"(lane));
    const int items = (K / 64) * (N / 32);
    for (int it = gw; it < items; it += NGW) conv_item(W, K, N, WT, permN, scr, it, lane);
}

template <bool HAS_M, bool STORE_X, bool HAS_WPRE, bool HAS_P>
__device__ __forceinline__ void rowpass(const float* xsrc, float* xdst, const float* m, const float* wpost, const float* wpre, bf16* hb, const float* psrc, bf16* pb, int gw, int NGW, const int wave) {
    int lane = tid_of(wave) & 63; asm volatile("" : "+v"(lane));
    for (int row = gw; row < TG; row += NGW) {
        const f32x4* xr = (const f32x4*)(xsrc + (size_t)row * DM) + lane;
        f32x4 v[4];
#pragma unroll
        for (int j = 0; j < 4; ++j) v[j] = xr[64 * j];
        if constexpr (HAS_M) {
            const f32x4* mr = (const f32x4*)(m + (size_t)row * DM) + lane; f32x4 mm[4]; float ss = 0.f;
#pragma unroll
            for (int j = 0; j < 4; ++j) { mm[j] = mr[64 * j]; ss += mm[j].x * mm[j].x + mm[j].y * mm[j].y + mm[j].z * mm[j].z + mm[j].w * mm[j].w; }
            const float r = rsqrtf(wave_sum(ss, lane) * (1.f / DM) + 1e-6f);
#pragma unroll
            for (int j = 0; j < 4; ++j) { const f32x4 wp = ((const f32x4*)wpost)[lane + 64 * j]; v[j] += mm[j] * r * wp; }
        }
        if constexpr (STORE_X) { f32x4* xo = (f32x4*)(xdst + (size_t)row * DM) + lane;
#pragma unroll
            for (int j = 0; j < 4; ++j) xo[64 * j] = v[j]; }
        {
            float ss = 0.f;
#pragma unroll
            for (int j = 0; j < 4; ++j) ss += v[j].x * v[j].x + v[j].y * v[j].y + v[j].z * v[j].z + v[j].w * v[j].w;
            const float r = rsqrtf(wave_sum(ss, lane) * (1.f / DM) + 1e-6f);
            u32x2* ho = (u32x2*)(hb + (size_t)row * DM) + lane;
#pragma unroll
            for (int j = 0; j < 4; ++j) { f32x4 o = v[j] * r; if constexpr (HAS_WPRE) o *= ((const f32x4*)wpre)[lane + 64 * j]; u32x2 w; w.x = cvtpk(o.x, o.y); w.y = cvtpk(o.z, o.w); ho[64 * j] = w; }
        }
        if constexpr (HAS_P) { const f32x4 pv = ((const f32x4*)(psrc + (size_t)row * 256))[lane]; u32x2 w; w.x = cvtpk(pv.x, pv.y); w.y = cvtpk(pv.z, pv.w); ((u32x2*)(pb + (size_t)row * 256))[lane] = w; }
    }
}

#define EPI_LOOP_AIM for (int ai = 0; ai < 2; ++ai) for (int m = 0; m < 4; ++m)
struct EpiF32 {
    static constexpr bool PERM = false, AFTER_DRAIN = false; float* O; int ldc;
    __device__ __forceinline__ void operator()(const pg8::f32x4 (&acc)[2][2][4][2], const pg8::Unit& u, int wr, int wc, int fr, int fq) const {
        const int row0 = u.pm * 256 + wr * 64 + fr, col0 = u.pn * 256 + wc * 32 + 4 * fq;
#pragma unroll
        for (int ai = 0; ai < 2; ++ai)
#pragma unroll
            for (int m = 0; m < 4; ++m) { float* rp = O + (size_t)(row0 + ai * 128 + m * 16) * ldc + col0;
#pragma unroll
                for (int bj = 0; bj < 2; ++bj)
#pragma unroll
                    for (int n = 0; n < 2; ++n) *(f32x4*)(rp + bj * 128 + n * 16) = acc[ai][bj][m][n]; }
    }
};
struct EpiRelu2 {
    static constexpr bool PERM = false, AFTER_DRAIN = false; bf16* O; int ldc;
    __device__ __forceinline__ void operator()(const pg8::f32x4 (&acc)[2][2][4][2], const pg8::Unit& u, int wr, int wc, int fr, int fq) const {
        const int row0 = u.pm * 256 + wr * 64 + fr, col0 = u.pn * 256 + wc * 32 + 4 * fq;
#pragma unroll
        for (int ai = 0; ai < 2; ++ai)
#pragma unroll
            for (int m = 0; m < 4; ++m) { bf16* rp = O + (size_t)(row0 + ai * 128 + m * 16) * ldc + col0;
#pragma unroll
                for (int bj = 0; bj < 2; ++bj)
#pragma unroll
                    for (int n = 0; n < 2; ++n) { f32x4 v = acc[ai][bj][m][n]; v.x = fmaxf(v.x, 0.f); v.y = fmaxf(v.y, 0.f); v.z = fmaxf(v.z, 0.f); v.w = fmaxf(v.w, 0.f); v = v * v;
                        u32x2 w; w.x = cvtpk(v.x, v.y); w.y = cvtpk(v.z, v.w); *(u32x2*)(rp + bj * 128 + n * 16) = w; } }
    }
};
struct EpiGate {
    static constexpr bool PERM = false, AFTER_DRAIN = false; float* X; const float* PR;
    __device__ __forceinline__ void operator()(const pg8::f32x4 (&acc)[2][2][4][2], const pg8::Unit& u, int wr, int wc, int fr, int fq) const {
        const int row0 = u.pm * 256 + wr * 64 + fr, col0 = u.pn * 256 + wc * 32 + 4 * fq;
#pragma unroll
        for (int ai = 0; ai < 2; ++ai)
#pragma unroll
            for (int m = 0; m < 4; ++m) { const size_t off = (size_t)(row0 + ai * 128 + m * 16) * DM + col0;
#pragma unroll
                for (int bj = 0; bj < 2; ++bj)
#pragma unroll
                    for (int n = 0; n < 2; ++n) { const f32x4 a = acc[ai][bj][m][n]; const f32x4 pr = *(const f32x4*)(PR + off + bj * 128 + n * 16); f32x4 xv = *(const f32x4*)(X + off + bj * 128 + n * 16);
                        xv.x += pr.x / (1.f + __expf(-a.x)); xv.y += pr.y / (1.f + __expf(-a.y)); xv.z += pr.z / (1.f + __expf(-a.z)); xv.w += pr.w / (1.f + __expf(-a.w));
                        *(f32x4*)(X + off + bj * 128 + n * 16) = xv; } }
    }
};
struct EpiSiluMul {
    static constexpr bool PERM = false, AFTER_DRAIN = false; bf16* O; int ldc;
    __device__ __forceinline__ void operator()(const pg8::f32x4 (&acc)[2][2][4][2], const pg8::Unit& u, int wr, int wc, int fr, int fq) const {
        const int row0 = u.pm * 256 + wr * 64 + fr, col0 = u.pn * 256 + wc * 32 + 4 * fq;
#pragma unroll
        for (int ai = 0; ai < 2; ++ai)
#pragma unroll
            for (int m = 0; m < 4; ++m) { bf16* rp = O + (size_t)(row0 + ai * 128 + m * 16) * ldc + col0;
#pragma unroll
                for (int bj = 0; bj < 2; ++bj)
#pragma unroll
                    for (int n = 0; n < 2; ++n) { const f32x4 a = acc[ai][bj][m][n]; u32x2 w = *(const u32x2*)(rp + bj * 128 + n * 16);
                        const float o0 = __uint_as_float(w.x << 16) * a.x / (1.f + __expf(-a.x)), o1 = __uint_as_float(w.x & 0xffff0000u) * a.y / (1.f + __expf(-a.y));
                        const float o2 = __uint_as_float(w.y << 16) * a.z / (1.f + __expf(-a.z)), o3 = __uint_as_float(w.y & 0xffff0000u) * a.w / (1.f + __expf(-a.w));
                        w.x = cvtpk(o0, o1); w.y = cvtpk(o2, o3); *(u32x2*)(rp + bj * 128 + n * 16) = w; } }
    }
};
struct EpiAttnQKV {
    static constexpr bool PERM = false, AFTER_DRAIN = false; bf16 *Q, *K, *V; const float *rc, *rs; int smask;
    __device__ __forceinline__ void operator()(const pg8::f32x4 (&acc)[2][2][4][2], const pg8::Unit& u, int wr, int wc, int fr, int fq) const {
        const int row0 = u.pm * 256 + wr * 64 + fr, region = u.pn >> 2, colt = (u.pn & 3) * 256;
        if (region == 2) {
            const int col0 = colt + wc * 32 + 4 * fq;
#pragma unroll
            for (int ai = 0; ai < 2; ++ai)
#pragma unroll
                for (int m = 0; m < 4; ++m) { bf16* rp = V + (size_t)(row0 + ai * 128 + m * 16) * DM + col0;
#pragma unroll
                    for (int bj = 0; bj < 2; ++bj)
#pragma unroll
                        for (int n = 0; n < 2; ++n) { const f32x4 v = acc[ai][bj][m][n]; u32x2 w; w.x = cvtpk(v.x, v.y); w.y = cvtpk(v.z, v.w); *(u32x2*)(rp + bj * 128 + n * 16) = w; } }
        } else {
            bf16* dst = region == 0 ? Q : K; const float sc = region == 0 ? 0.125f * LOG2E : 1.f; const int g = wc & 1, d1 = 16 * g + 4 * fq;
#pragma unroll
            for (int ai = 0; ai < 2; ++ai)
#pragma unroll
                for (int m = 0; m < 4; ++m) { const int row = row0 + ai * 128 + m * 16, s = row & smask;
                    const f32x4 c4 = *(const f32x4*)(rc + s * 32 + d1) * sc, s4 = *(const f32x4*)(rs + s * 32 + d1) * sc;
#pragma unroll
                    for (int bj = 0; bj < 2; ++bj) { const int cb = colt + bj * 128 + (wc >> 1) * 64;
                        const f32x4 x1 = acc[ai][bj][m][0], x2 = acc[ai][bj][m][1]; const f32x4 o1 = x1 * c4 - x2 * s4, o2 = x2 * c4 + x1 * s4;
                        u32x2 w; w.x = cvtpk(o1.x, o1.y); w.y = cvtpk(o1.z, o1.w); *(u32x2*)(dst + (size_t)row * DM + cb + d1) = w;
                        w.x = cvtpk(o2.x, o2.y); w.y = cvtpk(o2.z, o2.w); *(u32x2*)(dst + (size_t)row * DM + cb + d1 + 32) = w; } }
        }
    }
};
struct EpiRetQKV {
    static constexpr bool PERM = false, AFTER_DRAIN = false; bf16 *Q, *K, *V; const float *xc, *xs; int smask;
    __device__ __forceinline__ void operator()(const pg8::f32x4 (&acc)[2][2][4][2], const pg8::Unit& u, int wr, int wc, int fr, int fq) const {
        const int row0 = u.pm * 256 + wr * 64 + fr;
        if (u.pn >= 8) {
            const int col0 = (u.pn - 8) * 256 + wc * 32 + 4 * fq;
#pragma unroll
            for (int ai = 0; ai < 2; ++ai)
#pragma unroll
                for (int m = 0; m < 4; ++m) { bf16* rp = V + (size_t)(row0 + ai * 128 + m * 16) * 2048 + col0;
#pragma unroll
                    for (int bj = 0; bj < 2; ++bj)
#pragma unroll
                        for (int n = 0; n < 2; ++n) { const f32x4 v = acc[ai][bj][m][n]; u32x2 w; w.x = cvtpk(v.x, v.y); w.y = cvtpk(v.z, v.w); *(u32x2*)(rp + bj * 128 + n * 16) = w; } }
        } else {
            bf16* dst = u.pn < 4 ? Q : K; const float sc = u.pn < 4 ? 1.f : 0.0625f; const int col0 = (u.pn & 3) * 256 + wc * 32 + 4 * fq;
#pragma unroll
            for (int ai = 0; ai < 2; ++ai)
#pragma unroll
                for (int m = 0; m < 4; ++m) { const int row = row0 + ai * 128 + m * 16, s = row & smask;
#pragma unroll
                    for (int bj = 0; bj < 2; ++bj)
#pragma unroll
                        for (int n = 0; n < 2; ++n) { const int col = col0 + bj * 128 + n * 16, pi = (col & 255) >> 1;
                            const f32x2 c2 = *(const f32x2*)(xc + s * 128 + pi) * sc, s2 = *(const f32x2*)(xs + s * 128 + pi) * sc; const f32x4 x = acc[ai][bj][m][n];
                            u32x2 w; w.x = cvtpk(x.x * c2.x - x.y * s2.x, x.y * c2.x + x.x * s2.x); w.y = cvtpk(x.z * c2.y - x.w * s2.y, x.w * c2.y + x.z * s2.y);
                            *(u32x2*)(dst + (size_t)row * DM + col) = w; } }
        }
    }
};

__device__ __forceinline__ void attn_phase(LAS unsigned char* lds, const bf16* Q, const bf16* K, const bf16* V, bf16* OB, int S, int nbatch, int vcu, int G, float lam, float oscale, const float* subln, float* o1s, const int wave) {
    const int nqb = S / 256, nunits = nbatch * 8 * nqb, per = (nunits + G - 1) / G;
    constexpr int KSTR = 144, VSTR = 320, KBYTES = 64 * KSTR, BUF = KBYTES + 64 * VSTR;

    for (int it = 0; it < per; ++it) {
    int tid_l = tid_of(wave); asm volatile("" : "+v"(tid_l));
    const int tid = tid_l, lane = tid & 63, w = __builtin_amdgcn_readfirstlane(tid >> 6), l31 = lane & 31, hh = lane >> 5;
    const int krow = tid >> 3, kch = tid & 7, vrow0 = tid >> 4, vch = tid & 15;
    const int i15 = lane & 15, qq = i15 >> 2, pp = i15 & 3;
    const int vtr_off = (4 * hh + qq) * VSTR + (16 * ((lane >> 4) & 1) + 4 * pp) * 2;
    const int kfr_off = l31 * KSTR + hh * 16;
    const int kst_off = krow * KSTR + kch * 16, vst_off0 = vrow0 * VSTR + vch * 16, vst_off1 = (vrow0 + 32) * VSTR + vch * 16;
        const int u = vcu * per + it; if (u >= nunits) break;
        const int qb = u % nqb, bh = u / nqb, h = bh & 7, b = bh >> 3;
        const size_t rowbase = (size_t)b * S; const int q0 = qb * 256 + w * 32;
#pragma unroll 1
        for (int c = 0; c < 2; ++c) {
            const bf16* Kg = K + rowbase * DM + h * 128 + c * 64; const bf16* Vg = V + rowbase * DM + h * 128;
            bf16x8 qf[4];
#pragma unroll
            for (int ds = 0; ds < 4; ++ds) qf[ds] = *(const bf16x8*)(Q + (rowbase + q0 + l31) * DM + h * 128 + c * 64 + ds * 16 + hh * 8);
            u32x4 kr = *(const u32x4*)(Kg + (size_t)krow * DM + kch * 8);
            u32x4 vr0 = *(const u32x4*)(Vg + (size_t)vrow0 * DM + vch * 8), vr1 = *(const u32x4*)(Vg + (size_t)(vrow0 + 32) * DM + vch * 8);
            __syncthreads();
            *(LAS u32x4*)(lds + kst_off) = kr; *(LAS u32x4*)(lds + KBYTES + vst_off0) = vr0; *(LAS u32x4*)(lds + KBYTES + vst_off1) = vr1;
            __syncthreads();
            f32x16 o[4];
#pragma unroll
            for (int d0 = 0; d0 < 4; ++d0)
#pragma unroll
                for (int r = 0; r < 16; ++r) o[d0][r] = 0.f;
            float mrun = -1e30f, lrun = 0.f;
            const int NT = S / 64;
            for (int t = 0; t < NT; ++t) {
                LAS unsigned char* kb_ = lds + (t & 1) * BUF; LAS unsigned char* vb_ = kb_ + KBYTES;
                if (t + 1 < NT) { const size_t ro = (size_t)(t + 1) * 64;
                    kr = *(const u32x4*)(Kg + (ro + krow) * DM + kch * 8); vr0 = *(const u32x4*)(Vg + (ro + vrow0) * DM + vch * 8); vr1 = *(const u32x4*)(Vg + (ro + vrow0 + 32) * DM + vch * 8); }
                f32x16 s0, s1;
#pragma unroll
                for (int r = 0; r < 16; ++r) { s0[r] = 0.f; s1[r] = 0.f; }
#pragma unroll
                for (int ds = 0; ds < 4; ++ds) { const bf16x8 a0 = *(LAS bf16x8*)(kb_ + kfr_off + ds * 32), a1 = *(LAS bf16x8*)(kb_ + kfr_off + 32 * KSTR + ds * 32);
                    s0 = MFMA32(a0, qf[ds], s0); s1 = MFMA32(a1, qf[ds], s1); }
                float mx = fmaxf(s0[0], s1[0]);
#pragma unroll
                for (int r = 1; r < 16; ++r) mx = fmaxf(mx, fmaxf(s0[r], s1[r]));
                mx = fmaxf(mx, shx(mx, 32, lane));
                const float mnew = fmaxf(mrun, mx), alpha = ex2(mrun - mnew); mrun = mnew;
                float ps = 0.f;
#pragma unroll
                for (int r = 0; r < 16; ++r) { s0[r] = ex2(s0[r] - mnew); s1[r] = ex2(s1[r] - mnew); ps += s0[r] + s1[r]; }
                lrun = lrun * alpha + ps;
                if (__any(alpha != 1.f)) {
#pragma unroll
                    for (int d0 = 0; d0 < 4; ++d0)
#pragma unroll
                        for (int r = 0; r < 16; ++r) o[d0][r] *= alpha; }
                bf16x8 pf[4]; pf[0] = pack8(s0, 0); pf[1] = pack8(s0, 8); pf[2] = pack8(s1, 0); pf[3] = pack8(s1, 8);
#pragma unroll
                for (int ks = 0; ks < 4; ++ks)
#pragma unroll
                    for (int d0 = 0; d0 < 4; ++d0) { LAS unsigned char* vp = vb_ + vtr_off + (16 * ks) * VSTR + d0 * 64;
                        const bf16x8 vf = cat8(trr(vp), trr(vp + 8 * VSTR)); o[d0] = MFMA32(vf, pf[ks], o[d0]); }
                if (t + 1 < NT) { LAS unsigned char* nb_ = lds + ((t + 1) & 1) * BUF;
                    *(LAS u32x4*)(nb_ + kst_off) = kr; *(LAS u32x4*)(nb_ + KBYTES + vst_off0) = vr0; *(LAS u32x4*)(nb_ + KBYTES + vst_off1) = vr1; }
                __syncthreads();
            }
            lrun += shx(lrun, 32, lane);
            const float inv = 1.f / lrun;
            float* o1p = o1s + tid; asm volatile("" : "+v"(o1p));
            if (c == 0) {
#pragma unroll
                for (int d0 = 0; d0 < 4; ++d0)
#pragma unroll
                    for (int r = 0; r < 16; ++r) o1p[(d0 * 16 + r) * 512] = o[d0][r] * inv;
            } else {
                float ss = 0.f;
#pragma unroll
                for (int d0 = 0; d0 < 4; ++d0)
#pragma unroll
                    for (int r = 0; r < 16; ++r) { const float v = o1p[(d0 * 16 + r) * 512] - lam * (o[d0][r] * inv); o[d0][r] = v; ss += v * v; }
                ss += shx(ss, 32, lane);
                const float rstd = rsqrtf(ss * (1.f / 128.f) + 1e-5f) * oscale;
                bf16* orow = OB + (rowbase + q0 + l31) * DM + h * 128; asm volatile("" : "+v"(orow));
#pragma unroll
                for (int d0 = 0; d0 < 4; ++d0)
#pragma unroll
                    for (int rg = 0; rg < 4; ++rg) { const int d = 32 * d0 + 8 * rg + 4 * hh; const f32x4 w4 = *(const f32x4*)(subln + d);
                        u32x2 wv; wv.x = cvtpk(o[d0][4 * rg] * rstd * w4.x, o[d0][4 * rg + 1] * rstd * w4.y); wv.y = cvtpk(o[d0][4 * rg + 2] * rstd * w4.z, o[d0][4 * rg + 3] * rstd * w4.w);
                        *(u32x2*)(orow + d) = wv; }
            }
        }
    }
}

__device__ __forceinline__ void scan_phase(LAS unsigned char* lds, const bf16* Q, const bf16* K, const bf16* V, bf16* OF, bf16* OBK, int S, int nbatch, int vcu, int G, const float* decay, const int wave) {
    const int n = S / 128, nunits = nbatch * 64, per = (nunits + G - 1) / G;
    constexpr int KSTR = 576, VSTR = 192, RSTR = 528, KT = 0, VT = 128 * KSTR, RT = VT + 128 * VSTR;
    for (int it = 0; it < per; ++it) {
    int tid_l = tid_of(wave); asm volatile("" : "+v"(tid_l));
    const int tid = tid_l, lane = tid & 63, w = __builtin_amdgcn_readfirstlane(tid >> 6), l31 = lane & 31, hh = lane >> 5;
    const int i15 = lane & 15, qq = i15 >> 2, pp = i15 & 3, cg16 = 16 * ((lane >> 4) & 1) + 4 * pp;
    const int tb = w >> 1, nbk = w & 1;
        const int u = vcu * per + it; if (u >= nunits) break;
        const int dir = u & 1, j = (u >> 1) & 7, h = (u >> 4) & 3, b = u >> 6;
        const float lg2 = -__expf(decay[dir * 4 + h]) * LOG2E;
        const float cd = ex2(lg2 * 128.f);
        bf16* OD = dir ? OBK : OF;
        f32x16 racc[2];
#pragma unroll
        for (int r = 0; r < 16; ++r) { racc[0][r] = 0.f; racc[1][r] = 0.f; }
        u32x4 kreg[8], vreg[2];
        { const int c = dir ? n - 1 : 0; const size_t rowb = (size_t)b * S + (size_t)c * 128;
#pragma unroll
          for (int ii = 0; ii < 8; ++ii) { const int idx = tid + 512 * ii, row = idx >> 5, ch = idx & 31; kreg[ii] = *(const u32x4*)(K + (rowb + row) * DM + h * 256 + ch * 8); }
#pragma unroll
          for (int ii = 0; ii < 2; ++ii) { const int idx = tid + 512 * ii, row = idx >> 3, ch = idx & 7; vreg[ii] = *(const u32x4*)(V + (rowb + row) * 2048 + h * 512 + j * 64 + ch * 8); } }
        __syncthreads();
        for (int step = 0; step < n; ++step) {
            const int c = dir ? n - 1 - step : step; const size_t rowb = (size_t)b * S + (size_t)c * 128;
#pragma unroll
            for (int ii = 0; ii < 8; ++ii) { const int idx = tid + 512 * ii, row = idx >> 5, ch = idx & 31; *(LAS u32x4*)(lds + KT + row * KSTR + ch * 16) = kreg[ii]; }
#pragma unroll
            for (int ii = 0; ii < 2; ++ii) { const int idx = tid + 512 * ii, row = idx >> 3, ch = idx & 7;
                const float z = ex2(lg2 * (float)(dir ? row : 127 - row)); const u32x4 v = vreg[ii]; u32x4 o;
                o.x = cvtpk(__uint_as_float(v.x << 16) * z, __uint_as_float(v.x & 0xffff0000u) * z); o.y = cvtpk(__uint_as_float(v.y << 16) * z, __uint_as_float(v.y & 0xffff0000u) * z);
                o.z = cvtpk(__uint_as_float(v.z << 16) * z, __uint_as_float(v.z & 0xffff0000u) * z); o.w = cvtpk(__uint_as_float(v.w << 16) * z, __uint_as_float(v.w & 0xffff0000u) * z);
                *(LAS u32x4*)(lds + VT + row * VSTR + ch * 16) = o; }
#pragma unroll
            for (int nb2 = 0; nb2 < 2; ++nb2)
#pragma unroll
                for (int rg = 0; rg < 4; ++rg) { u32x2 wv; wv.x = cvtpk(racc[nb2][4 * rg], racc[nb2][4 * rg + 1]); wv.y = cvtpk(racc[nb2][4 * rg + 2], racc[nb2][4 * rg + 3]);
                    *(LAS u32x2*)(lds + RT + (32 * nb2 + l31) * RSTR + (32 * w + 8 * rg + 4 * hh) * 2) = wv; }
            __syncthreads();
            if (step + 1 < n) { const int c2 = dir ? c - 1 : c + 1; const size_t rb2 = (size_t)b * S + (size_t)c2 * 128;
#pragma unroll
                for (int ii = 0; ii < 8; ++ii) { const int idx = tid + 512 * ii, row = idx >> 5, ch = idx & 31; kreg[ii] = *(const u32x4*)(K + (rb2 + row) * DM + h * 256 + ch * 8); }
#pragma unroll
                for (int ii = 0; ii < 2; ++ii) { const int idx = tid + 512 * ii, row = idx >> 3, ch = idx & 7; vreg[ii] = *(const u32x4*)(V + (rb2 + row) * 2048 + h * 512 + j * 64 + ch * 8); } }
            { f32x16 acc;
#pragma unroll
              for (int r = 0; r < 16; ++r) acc[r] = 0.f;
              const bf16* qp = Q + (rowb + 32 * tb + l31) * DM + h * 256 + 8 * hh; LAS unsigned char* rp = lds + RT + (32 * nbk + l31) * RSTR + 16 * hh;
#pragma unroll
              for (int ks = 0; ks < 16; ++ks) { const bf16x8 a = *(const bf16x8*)(qp + 16 * ks); const bf16x8 bfr = *(LAS bf16x8*)(rp + 32 * ks); acc = MFMA32(a, bfr, acc); }
              bf16* op = OD + (rowb + 32 * tb) * 2048 + h * 512 + j * 64 + 32 * nbk + l31;
#pragma unroll
              for (int r = 0; r < 16; ++r) { const int tok = 32 * tb + crow(r, hh); const float xi = ex2(lg2 * (float)(dir ? 128 - tok : tok + 1)); op[(size_t)crow(r, hh) * 2048] = f2bf(acc[r] * xi); } }
#pragma unroll
            for (int r = 0; r < 16; ++r) { racc[0][r] *= cd; racc[1][r] *= cd; }
#pragma unroll
            for (int ks = 0; ks < 8; ++ks) { const int row = 16 * ks + 8 * hh + qq;
                LAS unsigned char* kp = lds + KT + row * KSTR + (32 * w + cg16) * 2; const bf16x8 af = cat8(trr(kp), trr(kp + 4 * KSTR));
                LAS unsigned char* vp = lds + VT + row * VSTR + cg16 * 2; const bf16x8 b0 = cat8(trr(vp), trr(vp + 4 * VSTR)), b1 = cat8(trr(vp + 64), trr(vp + 64 + 4 * VSTR));
                racc[0] = MFMA32(af, b0, racc[0]); racc[1] = MFMA32(af, b1, racc[1]); }
            __syncthreads();
        }
    }
}

__device__ __forceinline__ void intra_phase(LAS unsigned char* lds, const bf16* Q, const bf16* K, const bf16* V, bf16* OF, const bf16* OBK, int S, int nbatch, int vcu, int G, const float* decay, const int wave) {
    const int n = S / 128, nunits = nbatch * 4 * n, per = (nunits + G - 1) / G;
    constexpr int KSTR = 528, VSTR = 320, KT = 0, VT = 128 * KSTR, SSB = VT + 128 * VSTR;
    for (int it = 0; it < per; ++it) {
    int tid_l = tid_of(wave); asm volatile("" : "+v"(tid_l));
    const int tid = tid_l, lane = tid & 63, w = __builtin_amdgcn_readfirstlane(tid >> 6), l31 = lane & 31, hh = lane >> 5;
    const int i15 = lane & 15, qq = i15 >> 2, pp = i15 & 3, cg16 = 16 * ((lane >> 4) & 1) + 4 * pp;
    const int qb = w >> 1, par = w & 1;
        const int u = vcu * per + it; if (u >= nunits) break;
        const int c = u % n, bh = u / n, h = bh & 3, b = bh >> 2;
        const float lgf2 = -__expf(decay[h]) * LOG2E, lgb2 = -__expf(decay[4 + h]) * LOG2E;
        const size_t rowb = (size_t)b * S + (size_t)c * 128;
        __syncthreads();
#pragma unroll
        for (int ii = 0; ii < 8; ++ii) { const int idx = tid + 512 * ii, row = idx >> 5, ch = idx & 31; *(LAS u32x4*)(lds + KT + row * KSTR + ch * 16) = *(const u32x4*)(K + (rowb + row) * DM + h * 256 + ch * 8); }
        u32x4 vreg[4];
#pragma unroll
        for (int ii = 0; ii < 4; ++ii) { const int idx = tid + 512 * ii, row = idx >> 4, ch = idx & 15; vreg[ii] = *(const u32x4*)(V + (rowb + row) * 2048 + h * 512 + ch * 8); }
        __syncthreads();
        bf16x8 pf[8];
        { f32x16 X[4];
#pragma unroll
          for (int k4 = 0; k4 < 4; ++k4)
#pragma unroll
              for (int r = 0; r < 16; ++r) X[k4][r] = 0.f;
          const bf16* qp = Q + (rowb + 32 * qb + l31) * DM + h * 256 + 8 * hh; LAS unsigned char* kp = lds + KT + l31 * KSTR + 16 * hh;
#pragma unroll
          for (int ks = 0; ks < 16; ++ks) { const bf16x8 bq = *(const bf16x8*)(qp + 16 * ks);
#pragma unroll
              for (int k4 = 0; k4 < 4; ++k4) { const bf16x8 a = *(LAS bf16x8*)(kp + 32 * k4 * KSTR + 32 * ks); X[k4] = MFMA32(a, bq, X[k4]); } }
          const int iq = 32 * qb + l31;
#pragma unroll
          for (int k4 = 0; k4 < 4; ++k4) {
#pragma unroll
              for (int r = 0; r < 16; ++r) { const int d = iq - (32 * k4 + crow(r, hh)); X[k4][r] *= ex2(d >= 0 ? lgf2 * (float)d : -lgb2 * (float)d); }
              pf[2 * k4] = pack8(X[k4], 0); pf[2 * k4 + 1] = pack8(X[k4], 8); } }
        f32x16 z[8];
#pragma unroll
        for (int t = 0; t < 8; ++t)
#pragma unroll
            for (int r = 0; r < 16; ++r) z[t][r] = 0.f;
#pragma unroll
        for (int p = 0; p < 4; ++p) {
#pragma unroll
            for (int ii = 0; ii < 4; ++ii) { const int idx = tid + 512 * ii, row = idx >> 4, ch = idx & 15; *(LAS u32x4*)(lds + VT + row * VSTR + ch * 16) = vreg[ii]; }
            __syncthreads();
            if (p < 3) {
#pragma unroll
                for (int ii = 0; ii < 4; ++ii) { const int idx = tid + 512 * ii, row = idx >> 4, ch = idx & 15; vreg[ii] = *(const u32x4*)(V + (rowb + row) * 2048 + h * 512 + (p + 1) * 128 + ch * 8); } }
#pragma unroll
            for (int bi = 0; bi < 2; ++bi) { const int blk = 2 * bi + par;
#pragma unroll
                for (int ks = 0; ks < 8; ++ks) { LAS unsigned char* vp = lds + VT + (16 * ks + 4 * hh + qq) * VSTR + (32 * blk + cg16) * 2;
                    const bf16x8 vf = cat8(trr(vp), trr(vp + 8 * VSTR)); z[2 * p + bi] = MFMA32(pf[ks], vf, z[2 * p + bi]); } }
            __syncthreads();
        }
        float ss[16];
        size_t ebase = (rowb + 32 * qb + 4 * hh) * 2048 + h * 512 + 32 * par + l31; asm volatile("" : "+v"(ebase));
#pragma unroll
        for (int r = 0; r < 16; ++r) { const bf16* pf_ = OF + ebase + (size_t)((r & 3) + 8 * (r >> 2)) * 2048; const bf16* pb_ = OBK + ebase + (size_t)((r & 3) + 8 * (r >> 2)) * 2048; float s_ = 0.f;
#pragma unroll
            for (int t = 0; t < 8; ++t) { const int co = 128 * (t >> 1) + 64 * (t & 1); z[t][r] += bf2f(pf_[co]) + bf2f(pb_[co]); s_ += z[t][r] * z[t][r]; }
            ss[r] = s_; asm volatile("" ::: "memory"); }
#pragma unroll
        for (int r = 0; r < 16; ++r) {
#pragma unroll
            for (int o = 1; o < 32; o <<= 1) ss[r] += shx(ss[r], o, lane); }
        LAS float* ssb = (LAS float*)(lds + SSB);
        if (l31 == 0) {
#pragma unroll
            for (int r = 0; r < 16; ++r) ssb[w * 32 + hh * 16 + r] = ss[r]; }
        __syncthreads();
#pragma unroll
        for (int r = 0; r < 16; ++r) ss[r] = rsqrtf((ss[r] + ssb[(w ^ 1) * 32 + hh * 16 + r]) * (1.f / 512.f) + 1e-6f);
        asm volatile("" : "+v"(ebase));
#pragma unroll
        for (int r = 0; r < 16; ++r) { bf16* pf_ = OF + ebase + (size_t)((r & 3) + 8 * (r >> 2)) * 2048;
#pragma unroll
            for (int t = 0; t < 8; ++t) { const int co = 128 * (t >> 1) + 64 * (t & 1); pf_[co] = f2bf(z[t][r] * ss[r]); }
            asm volatile("" ::: "memory"); }
    }
}

__device__ __forceinline__ void gbar(unsigned* ctr, unsigned target, const int wave) {
    asm volatile("s_waitcnt vmcnt(0)" ::: "memory");
    __syncthreads();
    int t_ = tid_of(wave); asm volatile("" : "+v"(t_));
    if (t_ == 0) {
        __builtin_amdgcn_fence(__ATOMIC_RELEASE, "agent");
        asm volatile("s_waitcnt vmcnt(0) lgkmcnt(0)" ::: "memory");
        __hip_atomic_fetch_add(ctr, 1u, __ATOMIC_RELAXED, __HIP_MEMORY_SCOPE_AGENT);
        while (__hip_atomic_load(ctr, __ATOMIC_RELAXED, __HIP_MEMORY_SCOPE_AGENT) < target) __builtin_amdgcn_s_sleep(2);
        __builtin_amdgcn_fence(__ATOMIC_ACQUIRE, "agent");
        asm volatile("s_waitcnt vmcnt(0) lgkmcnt(0)" ::: "memory");
    }
    __syncthreads();
}
#define GSYNC() do { nsync += (unsigned)Gn; gbar(gctr, nsync, wave); } while (0)

#define GEMM_CALL(EPI_T, A_, B_, M_, N_, K_, E_) do { pg8::Gemm g_{(const pg8::bf16_t*)(A_), (const pg8::bf16_t*)(B_), (M_), (N_), (K_)}; pg8::StaticOrder S_; S_.init((M_), (N_), Gn, (int)blockIdx.x); \
    pg8::gemm_phase<EPI_T, pg8::StaticOrder, true, true>(lds, g_, S_, (E_), wave); } while (0)

#ifdef DBG
__device__ __forceinline__ void dbg_acc(unsigned char* ws, int id, float err2, float ref2, int lane) { if (lane == 0) { atomicAdd((float*)(ws + WS_CTL + 1024) + 2 * id, err2); atomicAdd((float*)(ws + WS_CTL + 1024) + 2 * id + 1, ref2); } }
__device__ __forceinline__ float wsum_d(float v) { for (int o = 1; o < 64; o <<= 1) v += __shfl_xor(v, o); return v; }
__device__ __forceinline__ float dbg_dot(const bf16* arow, const float* W, int K, int N, int col, int lane) { float a = 0.f; for (int k = lane; k < K; k += 64) a += bf2f(arow[k]) * W[(size_t)k * N + col]; return wsum_d(a); }
__device__ __forceinline__ void dbg_gemm(unsigned char* ws, int id, const bf16* A, const float* W, int K, int N, const void* O, int ldo, int mode, int gwv, int lane) {
    if (gwv >= 256) return;
    const int row = (gwv * 2731 + 17) % TG, col = (gwv * 977 + 5) % N;
    float ref = dbg_dot(A + (size_t)row * K, W, K, N, col, lane), got;
    if (mode == 0) got = ((const float*)O)[(size_t)row * ldo + col]; else { ref = fmaxf(ref, 0.f); ref *= ref; got = bf2f(((const bf16*)O)[(size_t)row * ldo + col]); }
    dbg_acc(ws, id, (got - ref) * (got - ref), ref * ref, lane);
}
__device__ __forceinline__ void dbg_attn_qkv(unsigned char* ws, int id, const bf16* A, const float* W, const bf16* Qb, const bf16* Kb, const bf16* Vb, int S, int gwv, int lane) {
    if (gwv >= 256) return;
    const int row = (gwv * 2731 + 17) % TG, col = (gwv * 1549 + 3) % 3072, region = col >> 10, cr = col & 1023, d = cr & 63, s = row % S;
    float x = dbg_dot(A + (size_t)row * 1024, W, 1024, 3072, col, lane), ref, got;
    if (region == 2) { ref = x; got = bf2f(Vb[(size_t)row * 1024 + cr]); }
    else { const int pc = d < 32 ? col + 32 : col - 32; const float xp = dbg_dot(A + (size_t)row * 1024, W, 1024, 3072, pc, lane);
        const float inv = ex2(-13.287712379549449f * (float)(2 * (d & 31)) / 64.0f); const double ad = (double)((float)s * inv); const float ang = (float)(ad - 6.283185307179586 * floor(ad / 6.283185307179586)); const float rot = d < 32 ? -xp : xp;
        ref = x * __cosf(ang) + rot * __sinf(ang); if (region == 0) ref *= 0.125f * LOG2E; got = bf2f((region == 0 ? Qb : Kb)[(size_t)row * 1024 + cr]); }
    dbg_acc(ws, id, (got - ref) * (got - ref), ref * ref, lane);
}
__device__ __forceinline__ void dbg_ret_qkv(unsigned char* ws, int id, const bf16* A, const float* W, const bf16* Qb, const bf16* Kb, const bf16* Vb, int S, int gwv, int lane) {
    if (gwv >= 256) return;
    const int row = (gwv * 2731 + 17) % TG, col = (gwv * 1549 + 3) % 4096, s = row % S;
    float x = dbg_dot(A + (size_t)row * 1024, W, 1024, 6144, col, lane), ref, got;
    if (col >= 2048) { ref = x; got = bf2f(Vb[(size_t)row * 2048 + col - 2048]); }
    else { const float xp = dbg_dot(A + (size_t)row * 1024, W, 1024, 6144, col ^ 1, lane); const int pi = (col & 255) >> 1;
        const float a = ex2(-13.287712379549449f * (float)pi / 127.0f); const double ad = (double)((float)s * a); const float ang = (float)(ad - 6.283185307179586 * floor(ad / 6.283185307179586)); const float rot = (col & 1) ? xp : -xp;
        ref = x * __cosf(ang) + rot * __sinf(ang); if (col >= 1024) ref *= 0.0625f; got = bf2f((col < 1024 ? Qb : Kb)[(size_t)row * 1024 + (col & 1023)]); }
    dbg_acc(ws, id, (got - ref) * (got - ref), ref * ref, lane);
}
__device__ __forceinline__ void dbg_attn(unsigned char* ws, int id, const bf16* Qb, const bf16* Kb, const bf16* Vb, const bf16* OB, int S, int NB, float lam, float oscale, const float* subln, int gwv, int lane) {
    if (gwv >= 32) return;
    const int b = gwv % NB, s = (gwv * 389 + 7) % S, h = (gwv * 5 + 1) & 7; const size_t row = (size_t)b * S + s, rb = (size_t)b * S;
    float of0 = 0.f, of1 = 0.f;
    for (int c = 0; c < 2; ++c) {
        const float q = bf2f(Qb[row * 1024 + h * 128 + c * 64 + lane]);
        float mr = -1e30f, l = 0.f, o0 = 0.f, o1 = 0.f;
        for (int m = 0; m < S; ++m) {
            const float sc = wsum_d(q * bf2f(Kb[(rb + m) * 1024 + h * 128 + c * 64 + lane]));
            const float mn = fmaxf(mr, sc), al = exp2f(mr - mn), p = exp2f(sc - mn); mr = mn;
            l = l * al + p; o0 = o0 * al + p * bf2f(Vb[(rb + m) * 1024 + h * 128 + lane]); o1 = o1 * al + p * bf2f(Vb[(rb + m) * 1024 + h * 128 + 64 + lane]);
        }
        if (c == 0) { of0 = o0 / l; of1 = o1 / l; } else { of0 -= lam * o0 / l; of1 -= lam * o1 / l; }
    }
    const float ss = wsum_d(of0 * of0 + of1 * of1), r = rsqrtf(ss / 128.f + 1e-5f) * oscale;
    const float r0 = of0 * r * subln[lane], r1 = of1 * r * subln[64 + lane];
    const float g0 = bf2f(OB[row * 1024 + h * 128 + lane]), g1 = bf2f(OB[row * 1024 + h * 128 + 64 + lane]);
    dbg_acc(ws, id, wsum_d((g0 - r0) * (g0 - r0) + (g1 - r1) * (g1 - r1)), wsum_d(r0 * r0 + r1 * r1), lane);
}
__device__ __forceinline__ void dbg_ret(unsigned char* ws, int id, const bf16* Qb, const bf16* Kb, const bf16* Vb, const bf16* OB, int S, int NB, const float* decay, int gwv, int lane) {
    if (gwv >= 32) return;
    const int b = gwv % NB, n = (gwv * 389 + 7) % S, h = (gwv * 3 + 1) & 3; const size_t row = (size_t)b * S + n, rb = (size_t)b * S;
    const float lgf = -expf(decay[h]), lgb = -expf(decay[4 + h]);
    float q[4], o[8];
#pragma unroll
    for (int t = 0; t < 4; ++t) q[t] = bf2f(Qb[row * 1024 + h * 256 + lane + 64 * t]);
#pragma unroll
    for (int t = 0; t < 8; ++t) o[t] = 0.f;
    for (int m = 0; m < S; ++m) {
        float a = 0.f;
#pragma unroll
        for (int t = 0; t < 4; ++t) a += q[t] * bf2f(Kb[(rb + m) * 1024 + h * 256 + lane + 64 * t]);
        a = wsum_d(a) * (m <= n ? expf(lgf * (float)(n - m)) : expf(lgb * (float)(m - n)));
#pragma unroll
        for (int t = 0; t < 8; ++t) o[t] += a * bf2f(Vb[(rb + m) * 2048 + h * 512 + lane + 64 * t]);
    }
    float ss = 0.f;
#pragma unroll
    for (int t = 0; t < 8; ++t) ss += o[t] * o[t];
    const float r = rsqrtf(wsum_d(ss) / 512.f + 1e-6f); float e2 = 0.f, r2 = 0.f;
#pragma unroll
    for (int t = 0; t < 8; ++t) { const float rf = o[t] * r, gt = bf2f(OB[row * 2048 + h * 512 + lane + 64 * t]); e2 += (gt - rf) * (gt - rf); r2 += rf * rf; }
    dbg_acc(ws, id, wsum_d(e2), wsum_d(r2), lane);
}

__device__ __forceinline__ void dbg_rp(unsigned char* ws, int id, const float* xold, const float* xnew, const float* m, const float* wpost, const float* wpre, const bf16* hb, int gwv, int lane) {
    if (gwv >= 64) return;
    const int row = (gwv * 2731 + 17) % TG; float e2 = 0.f, r2 = 0.f, ss = 0.f, xs[16];
    if (m) { for (int k = lane; k < 1024; k += 64) { const float v = m[(size_t)row * 1024 + k]; ss += v * v; } }
    const float r = rsqrtf(wsum_d(ss) / 1024.f + 1e-6f); float s2 = 0.f;
#pragma unroll
    for (int t = 0; t < 16; ++t) { const int k = lane + 64 * t; float v = xold ? xold[(size_t)row * 1024 + k] : xnew[(size_t)row * 1024 + k]; if (m) v += m[(size_t)row * 1024 + k] * r * wpost[k]; xs[t] = v; s2 += v * v;
        if (xold) { const float g = xnew[(size_t)row * 1024 + k]; e2 += (g - v) * (g - v); r2 += v * v; } }
    const float rr = rsqrtf(wsum_d(s2) / 1024.f + 1e-6f);
#pragma unroll
    for (int t = 0; t < 16; ++t) { const int k = lane + 64 * t; const float rf = xs[t] * rr * (wpre ? wpre[k] : 1.f), g = bf2f(hb[(size_t)row * 1024 + k]); e2 += (g - rf) * (g - rf); r2 += rf * rf; }
    dbg_acc(ws, id, wsum_d(e2), wsum_d(r2), lane);
}
#endif

#ifndef DBG_MASK
#define DBG_MASK 255
#endif
#ifndef DBG_G
#define DBG_G 0
#endif
#ifndef DBG_TOL
#define DBG_TOL 1e-3f
#endif
#define PT_OFF 143360
__device__ __forceinline__ unsigned long long ldpk(int k) { unsigned a = (unsigned)(PT_OFF + 8 * k); asm volatile("" : "+s"(a)); const unsigned long long v = *(LAS unsigned long long*)a;
    const unsigned lo = __builtin_amdgcn_readfirstlane((unsigned)v), hi = __builtin_amdgcn_readfirstlane((unsigned)(v >> 32)); return ((unsigned long long)hi << 32) | lo; }
#define PIN(k) ((const float*)ldpk(k))
#define WSP ((unsigned char*)ldpk(23))
#define GW (vcu * 8 + wave)
#define NGW (Gn * 8)
#define GCTR ((unsigned*)(WSP + WS_CTL))
#undef GSYNC
#define GSYNC() do { nsync += (unsigned)Gn; gbar(GCTR, nsync, wave); } while (0)
#define XP ((float*)ldpk(22) + (size_t)g * TG * DM)
#define WBP ((bf16*)(WSP + WS_W))
#define HBP ((bf16*)(WSP + WS_HB))
#define PBP ((bf16*)(WSP + WS_PB))
#define OBP ((bf16*)(WSP + WS_OB))
#define BIGP (WSP + WS_BIG)
__global__ void __launch_bounds__(512) fwd_mega(Params P) {
    extern __shared__ __attribute__((aligned(16))) unsigned char lds_raw[];
    LAS unsigned char* lds = (LAS unsigned char*)lds_raw;
    cg::grid_group grid = cg::this_grid();
    const int wave = __builtin_amdgcn_readfirstlane(threadIdx.x >> 6);
    const int Gn = gridDim.x, bx = blockIdx.x, vcu = (Gn % 8 == 0) ? (bx % 8) * (Gn / 8) + bx / 8 : bx;
    { LAS unsigned long long* PT = (LAS unsigned long long*)(lds + PT_OFF);
      if (threadIdx.x < 22) PT[threadIdx.x] = (unsigned long long)P.in[threadIdx.x];
      if (threadIdx.x == 22) PT[22] = (unsigned long long)P.out;
      if (threadIdx.x == 23) PT[23] = (unsigned long long)P.ws; }
    __syncthreads();
    unsigned nsync = 0;

    { unsigned char* ws = WSP; bf16* Wb = (bf16*)(ws + WS_W);
      float* rc = (float*)(ws + WS_TAB + TAB_RC); float* rs = (float*)(ws + WS_TAB + TAB_RS); float* xc = (float*)(ws + WS_TAB + TAB_XC); float* xs = (float*)(ws + WS_TAB + TAB_XS);
      int tid_t = tid_of(wave); asm volatile("" : "+v"(tid_t)); const int gt = (vcu * 512 + tid_t), NT_ = Gn * 512;
#ifndef NO_TAB
      for (int idx = gt; idx < 8192 * 32; idx += NT_) { const int s = idx >> 5, j = idx & 31; const float inv = 1.0f / powf(10000.0f, (float)(2 * j) / 64.0f); const float ang = (float)s * inv; float sn, cs; sincosf(ang, &sn, &cs); rc[idx] = cs; rs[idx] = sn; }
      for (int idx = gt; idx < 8192 * 128; idx += NT_) { const int s = idx >> 7, i = idx & 127; const float a = 1.0f / powf(10000.0f, (float)i / 127.0f); const float ang = (float)s * a; float sn, cs; sincosf(ang, &sn, &cs); xc[idx] = cs; xs[idx] = sn; }
#endif
      LAS float* scr = (LAS float*)(lds + wave * 16384);
#pragma unroll 1
      for (int mi = 0; mi < 32; ++mi) {
          const int kind = mi >> 2, li = mi & 3;
          int pin, K, N, permN = 0; size_t soff, doff;
          switch (kind) {
              case 0: if (li >= 2) continue; pin = 8; K = 1024; N = 3072; permN = 2048; soff = (size_t)li * 1024 * 3072; doff = W_QKV + (size_t)li * 3 * MEL; break;
              case 1: if (li >= 2) continue; pin = 9; K = 1024; N = 1024; soff = (size_t)li * MEL; doff = W_O + (size_t)li * MEL; break;
              case 2: if (li >= 2) continue; pin = 15; K = 1024; N = 6144; soff = (size_t)li * 1024 * 6144; doff = W_RIN + (size_t)li * 6 * MEL; break;
              case 3: if (li >= 2) continue; pin = 16; K = 2048; N = 1024; soff = (size_t)li * 2 * MEL; doff = W_ROUT + (size_t)li * 2 * MEL; break;
              case 4: pin = 18; K = 1024; N = 4096; soff = (size_t)li * 4 * MEL; doff = W_MIN + (size_t)li * 4 * MEL; break;
              case 5: pin = 19; K = 4096; N = 1024; soff = (size_t)li * 4 * MEL; doff = W_MOUT + (size_t)li * 4 * MEL; break;
              case 6: pin = 20; K = 256; N = 1024; soff = (size_t)li * 262144; doff = W_PROJ + (size_t)li * 262144; break;
              default: pin = 21; K = 1024; N = 1024; soff = (size_t)li * MEL; doff = W_GATE + (size_t)li * MEL; break;
          }
          conv_matrix(PIN(pin) + soff, K, N, Wb + doff, permN, scr, GW, NGW, wave);
      }
    }
    grid.sync();
#pragma unroll 1
    for (int step = 0; step < 2 * 4 * 13; ++step) {
        const int g = step / 52, i = (step % 52) / 13, ph = step % 13, j = i >> 1, ret = i & 1;
        const int S = g ? 8192 : 2048, NB = g ? 4 : 16, smask = S - 1;
        switch (ph) {
        case 0: { if (i != 0) continue; rowpass<false, true, true, false>(PIN(g), XP, nullptr, nullptr, PIN(4), HBP, nullptr, nullptr, GW, NGW, wave); } break;
        case 1: {
            unsigned char* B_ = BIGP; unsigned char* ws = WSP;
            if (!ret) { EpiAttnQKV E{(bf16*)B_, (bf16*)(B_ + 64 * MiB), (bf16*)(B_ + 128 * MiB), (const float*)(ws + WS_TAB + TAB_RC), (const float*)(ws + WS_TAB + TAB_RS), smask};
                GEMM_CALL(EpiAttnQKV, HBP, WBP + W_QKV + (size_t)j * 3 * MEL, TG, 3072, 1024, E); }
            else { EpiRetQKV E{(bf16*)B_, (bf16*)(B_ + 64 * MiB), (bf16*)(B_ + 128 * MiB), (const float*)(ws + WS_TAB + TAB_XC), (const float*)(ws + WS_TAB + TAB_XS), smask};
                GEMM_CALL(EpiRetQKV, HBP, WBP + W_RIN + (size_t)j * 6 * MEL, TG, 4096, 1024, E); }
        } break;
        case 2: {
            unsigned char* B_ = BIGP;
            if (!ret) {
                const float* lq1 = PIN(10) + j * 64; const float* lk1 = PIN(11) + j * 64; const float* lq2 = PIN(12) + j * 64; const float* lk2 = PIN(13) + j * 64;
                float d1 = 0.f, d2 = 0.f;
                for (int k = 0; k < 64; ++k) { d1 += lq1[k] * lk1[k]; d2 += lq2[k] * lk2[k]; }
                const float lam_init = 0.8f - 0.6f * expf(-0.3f * (float)i); const float lam = expf(d1) - expf(d2) + lam_init;
#ifndef NO_ATTN
                attn_phase(lds, (const bf16*)B_, (const bf16*)(B_ + 64 * MiB), (const bf16*)(B_ + 128 * MiB), OBP, S, NB, vcu, Gn, lam, 1.0f - lam_init, PIN(14) + j * 128, (float*)(B_ + 256 * MiB) + (size_t)blockIdx.x * 32768, wave);
#endif
            } else {
#ifndef NO_SCAN
                scan_phase(lds, (const bf16*)B_, (const bf16*)(B_ + 64 * MiB), (const bf16*)(B_ + 128 * MiB), OBP, (bf16*)(B_ + 256 * MiB), S, NB, vcu, Gn, PIN(17) + j * 8, wave);
#endif
            }
        } break;
        case 3: { if (!ret) continue;
#ifndef NO_INTRA
            unsigned char* B_ = BIGP; intra_phase(lds, (const bf16*)B_, (const bf16*)(B_ + 64 * MiB), (const bf16*)(B_ + 128 * MiB), OBP, (const bf16*)(B_ + 256 * MiB), S, NB, vcu, Gn, PIN(17) + j * 8, wave);
#endif
        } break;
        case 4: { if (!ret) continue; EpiSiluMul E{OBP, 2048}; GEMM_CALL(EpiSiluMul, HBP, WBP + W_RIN + (size_t)j * 6 * MEL + (size_t)4096 * 1024, TG, 2048, 1024, E); } break;
        case 5: case 8: case 10: {
            unsigned char* B_ = BIGP; const bf16* A_; const bf16* W_; int K_; float* O_;
            if (ph == 5) { A_ = OBP; K_ = ret ? 2048 : 1024; W_ = WBP + (ret ? W_ROUT + (size_t)j * 2 * MEL : W_O + (size_t)j * MEL); O_ = (float*)B_; }
            else if (ph == 8) { A_ = (const bf16*)B_; K_ = 4096; W_ = WBP + W_MOUT + (size_t)i * 4 * MEL; O_ = (float*)(B_ + 256 * MiB); }
            else { A_ = PBP; K_ = 256; W_ = WBP + W_PROJ + (size_t)i * 262144; O_ = (float*)B_; }
            EpiF32 E{O_, DM}; GEMM_CALL(EpiF32, A_, W_, TG, 1024, K_, E);
#ifndef PROJ_SYNC
            if (ph == 10) continue;
#endif
        } break;
        case 6: { float* x = XP; rowpass<true, true, true, false>(x, x, (const float*)BIGP, PIN(5) + i * DM, PIN(6) + i * DM, HBP, nullptr, nullptr, GW, NGW, wave); } break;
        case 7: { EpiRelu2 E{(bf16*)BIGP, FFD}; GEMM_CALL(EpiRelu2, HBP, WBP + W_MIN + (size_t)i * 4 * MEL, TG, 4096, 1024, E); } break;
        case 9: { float* x = XP; rowpass<true, true, false, true>(x, x, (const float*)(BIGP + 256 * MiB), PIN(7) + i * DM, nullptr, HBP, PIN(2 + g) + (size_t)i * TG * 256, PBP, GW, NGW, wave); } break;
        case 11: { EpiGate E{XP, (const float*)BIGP}; GEMM_CALL(EpiGate, HBP, WBP + W_GATE + (size_t)i * MEL, TG, 1024, 1024, E); } break;
        default: { if (i == 3) continue; rowpass<false, false, true, false>(XP, nullptr, nullptr, nullptr, PIN(4) + (i + 1) * DM, HBP, nullptr, nullptr, GW, NGW, wave); } break;
        }
        GSYNC();
#ifdef DBG
        if (g == DBG_G) {
            int lane = tid_of(wave) & 63, gwv = (int)blockIdx.x * 8 + wave; asm volatile("" : "+v"(lane), "+s"(gwv)); unsigned char* ws = WSP; unsigned char* B_ = ws + WS_BIG;
            const bf16* Qb = (const bf16*)B_; const bf16* Kb = (const bf16*)(B_ + 64 * MiB); const bf16* Vb = (const bf16*)(B_ + 128 * MiB);
            const int hi_ = i >> 1;
            bool did = true;
            if (!ret && ph == 1) dbg_attn_qkv(ws, hi_ ? 14 : 2, HBP, PIN(8) + (size_t)j * 1024 * 3072, Qb, Kb, Vb, S, gwv, lane);
            else if (!ret && ph == 2) { const float* lq1 = PIN(10) + j * 64; const float* lk1 = PIN(11) + j * 64; const float* lq2 = PIN(12) + j * 64; const float* lk2 = PIN(13) + j * 64; float d1 = 0.f, d2 = 0.f;
                for (int k = 0; k < 64; ++k) { d1 += lq1[k] * lk1[k]; d2 += lq2[k] * lk2[k]; }
                const float lam_init = 0.8f - 0.6f * expf(-0.3f * (float)i); dbg_attn(ws, hi_ ? 14 : 3, Qb, Kb, Vb, OBP, S, NB, expf(d1) - expf(d2) + lam_init, 1.0f - lam_init, PIN(14) + j * 128, gwv, lane); }
            else if (!ret && ph == 5) dbg_gemm(ws, hi_ ? 14 : 4, OBP, PIN(9) + (size_t)j * MEL, 1024, 1024, B_, 1024, 0, gwv, lane);
            else if (i == 0 && ph == 6) dbg_rp(ws, 5, PIN(g), XP, (const float*)B_, PIN(5), PIN(6), HBP, gwv, lane);
            else if (i == 0 && ph == 7) dbg_gemm(ws, 6, HBP, PIN(18), 1024, 4096, B_, 4096, 1, gwv, lane);
            else if (i == 0 && ph == 8) dbg_gemm(ws, 7, (const bf16*)B_, PIN(19), 4096, 1024, B_ + 256 * MiB, 1024, 0, gwv, lane);
            else if (i == 0 && ph == 9) dbg_rp(ws, 8, nullptr, XP, nullptr, nullptr, nullptr, HBP, gwv, lane);
            else if (i == 0 && ph == 11) dbg_gemm(ws, 9, PBP, PIN(20), 256, 1024, B_, 1024, 0, gwv, lane);
            else if (ret && ph == 1) dbg_ret_qkv(ws, hi_ ? 14 : 10, HBP, PIN(15) + (size_t)j * 1024 * 6144, Qb, Kb, Vb, S, gwv, lane);
            else if (ret && ph == 3) dbg_ret(ws, hi_ ? 14 : 11, Qb, Kb, Vb, OBP, S, NB, PIN(17) + j * 8, gwv, lane);
            else if (ret && ph == 5) dbg_gemm(ws, hi_ ? 14 : 13, OBP, PIN(16) + (size_t)j * 2 * MEL, 2048, 1024, B_, 1024, 0, gwv, lane);
            else if (i == 3 && ph == 11) dbg_acc(ws, 15, 1.f, 1.f, lane);
            else did = false;
            if (did) GSYNC();
        }
#endif
    }
#ifdef DBG
    { unsigned char* ws = WSP; const float* acc = (const float*)(ws + WS_CTL + 1024); int bad = -1;
      for (int id = 15; id >= 0; --id) { const float e = __hip_atomic_load(acc + 2 * id, __ATOMIC_RELAXED, __HIP_MEMORY_SCOPE_AGENT), r = __hip_atomic_load(acc + 2 * id + 1, __ATOMIC_RELAXED, __HIP_MEMORY_SCOPE_AGENT); if (r > 0.f && !(e <= DBG_TOL * r)) bad = id; }
      if (bad >= 0) { float C = 100.f; for (int k = 0; k < bad; ++k) C *= 4.f;
#ifdef DBG_RATIO
          C = 1000.f * fminf(fmaxf(__hip_atomic_load(acc + 2 * bad, __ATOMIC_RELAXED, __HIP_MEMORY_SCOPE_AGENT) / __hip_atomic_load(acc + 2 * bad + 1, __ATOMIC_RELAXED, __HIP_MEMORY_SCOPE_AGENT), 1e-3f), 1e3f);
#endif
 float* o = (float*)ldpk(22); const size_t n = (size_t)2 * TG * DM;
          for (size_t idx = (size_t)blockIdx.x * 512 + tid_of(wave); idx < n; idx += (size_t)Gn * 512) o[idx] = C; } }
#endif
}

extern "C" void kernel_launch(void* const* d_in, const int* in_sizes, int n_in, void* d_out, int out_size, void* d_ws, size_t ws_size, hipStream_t stream) {
    static int grid_blocks = 0;
    if (!grid_blocks) {
        int dev = 0, cus = 0, per_cu = 0;
        (void)hipGetDevice(&dev);
        (void)hipDeviceGetAttribute(&cus, hipDeviceAttributeMultiprocessorCount, dev);
        (void)hipFuncSetAttribute((const void*)fwd_mega, hipFuncAttributeMaxDynamicSharedMemorySize, LDS_BYTES);
        (void)hipOccupancyMaxActiveBlocksPerMultiprocessor(&per_cu, (const void*)fwd_mega, 512, LDS_BYTES);
        if (per_cu < 1) per_cu = 1;
        grid_blocks = cus * per_cu;
        if (ws_size < WS_END || n_in != 22) { fprintf(stderr, "kernel_launch: workspace %zu < %zu or n_in %d != 22\n", ws_size, (size_t)WS_END, n_in); }
    }
    (void)hipMemsetAsync((char*)d_ws + WS_CTL, 0, 4096, stream);
    Params p{};
    for (int i = 0; i < 22; ++i) p.in[i] = (const float*)d_in[i];
    p.out = (float*)d_out; p.ws = (unsigned char*)d_ws;
    void* args[] = {&p};
    hipError_t e = hipLaunchCooperativeKernel((void*)fwd_mega, dim3(grid_blocks), dim3(512), args, LDS_BYTES, stream);
    if (e != hipSuccess) fprintf(stderr, "cooperative launch failed: %s (grid %d)\n", hipGetErrorString(e), grid_blocks);
}
```

```cpp
#include <hip/hip_runtime.h>
#include <hip/hip_cooperative_groups.h>
#include <cstdio>
#include <cstdint>
namespace pg8 {
#define PG8_LAS __attribute__((address_space(3)))
typedef unsigned short bf16_t;
typedef short bf16x8 __attribute__((ext_vector_type(8)));
typedef float f32x4 __attribute__((ext_vector_type(4)));
typedef unsigned u32x4 __attribute__((ext_vector_type(4)));
constexpr int BM = 256, BK = 64, HALF = 128, HTB = HALF * BK * 2  , STAGE_BYTES = 8 * HTB, NXCD = 8, WGM = 8;

__host__ __device__ __forceinline__ int lds_byte(int r, int c) { const int st = (r >> 4) * 2 + (c >> 5), rr = r & 15, cc = c & 31, ob = rr * 64 + cc * 2; return st * 1024 + (ob ^ (((ob >> 9) & 1) << 5)); }
__host__ __device__ __forceinline__ void stage_rc(int b, int& R, int& C) { const int st = b / 1024, sb = b % 1024, swz = sb ^ (((sb >> 9) & 1) << 5); R = (st >> 1) * 16 + swz / 64; C = (st & 1) * 32 + (swz % 64) / 2; }
__host__ __device__ __forceinline__ int perm32(int rho) { const int n = rho >> 4, i = rho & 15; return 8 * (i >> 2) + 4 * n + (i & 3); }

struct Unit { int pm, pn; };
struct Gemm { const bf16_t* A; const bf16_t* Bt; int M, N, K; };

struct StaticOrder {
    int nM, nN, nwg, G, c;
    __host__ __device__ void init(int M, int N, int G_, int c_) { nM = M / BM; nN = N / BM; nwg = nM * nN; G = G_; c = c_; }
    __host__ __device__ bool next(int i, Unit& u) const {
        const long L = (long)i * G + c; if (L >= nwg) return false;
        int wgid = (int)L; { const int q = nwg / NXCD, r = nwg % NXCD, xcd = wgid % NXCD, off = wgid / NXCD; wgid = (xcd < r ? xcd * (q + 1) : r * (q + 1) + (xcd - r) * q) + off; }
        const int nig = WGM * nN, gid = wgid / nig, fm = gid * WGM, gsz = (nM - fm) < WGM ? (nM - fm) : WGM;
        u.pm = fm + ((wgid % nig) % gsz); u.pn = (wgid % nig) / gsz; return true;
    }
    __device__ __forceinline__ void a_ready(const Unit&) const {}
    __device__ __forceinline__ void done(const Unit&) const {}
};

__device__ __forceinline__ unsigned cvt_pk_bf16(float lo, float hi) { unsigned r; asm volatile("v_cvt_pk_bf16_f32 %0, %1, %2" : "=v"(r) : "v"(lo), "v"(hi)); return r; }
typedef float f32x2 __attribute__((ext_vector_type(2)));
template <class Epi, class Sched, bool ALIGN_EPI = false, bool SP2 = false>
__device__ __forceinline__ void gemm_phase(PG8_LAS unsigned char* lds, const Gemm g, const Sched& S, const Epi& E, const int wave_id) {
    int tid_l; asm volatile("v_mbcnt_lo_u32_b32 %0, -1, 0\n\tv_mbcnt_hi_u32_b32 %0, -1, %0" : "=v"(tid_l)); tid_l += wave_id * 64; asm volatile("" : "+v"(tid_l));
    const int tid = tid_l, wid = __builtin_amdgcn_readfirstlane(tid >> 6), lane = tid & 63, wr = wid >> 2, wc = wid & 3, fr = lane & 15, fq = lane >> 4;
    const int K = g.K, nt = K / BK;
    unsigned voffA[2], voffB[2];
#pragma unroll
    for (int i = 0; i < 2; ++i) { int R, C; stage_rc(tid * 16 + i * 8192, R, C); const int Rb = Epi::PERM ? ((R & ~31) + perm32(R & 31)) : R;
        voffA[i] = (unsigned)(R * K + C) * 2u; voffB[i] = (unsigned)(Rb * K + C) * 2u; }
    const size_t kstep = (size_t)(BK * 2);
    const size_t hstep = (size_t)HALF * K * 2;
    const size_t tstep = 2 * hstep;
    const unsigned ldsw = (unsigned)wid * 1024u;
    const int aoff = lds_byte(wr * 64 + fr, fq * 8), boff = lds_byte(wc * 32 + fr, fq * 8);
#define PG8_SA(b, h) (((b) * 2 + (h)) * HTB)
#define PG8_SB(b, h) ((4 + (b) * 2 + (h)) * HTB)
#define PG8_STAGE(bufoff, gbase, voff) do { _Pragma("unroll") for (int _i = 0; _i < 2; ++_i) \
        __builtin_amdgcn_global_load_lds((const unsigned*)((const char*)(gbase) + (voff)[_i]), (PG8_LAS unsigned*)(lds + (bufoff) + ldsw + _i * 8192), 16, 0, 0); } while (0)
#define PG8_LDA(dst, b, h) do { _Pragma("unroll") for (int m = 0; m < 4; ++m) _Pragma("unroll") for (int k = 0; k < 2; ++k) dst[m][k] = *(const PG8_LAS bf16x8*)(lds + PG8_SA(b, h) + aoff + m * 2048 + k * 1024); } while (0)
#define PG8_LDB(dst, b, h) do { _Pragma("unroll") for (int n = 0; n < 2; ++n) _Pragma("unroll") for (int k = 0; k < 2; ++k) dst[n][k] = *(const PG8_LAS bf16x8*)(lds + PG8_SB(b, h) + boff + n * 2048 + k * 1024); } while (0)
#define PG8_MMA(ai, bj, At, Bt) do { __builtin_amdgcn_s_setprio(1); _Pragma("unroll") for (int m = 0; m < 4; ++m) _Pragma("unroll") for (int n = 0; n < 2; ++n) _Pragma("unroll") for (int k = 0; k < 2; ++k) \
        acc[ai][bj][m][n] = __builtin_amdgcn_mfma_f32_16x16x32_bf16(Bt[n][k], At[m][k], acc[ai][bj][m][n], 0, 0, 0); __builtin_amdgcn_s_setprio(0); } while (0)
#define PG8_WAIT_V(n) asm volatile("s_waitcnt vmcnt(" #n ")" ::: "memory")
#define PG8_WAIT_L(n) asm volatile("s_waitcnt lgkmcnt(" #n ")" ::: "memory")
#define PG8_BAR __builtin_amdgcn_s_barrier()
#define PG8_SCHED __builtin_amdgcn_sched_barrier(0)
    Unit cur, nxt; int ui = 0;
    if (!S.next(0, cur)) return;
    f32x4 acc[2][2][4][2];
#pragma unroll
    for (int a = 0; a < 2; ++a)
#pragma unroll
        for (int b = 0; b < 2; ++b)
#pragma unroll
            for (int m = 0; m < 4; ++m)
#pragma unroll
                for (int n = 0; n < 2; ++n) acc[a][b][m][n] = (f32x4){0.f, 0.f, 0.f, 0.f};
    bf16x8 At[4][2], B0[2][2], B1[2][2];
    const char* cA = (const char*)g.A + (size_t)cur.pm * tstep; const char* cB = (const char*)g.Bt + (size_t)cur.pn * tstep;
    S.a_ready(cur);
    if constexpr (SP2) {
        PG8_STAGE(PG8_SB(0, 0), cB, voffB); PG8_STAGE(PG8_SB(0, 1), cB + hstep, voffB); PG8_STAGE(PG8_SA(0, 0), cA, voffA); PG8_STAGE(PG8_SA(0, 1), cA + hstep, voffA);
        if (wr == 1) PG8_BAR;
        PG8_WAIT_V(2); PG8_BAR;
        PG8_STAGE(PG8_SB(1, 0), cB + kstep, voffB); PG8_STAGE(PG8_SA(1, 0), cA + kstep, voffA); PG8_STAGE(PG8_SB(1, 1), cB + hstep + kstep, voffB);
        PG8_WAIT_V(6); PG8_BAR;
    } else {
        PG8_STAGE(PG8_SB(0, 0), cB, voffB); PG8_STAGE(PG8_SA(0, 0), cA, voffA); PG8_STAGE(PG8_SB(0, 1), cB + hstep, voffB); PG8_STAGE(PG8_SA(0, 1), cA + hstep, voffA);
        if (wr == 1) PG8_BAR;
        PG8_WAIT_V(4); PG8_BAR;
        PG8_STAGE(PG8_SB(1, 0), cB + kstep, voffB); PG8_STAGE(PG8_SA(1, 0), cA + kstep, voffA); PG8_STAGE(PG8_SB(1, 1), cB + hstep + kstep, voffB);
        PG8_WAIT_V(6); PG8_BAR;
    }
    for (;;) {
        const bool has_next = S.next(ui + 1, nxt);
        const char* nA = has_next ? (const char*)g.A + (size_t)nxt.pm * tstep : cA; const char* nB = has_next ? (const char*)g.Bt + (size_t)nxt.pn * tstep : cB;
        for (int t = 0; t < nt; t += 2) {
            const bool last = (t == nt - 2);
            const char* a1 = cA + (size_t)(t + 1) * kstep;
            const char* a2 = last ? nA : cA + (size_t)(t + 2) * kstep; const char* b2 = last ? nB : cB + (size_t)(t + 2) * kstep;
            const char* a3 = a2 + kstep; const char* b3 = b2 + kstep;
            if (last && has_next) S.a_ready(nxt);
            if constexpr (SP2) {
            PG8_LDB(B0, 0, 0); PG8_LDB(B1, 0, 1); PG8_SCHED; PG8_LDA(At, 0, 0); PG8_STAGE(PG8_SA(1, 1), a1 + hstep, voffA);
            PG8_WAIT_V(8); PG8_WAIT_L(0); PG8_BAR; PG8_MMA(0, 0, At, B0); PG8_MMA(0, 1, At, B1); PG8_BAR; PG8_SCHED;
            PG8_LDA(At, 0, 1); PG8_STAGE(PG8_SB(0, 0), b2, voffB); PG8_STAGE(PG8_SB(0, 1), b2 + hstep, voffB); PG8_STAGE(PG8_SA(0, 0), a2, voffA);
            PG8_WAIT_V(8); PG8_WAIT_L(0); PG8_BAR; PG8_MMA(1, 0, At, B0); PG8_MMA(1, 1, At, B1); PG8_BAR; PG8_SCHED;
            PG8_LDB(B0, 1, 0); PG8_LDB(B1, 1, 1); PG8_SCHED; PG8_LDA(At, 1, 0); PG8_STAGE(PG8_SA(0, 1), a2 + hstep, voffA);
            PG8_WAIT_V(8); PG8_WAIT_L(0); PG8_BAR; PG8_MMA(0, 0, At, B0); PG8_MMA(0, 1, At, B1); PG8_BAR; PG8_SCHED;
            PG8_LDA(At, 1, 1); PG8_STAGE(PG8_SB(1, 0), b3, voffB); PG8_STAGE(PG8_SB(1, 1), b3 + hstep, voffB); PG8_STAGE(PG8_SA(1, 0), a3, voffA);
            PG8_WAIT_V(8); PG8_WAIT_L(0); PG8_BAR; PG8_MMA(1, 0, At, B0); PG8_MMA(1, 1, At, B1); PG8_BAR; PG8_SCHED;
            } else {
            PG8_LDB(B0, 0, 0); PG8_SCHED; PG8_LDA(At, 0, 0); PG8_STAGE(PG8_SA(1, 1), a1 + hstep, voffA);
            PG8_WAIT_L(8); PG8_BAR; PG8_WAIT_L(0); PG8_MMA(0, 0, At, B0); PG8_BAR; PG8_SCHED;
            PG8_LDB(B1, 0, 1); PG8_STAGE(PG8_SB(0, 0), b2, voffB);
            PG8_BAR; PG8_WAIT_L(0); PG8_MMA(0, 1, At, B1); PG8_BAR;
            PG8_LDA(At, 0, 1); PG8_STAGE(PG8_SA(0, 0), a2, voffA);
            PG8_BAR; PG8_WAIT_L(0); PG8_MMA(1, 0, At, B0); PG8_BAR; PG8_SCHED;
            PG8_STAGE(PG8_SB(0, 1), b2 + hstep, voffB);
            PG8_WAIT_V(6); PG8_BAR; PG8_MMA(1, 1, At, B1); PG8_BAR;
            PG8_LDB(B0, 1, 0); PG8_SCHED; PG8_LDA(At, 1, 0); PG8_STAGE(PG8_SA(0, 1), a2 + hstep, voffA);
            PG8_WAIT_L(8); PG8_BAR; PG8_WAIT_L(0); PG8_MMA(0, 0, At, B0); PG8_BAR; PG8_SCHED;
            PG8_LDB(B1, 1, 1); PG8_STAGE(PG8_SB(1, 0), b3, voffB);
            PG8_BAR; PG8_WAIT_L(0); PG8_MMA(0, 1, At, B1); PG8_BAR;
            PG8_LDA(At, 1, 1); PG8_STAGE(PG8_SA(1, 0), a3, voffA);
            PG8_BAR; PG8_WAIT_L(0); PG8_MMA(1, 0, At, B0); PG8_BAR; PG8_SCHED;
            PG8_STAGE(PG8_SB(1, 1), b3 + hstep, voffB);
            PG8_WAIT_V(6); PG8_BAR; PG8_MMA(1, 1, At, B1); PG8_BAR;
            }
        }
        if constexpr (ALIGN_EPI) { if (wr == 0) PG8_BAR; }
        if constexpr (!Epi::AFTER_DRAIN) { E(acc, cur, wr, wc, fr, fq); S.done(cur); }
        if (!has_next) break;
#pragma unroll
        for (int a = 0; a < 2; ++a)
#pragma unroll
            for (int b = 0; b < 2; ++b)
#pragma unroll
                for (int m = 0; m < 4; ++m)
#pragma unroll
                    for (int n = 0; n < 2; ++n) acc[a][b][m][n] = (f32x4){0.f, 0.f, 0.f, 0.f};
        cur = nxt; cA = nA; cB = nB; ++ui;
        if constexpr (ALIGN_EPI) { if (wr == 1) PG8_BAR; }
    }
    PG8_WAIT_V(0);
    if constexpr (!ALIGN_EPI) { if (wr == 0) PG8_BAR; }
    PG8_BAR;
    if constexpr (Epi::AFTER_DRAIN) { E.fused(acc, cur, wr, wc, fr, fq, lds, wid, lane); S.done(cur); }
#undef PG8_SA
#undef PG8_SB
#undef PG8_STAGE
#undef PG8_LDA
#undef PG8_LDB
#undef PG8_MMA
#undef PG8_WAIT_V
#undef PG8_WAIT_L
#undef PG8_BAR
#undef PG8_SCHED
}
}

namespace cg = cooperative_groups;
#define LAS __attribute__((address_space(3)))
#define GAS __attribute__((address_space(1)))
typedef unsigned short bf16;
typedef short bf16x8 __attribute__((ext_vector_type(8)));
typedef short s16x4 __attribute__((ext_vector_type(4)));
typedef float f32x2 __attribute__((ext_vector_type(2)));
typedef float f32x4 __attribute__((ext_vector_type(4)));
typedef float f32x16 __attribute__((ext_vector_type(16)));
typedef unsigned u32x2 __attribute__((ext_vector_type(2)));
typedef unsigned u32x4 __attribute__((ext_vector_type(4)));

constexpr int DM = 1024, TG = 32768, FFD = 4096;
constexpr size_t MiB = (size_t)1 << 20;
constexpr size_t WS_CTL = 0, WS_TAB = 1 * MiB, WS_W = 12 * MiB, WS_HB = 136 * MiB, WS_PB = 200 * MiB, WS_OB = 216 * MiB, WS_BIG = 344 * MiB, WS_END = 728 * MiB;
constexpr size_t TAB_RC = 0, TAB_RS = 1 * MiB, TAB_XC = 2 * MiB, TAB_XS = 6 * MiB;
constexpr size_t MEL = 1048576;
constexpr size_t W_QKV = 0, W_O = 6 * MEL, W_RIN = 8 * MEL, W_ROUT = 20 * MEL, W_MIN = 24 * MEL, W_MOUT = 40 * MEL, W_PROJ = 56 * MEL, W_GATE = 57 * MEL;
constexpr float LOG2E = 1.4426950408889634f;
constexpr int LDS_BYTES = 147456;

struct Params { const float* in[22]; float* out; unsigned char* ws; };

__device__ __forceinline__ unsigned cvtpk(float lo, float hi) { typedef __bf16 b2 __attribute__((ext_vector_type(2))); f32x2 v = {lo, hi}; b2 b = __builtin_convertvector(v, b2); return __builtin_bit_cast(unsigned, b); }
__device__ __forceinline__ float bf2f(unsigned short b) { return __uint_as_float(((unsigned)b) << 16); }
__device__ __forceinline__ unsigned short f2bf(float f) { return (unsigned short)(cvtpk(f, 0.f) & 0xffffu); }
__device__ __forceinline__ float shx(float v, int o, int lane) { return __int_as_float(__builtin_amdgcn_ds_bpermute((lane ^ o) << 2, __float_as_int(v))); }
__device__ __forceinline__ float wave_sum(float v, int lane) {
#pragma unroll
    for (int o = 1; o < 64; o <<= 1) v += shx(v, o, lane);
    return v;
}
__device__ __forceinline__ int crow(int r, int hh) { return (r & 3) + 8 * (r >> 2) + 4 * hh; }
__device__ __forceinline__ s16x4 trr(LAS unsigned char* p) { return __builtin_bit_cast(s16x4, __builtin_amdgcn_ds_read_tr16_b64_v4i16((LAS s16x4*)p)); }
__device__ __forceinline__ bf16x8 cat8(s16x4 lo, s16x4 hi) { return (bf16x8){lo[0], lo[1], lo[2], lo[3], hi[0], hi[1], hi[2], hi[3]}; }
__device__ __forceinline__ bf16x8 pack8(const f32x16& v, int b) { u32x4 w; w.x = cvtpk(v[b], v[b + 1]); w.y = cvtpk(v[b + 2], v[b + 3]); w.z = cvtpk(v[b + 4], v[b + 5]); w.w = cvtpk(v[b + 6], v[b + 7]); return __builtin_bit_cast(bf16x8, w); }
#define LBAR() do { asm volatile("s_waitcnt lgkmcnt(0)" ::: "memory"); __builtin_amdgcn_s_barrier(); asm volatile("" ::: "memory"); } while (0)
#ifndef ATT_THR
#define ATT_THR 6.0f
#endif
#ifndef PPSEL
#define PPSEL(w) ((w) >= 4)
#endif
#define MFMA32(a, b, c) __builtin_amdgcn_mfma_f32_32x32x16_bf16((a), (b), (c), 0, 0, 0)
__device__ __forceinline__ int tid_of(int wave) { int l; asm volatile("v_mbcnt_lo_u32_b32 %0, -1, 0\n\tv_mbcnt_hi_u32_b32 %0, -1, %0" : "=v"(l)); return wave * 64 + l; }
__device__ __forceinline__ float max3f(float a, float b, float c) { float r; asm("v_max3_f32 %0, %1, %2, %3" : "=v"(r) : "v"(a), "v"(b), "v"(c)); return r; }
__device__ __forceinline__ float ex2(float x) { return __builtin_amdgcn_exp2f(x); }

__device__ __forceinline__ int qk_perm(int n) { const int d = n & 63; return (n & ~63) | (((d >> 4) & 1) << 5) | ((d >> 5) << 4) | (d & 15); }
__device__ __forceinline__ void conv_item(const float* W, int K, int N, bf16* WT, int permN, LAS float* scr, int item, int lane) {
    const int nblk = N / 32, kb = item / nblk, nb = item % nblk, k0 = 64 * kb, n0 = 32 * nb;
#pragma unroll 8
    for (int i = 0; i < 32; ++i) { const int kk = 2 * i + (lane >> 5); scr[kk * 33 + (lane & 31)] = ((GAS const float*)W)[(size_t)(k0 + kk) * N + n0 + (lane & 31)]; }
    asm volatile("s_waitcnt lgkmcnt(0)" ::: "memory");
    const int c = lane & 7;
#pragma unroll
    for (int j = 0; j < 4; ++j) { const int n = (lane >> 3) + 8 * j; const LAS float* s = scr + (8 * c) * 33 + n;
        u32x4 o; o.x = cvtpk(s[0 * 33], s[1 * 33]); o.y = cvtpk(s[2 * 33], s[3 * 33]); o.z = cvtpk(s[4 * 33], s[5 * 33]); o.w = cvtpk(s[6 * 33], s[7 * 33]);
        const int nn = n0 + n, dst = nn < permN ? qk_perm(nn) : nn;
        *(GAS u32x4*)(WT + (size_t)dst * K + k0 + 8 * c) = o; }
    asm volatile("s_waitcnt lgkmcnt(0)" ::: "memory");
}
__device__ __forceinline__ void conv_matrix(const float* W, int K, int N, bf16* WT, int permN, LAS float* scr, int gw, int NGW, const int wave) {
    int lane = tid_of(wave) & 63; asm volatile("" : "+v"(lane));
    const int items = (K / 64) * (N / 32);
    for (int it = gw; it < items; it += NGW) conv_item(W, K, N, WT, permN, scr, it, lane);
}

template <bool HAS_M, bool STORE_X, bool HAS_WPRE, bool HAS_P>
__device__ __forceinline__ void rowpass(const float* xsrc, float* xdst, const bf16* m, const float* wpost, const float* wpre, bf16* hb, const float* psrc, bf16* pb, int gw, int NGW, const int wave) {
    int lane = tid_of(wave) & 63; asm volatile("" : "+v"(lane));
    constexpr int RB = 4;
    for (int row0 = gw; row0 < TG; row0 += RB * NGW) {
        f32x4 v[RB][4]; u32x2 mw[RB][4]; f32x4 pv[RB];
#pragma unroll
        for (int q = 0; q < RB; ++q) { const int row = min(row0 + q * NGW, TG - 1);
            GAS const f32x4* xr = (GAS const f32x4*)(xsrc + (size_t)row * DM) + lane;
#pragma unroll
            for (int j = 0; j < 4; ++j) v[q][j] = xr[64 * j];
            if constexpr (HAS_M) { GAS const u32x2* mr = (GAS const u32x2*)(m + (size_t)row * DM) + lane;
#pragma unroll
                for (int j = 0; j < 4; ++j) mw[q][j] = mr[64 * j]; }
            if constexpr (HAS_P) pv[q] = ((GAS const f32x4*)(psrc + (size_t)row * 256))[lane]; }
        f32x4 wp[4], wq[4];
#pragma unroll
        for (int j = 0; j < 4; ++j) { if constexpr (HAS_M) wp[j] = ((GAS const f32x4*)wpost)[lane + 64 * j]; if constexpr (HAS_WPRE) wq[j] = ((GAS const f32x4*)wpre)[lane + 64 * j]; }
#pragma unroll
        for (int q = 0; q < RB; ++q) { const int row = row0 + q * NGW; if (row >= TG) break;
            if constexpr (HAS_M) {
                f32x4 mm[4]; float ss = 0.f;
#pragma unroll
                for (int j = 0; j < 4; ++j) { const u32x2 w_ = mw[q][j]; mm[j].x = __uint_as_float(w_.x << 16); mm[j].y = __uint_as_float(w_.x & 0xffff0000u); mm[j].z = __uint_as_float(w_.y << 16); mm[j].w = __uint_as_float(w_.y & 0xffff0000u);
                    ss += mm[j].x * mm[j].x + mm[j].y * mm[j].y + mm[j].z * mm[j].z + mm[j].w * mm[j].w; }
                const float r = rsqrtf(wave_sum(ss, lane) * (1.f / DM) + 1e-6f);
#pragma unroll
                for (int j = 0; j < 4; ++j) v[q][j] += mm[j] * r * wp[j];
            }
            if constexpr (STORE_X) { GAS f32x4* xo = (GAS f32x4*)(xdst + (size_t)row * DM) + lane;
#pragma unroll
                for (int j = 0; j < 4; ++j) xo[64 * j] = v[q][j]; }
            {
                float ss = 0.f;
#pragma unroll
                for (int j = 0; j < 4; ++j) ss += v[q][j].x * v[q][j].x + v[q][j].y * v[q][j].y + v[q][j].z * v[q][j].z + v[q][j].w * v[q][j].w;
                const float r = rsqrtf(wave_sum(ss, lane) * (1.f / DM) + 1e-6f);
                GAS u32x2* ho = (GAS u32x2*)(hb + (size_t)row * DM) + lane;
#pragma unroll
                for (int j = 0; j < 4; ++j) { f32x4 o = v[q][j] * r; if constexpr (HAS_WPRE) o *= wq[j]; u32x2 w; w.x = cvtpk(o.x, o.y); w.y = cvtpk(o.z, o.w); ho[64 * j] = w; }
            }
            if constexpr (HAS_P) { u32x2 w; w.x = cvtpk(pv[q].x, pv[q].y); w.y = cvtpk(pv[q].z, pv[q].w); ((GAS u32x2*)(pb + (size_t)row * 256))[lane] = w; }
        }
    }
}

#define EPI_LOOP_AIM for (int ai = 0; ai < 2; ++ai) for (int m = 0; m < 4; ++m)
struct EpiF32 {
    static constexpr bool PERM = false, AFTER_DRAIN = false; float* O; int ldc;
    __device__ __forceinline__ void operator()(const pg8::f32x4 (&acc)[2][2][4][2], const pg8::Unit& u, int wr, int wc, int fr, int fq) const {
        const int row0 = u.pm * 256 + wr * 64 + fr, col0 = u.pn * 256 + wc * 32 + 4 * fq;
#pragma unroll
        for (int ai = 0; ai < 2; ++ai)
#pragma unroll
            for (int m = 0; m < 4; ++m) { GAS float* rp = (GAS float*)(O + (size_t)(row0 + ai * 128 + m * 16) * ldc + col0);
#pragma unroll
                for (int bj = 0; bj < 2; ++bj)
#pragma unroll
                    for (int n = 0; n < 2; ++n) *(GAS f32x4*)(rp + bj * 128 + n * 16) = acc[ai][bj][m][n]; }
    }
};
struct EpiBf16Plain {
    static constexpr bool PERM = true, AFTER_DRAIN = false; bf16* O; int ldc;
    __device__ __forceinline__ void operator()(const pg8::f32x4 (&acc)[2][2][4][2], const pg8::Unit& u, int wr, int wc, int fr, int fq) const {
        const int row0 = u.pm * 256 + wr * 64 + fr, col0 = u.pn * 256 + wc * 32 + 8 * fq;
#pragma unroll
        for (int ai = 0; ai < 2; ++ai)
#pragma unroll
            for (int m = 0; m < 4; ++m) { GAS bf16* rp = (GAS bf16*)(O + (size_t)(row0 + ai * 128 + m * 16) * ldc + col0);
#pragma unroll
                for (int bj = 0; bj < 2; ++bj) { f32x4 v0 = acc[ai][bj][m][0], v1 = acc[ai][bj][m][1];
                    u32x4 w; w.x = cvtpk(v0.x, v0.y); w.y = cvtpk(v0.z, v0.w); w.z = cvtpk(v1.x, v1.y); w.w = cvtpk(v1.z, v1.w); *(GAS u32x4*)(rp + bj * 128) = w; } }
    }
};
struct EpiRelu2 {
    static constexpr bool PERM = true, AFTER_DRAIN = false; bf16* O; int ldc;
    __device__ __forceinline__ void operator()(const pg8::f32x4 (&acc)[2][2][4][2], const pg8::Unit& u, int wr, int wc, int fr, int fq) const {
        const int row0 = u.pm * 256 + wr * 64 + fr, col0 = u.pn * 256 + wc * 32 + 8 * fq;
#pragma unroll
        for (int ai = 0; ai < 2; ++ai)
#pragma unroll
            for (int m = 0; m < 4; ++m) { GAS bf16* rp = (GAS bf16*)(O + (size_t)(row0 + ai * 128 + m * 16) * ldc + col0);
#pragma unroll
                for (int bj = 0; bj < 2; ++bj) { f32x4 v0 = acc[ai][bj][m][0], v1 = acc[ai][bj][m][1];
                    v0.x = fmaxf(v0.x, 0.f); v0.y = fmaxf(v0.y, 0.f); v0.z = fmaxf(v0.z, 0.f); v0.w = fmaxf(v0.w, 0.f); v1.x = fmaxf(v1.x, 0.f); v1.y = fmaxf(v1.y, 0.f); v1.z = fmaxf(v1.z, 0.f); v1.w = fmaxf(v1.w, 0.f); v0 = v0 * v0; v1 = v1 * v1;
                    u32x4 w; w.x = cvtpk(v0.x, v0.y); w.y = cvtpk(v0.z, v0.w); w.z = cvtpk(v1.x, v1.y); w.w = cvtpk(v1.z, v1.w); *(GAS u32x4*)(rp + bj * 128) = w; } }
    }
};
struct EpiBf16NP {
    static constexpr bool PERM = false, AFTER_DRAIN = false; bf16* O; int ldc;
    __device__ __forceinline__ void operator()(const pg8::f32x4 (&acc)[2][2][4][2], const pg8::Unit& u, int wr, int wc, int fr, int fq) const {
        const int row0 = u.pm * 256 + wr * 64 + fr, col0 = u.pn * 256 + wc * 32 + 4 * fq;
#pragma unroll
        for (int ai = 0; ai < 2; ++ai)
#pragma unroll
            for (int m = 0; m < 4; ++m) { GAS bf16* rp = (GAS bf16*)(O + (size_t)(row0 + ai * 128 + m * 16) * ldc + col0);
#pragma unroll
                for (int bj = 0; bj < 2; ++bj)
#pragma unroll
                    for (int n = 0; n < 2; ++n) { const f32x4 v = acc[ai][bj][m][n]; u32x2 w; w.x = cvtpk(v.x, v.y); w.y = cvtpk(v.z, v.w); *(GAS u32x2*)(rp + bj * 128 + n * 16) = w; } }
    }
};
struct EpiGate {
    static constexpr bool PERM = false, AFTER_DRAIN = false; float* X; const bf16* PR;
    __device__ __forceinline__ void operator()(const pg8::f32x4 (&acc)[2][2][4][2], const pg8::Unit& u, int wr, int wc, int fr, int fq) const {
        const int row0 = u.pm * 256 + wr * 64 + fr, col0 = u.pn * 256 + wc * 32 + 4 * fq;
#pragma unroll
        for (int ai = 0; ai < 2; ++ai)
#pragma unroll
            for (int m = 0; m < 4; ++m) { const size_t off = (size_t)(row0 + ai * 128 + m * 16) * DM + col0;
#pragma unroll
                for (int bj = 0; bj < 2; ++bj)
#pragma unroll
                    for (int n = 0; n < 2; ++n) { const f32x4 a = acc[ai][bj][m][n]; const u32x2 prw = *(GAS const u32x2*)(PR + off + bj * 128 + n * 16); f32x4 pr; pr.x = __uint_as_float(prw.x << 16); pr.y = __uint_as_float(prw.x & 0xffff0000u); pr.z = __uint_as_float(prw.y << 16); pr.w = __uint_as_float(prw.y & 0xffff0000u); f32x4 xv = *(GAS const f32x4*)(X + off + bj * 128 + n * 16);
                        xv.x += pr.x / (1.f + __expf(-a.x)); xv.y += pr.y / (1.f + __expf(-a.y)); xv.z += pr.z / (1.f + __expf(-a.z)); xv.w += pr.w / (1.f + __expf(-a.w));
                        *(GAS f32x4*)(X + off + bj * 128 + n * 16) = xv; } }
    }
};
struct EpiSiluMul {
    static constexpr bool PERM = false, AFTER_DRAIN = false; bf16* O; int ldc;
    __device__ __forceinline__ void operator()(const pg8::f32x4 (&acc)[2][2][4][2], const pg8::Unit& u, int wr, int wc, int fr, int fq) const {
        const int row0 = u.pm * 256 + wr * 64 + fr, col0 = u.pn * 256 + wc * 32 + 4 * fq;
#pragma unroll
        for (int ai = 0; ai < 2; ++ai)
#pragma unroll
            for (int m = 0; m < 4; ++m) { GAS bf16* rp = (GAS bf16*)(O + (size_t)(row0 + ai * 128 + m * 16) * ldc + col0);
#pragma unroll
                for (int bj = 0; bj < 2; ++bj)
#pragma unroll
                    for (int n = 0; n < 2; ++n) { const f32x4 a = acc[ai][bj][m][n]; u32x2 w = *(GAS const u32x2*)(rp + bj * 128 + n * 16);
                        const float o0 = __uint_as_float(w.x << 16) * a.x / (1.f + __expf(-a.x)), o1 = __uint_as_float(w.x & 0xffff0000u) * a.y / (1.f + __expf(-a.y));
                        const float o2 = __uint_as_float(w.y << 16) * a.z / (1.f + __expf(-a.z)), o3 = __uint_as_float(w.y & 0xffff0000u) * a.w / (1.f + __expf(-a.w));
                        w.x = cvtpk(o0, o1); w.y = cvtpk(o2, o3); *(GAS u32x2*)(rp + bj * 128 + n * 16) = w; } }
    }
};
struct EpiAttnQKV {
    static constexpr bool PERM = false, AFTER_DRAIN = false; bf16 *Q, *K, *V; const float *rc, *rs; int smask;
    __device__ __forceinline__ void operator()(const pg8::f32x4 (&acc)[2][2][4][2], const pg8::Unit& u, int wr, int wc, int fr, int fq) const {
        const int row0 = u.pm * 256 + wr * 64 + fr, region = u.pn >> 2, colt = (u.pn & 3) * 256;
        if (region == 2) {
            const int col0 = colt + wc * 32 + 4 * fq;
#pragma unroll
            for (int ai = 0; ai < 2; ++ai)
#pragma unroll
                for (int m = 0; m < 4; ++m) { GAS bf16* rp = (GAS bf16*)(V + (size_t)(row0 + ai * 128 + m * 16) * DM + col0);
#pragma unroll
                    for (int bj = 0; bj < 2; ++bj)
#pragma unroll
                        for (int n = 0; n < 2; ++n) { const f32x4 v = acc[ai][bj][m][n]; u32x2 w; w.x = cvtpk(v.x, v.y); w.y = cvtpk(v.z, v.w); *(GAS u32x2*)(rp + bj * 128 + n * 16) = w; } }
        } else {
            bf16* dst = region == 0 ? Q : K; const float sc = region == 0 ? 0.125f * LOG2E : 1.f; const int g = wc & 1, d1 = 16 * g + 4 * fq;
#pragma unroll
            for (int ai = 0; ai < 2; ++ai)
#pragma unroll
                for (int m = 0; m < 4; ++m) { const int row = row0 + ai * 128 + m * 16, s = row & smask;
                    const f32x4 c4 = *(GAS const f32x4*)(rc + s * 32 + d1) * sc, s4 = *(GAS const f32x4*)(rs + s * 32 + d1) * sc;
#pragma unroll
                    for (int bj = 0; bj < 2; ++bj) { const int cb = colt + bj * 128 + (wc >> 1) * 64;
                        const f32x4 x1 = acc[ai][bj][m][0], x2 = acc[ai][bj][m][1]; const f32x4 o1 = x1 * c4 - x2 * s4, o2 = x2 * c4 + x1 * s4;
                        u32x2 w; w.x = cvtpk(o1.x, o1.y); w.y = cvtpk(o1.z, o1.w); *(GAS u32x2*)(dst + (size_t)row * DM + cb + d1) = w;
                        w.x = cvtpk(o2.x, o2.y); w.y = cvtpk(o2.z, o2.w); *(GAS u32x2*)(dst + (size_t)row * DM + cb + d1 + 32) = w; } }
        }
    }
};
struct EpiRetQKV {
    static constexpr bool PERM = false, AFTER_DRAIN = false; bf16 *Q, *K, *V; const float *xc, *xs; int smask;
    __device__ __forceinline__ void operator()(const pg8::f32x4 (&acc)[2][2][4][2], const pg8::Unit& u, int wr, int wc, int fr, int fq) const {
        const int row0 = u.pm * 256 + wr * 64 + fr;
        if (u.pn >= 8) {
            const int col0 = (u.pn - 8) * 256 + wc * 32 + 4 * fq;
#pragma unroll
            for (int ai = 0; ai < 2; ++ai)
#pragma unroll
                for (int m = 0; m < 4; ++m) { GAS bf16* rp = (GAS bf16*)(V + (size_t)(row0 + ai * 128 + m * 16) * 2048 + col0);
#pragma unroll
                    for (int bj = 0; bj < 2; ++bj)
#pragma unroll
                        for (int n = 0; n < 2; ++n) { const f32x4 v = acc[ai][bj][m][n]; u32x2 w; w.x = cvtpk(v.x, v.y); w.y = cvtpk(v.z, v.w); *(GAS u32x2*)(rp + bj * 128 + n * 16) = w; } }
        } else {
            bf16* dst = u.pn < 4 ? Q : K; const float sc = u.pn < 4 ? 1.f : 0.0625f; const int col0 = (u.pn & 3) * 256 + wc * 32 + 4 * fq;
#pragma unroll
            for (int ai = 0; ai < 2; ++ai)
#pragma unroll
                for (int m = 0; m < 4; ++m) { const int row = row0 + ai * 128 + m * 16, s = row & smask;
#pragma unroll
                    for (int bj = 0; bj < 2; ++bj)
#pragma unroll
                        for (int n = 0; n < 2; ++n) { const int col = col0 + bj * 128 + n * 16, pi = (col & 255) >> 1;
                            const f32x2 c2 = *(GAS const f32x2*)(xc + s * 128 + pi) * sc, s2 = *(GAS const f32x2*)(xs + s * 128 + pi) * sc; const f32x4 x = acc[ai][bj][m][n];
                            u32x2 w; w.x = cvtpk(x.x * c2.x - x.y * s2.x, x.y * c2.x + x.x * s2.x); w.y = cvtpk(x.z * c2.y - x.w * s2.y, x.w * c2.y + x.z * s2.y);
                            const size_t qoff = u.pn < 4 ? ((((size_t)(row >> 5) * 4 + (col >> 8)) * 16 + ((col & 255) >> 4)) * 512 + (((col & 255) >> 3) & 1) * 256 + (row & 31) * 8 + (col & 7)) : ((size_t)row * DM + col);
                            *(GAS u32x2*)(dst + qoff) = w; } }
        }
    }
};

__device__ __forceinline__ void attn_phase(LAS unsigned char* lds, const bf16* Q, const bf16* K, const bf16* V, bf16* OB, int S, int nbatch, int vcu, int G, float lam, float oscale, const float* subln, float* o1s, const int wave) {
    lam = __uint_as_float(__builtin_amdgcn_readfirstlane(__float_as_uint(lam))); oscale = __uint_as_float(__builtin_amdgcn_readfirstlane(__float_as_uint(oscale)));
    const int nqb = S / 256, nunits = nbatch * 8 * nqb, per = (nunits + G - 1) / G;
    constexpr int KSTR = 144, VSTR = 320, KBYTES = 64 * KSTR, VBYTES = 64 * VSTR, VBASE = 3 * KBYTES, QBASE = VBASE + 4 * VBYTES;

    for (int it = 0; it < per; ++it) {
    int tid_l = tid_of(wave); asm volatile("" : "+v"(tid_l));
    const int tid = tid_l, lane = tid & 63, w = __builtin_amdgcn_readfirstlane(tid >> 6), l31 = lane & 31, hh = lane >> 5;
    const int krow = tid >> 3, kch = tid & 7, vrow0 = tid >> 4, vch = tid & 15;
    const int i15 = lane & 15, qq = i15 >> 2, pp = i15 & 3;
    const int vtr_off = (4 * hh + qq) * VSTR + (16 * ((lane >> 4) & 1) + 4 * pp) * 2;
    const int kfr_off = l31 * KSTR + hh * 16;
    const int kst_off = krow * KSTR + kch * 16, vst_off0 = vrow0 * VSTR + vch * 16, vst_off1 = (vrow0 + 32) * VSTR + vch * 16;
        const int u = vcu * per + it; if (u >= nunits) break;
        const int qb = u % nqb, bh = u / nqb, h = bh & 7, b = bh >> 3;
        const size_t rowbase = (size_t)b * S; const int q0 = qb * 256 + w * 32;
#pragma unroll 1
        for (int c = 0; c < 2; ++c) {
            const bf16* Kg = K + rowbase * DM + h * 128 + c * 64; const bf16* Vg = V + rowbase * DM + h * 128;
            size_t koff = (size_t)krow * DM + kch * 8, voff0 = (size_t)vrow0 * DM + vch * 8; asm volatile("" : "+v"(koff), "+v"(voff0)); const size_t voff1 = voff0 + 32 * DM;
            bf16x8 qf[4];
#pragma unroll
            for (int ds = 0; ds < 4; ++ds) qf[ds] = *(GAS const bf16x8*)(Q + (rowbase + q0 + l31) * DM + h * 128 + c * 64 + ds * 16 + hh * 8);
            LAS unsigned char* qst_ = lds + QBASE + w * (32 * KSTR) + l31 * KSTR + hh * 16;
            const int NT = S / 64;
            __syncthreads();
            {   const u32x4 kr = *(GAS const u32x4*)(Kg + koff), kr1 = *(GAS const u32x4*)(Kg + koff + 64 * DM);
                *(LAS u32x4*)(lds + kst_off) = kr; *(LAS u32x4*)(lds + KBYTES + kst_off) = kr1; }
            asm volatile("" ::: "memory");
            {   const u32x4 vr0 = *(GAS const u32x4*)(Vg + voff0), vr1 = *(GAS const u32x4*)(Vg + voff1);
                *(LAS u32x4*)(lds + VBASE + vst_off0) = vr0; *(LAS u32x4*)(lds + VBASE + vst_off1) = vr1; }
            asm volatile("" ::: "memory");
            {   const u32x4 vr2 = *(GAS const u32x4*)(Vg + voff0 + 64 * DM), vr3 = *(GAS const u32x4*)(Vg + voff1 + 64 * DM);
                *(LAS u32x4*)(lds + VBASE + VBYTES + vst_off0) = vr2; *(LAS u32x4*)(lds + VBASE + VBYTES + vst_off1) = vr3;
                unsigned z0_ = 0u; asm volatile("" : "+v"(z0_)); const u32x4 zz = {z0_, z0_, z0_, z0_}; *(LAS u32x4*)(lds + VBASE + 3 * VBYTES + vst_off0) = zz; *(LAS u32x4*)(lds + VBASE + 3 * VBYTES + vst_off1) = zz; }
            __syncthreads();
            f32x16 o[4]; float zf_ = 0.f; asm volatile("" : "+v"(zf_));
#pragma unroll
            for (int d0 = 0; d0 < 4; ++d0)
#pragma unroll
                for (int r = 0; r < 16; ++r) o[d0][r] = zf_;
            float lrun = 0.f, alpha_prev = 1.f;
            f32x16 s0, s1;
#pragma unroll
            for (int ds = 0; ds < 4; ++ds) *(LAS bf16x8*)(qst_ + ds * 32) = qf[ds];
            bf16x8 pfp[4];
#pragma unroll
            for (int k4 = 0; k4 < 4; ++k4) pfp[k4] = (bf16x8){0, 0, 0, 0, 0, 0, 0, 0};
            float mref = -1e30f; f32x16 negm;
#pragma unroll
            for (int r = 0; r < 16; ++r) negm[r] = zf_;
            bool first = true;
            int ks_cur = 0, ks_stage = 2 * KBYTES;
            u32x4 krA, vA0, vA1;
#define ATT_ITER(T_, KW_, V0W_, V1W_, KL_, V0L_, V1L_) do { \
                if (__any(alpha_prev != 1.f)) { \
                _Pragma("unroll") \
                    for (int d0 = 0; d0 < 4; ++d0) \
                _Pragma("unroll") \
                        for (int r = 0; r < 16; ++r) o[d0][r] *= alpha_prev; } \
                { const int tk = (T_ + 2 < NT) ? T_ + 2 : NT - 1, tv = (T_ + 2 < NT) ? T_ + 2 : NT - 1; \
                  KL_ = *(GAS const u32x4*)(Kg + koff + (size_t)tk * 64 * DM); \
                  V0L_ = *(GAS const u32x4*)(Vg + voff0 + (size_t)tv * 64 * DM); V1L_ = *(GAS const u32x4*)(Vg + voff1 + (size_t)tv * 64 * DM); } \
                { LAS unsigned char* kb_ = lds + ks_cur + kfr_off; LAS unsigned char* vb_ = lds + VBASE + ((T_ + 3) & 3) * VBYTES + vtr_off; \
                  bf16x8 kfr[8], vfr[16], qfl[4]; \
                  qfl[0] = *(LAS bf16x8*)(qst_); \
                  kfr[0] = *(LAS bf16x8*)(kb_); kfr[1] = *(LAS bf16x8*)(kb_ + 32 * KSTR); \
                _Pragma("unroll") \
                  for (int i_ = 0; i_ < 8; ++i_) { \
                      if (i_ + 2 < 8) { kfr[i_ + 2] = *(LAS bf16x8*)(kb_ + ((i_ + 2) & 1) * 32 * KSTR + ((i_ + 2) >> 1) * 32); if (!(i_ & 1)) qfl[(i_ + 2) >> 1] = *(LAS bf16x8*)(qst_ + ((i_ + 2) >> 1) * 32); } \
                      else { const int v_ = i_ - 6; vfr[v_] = cat8(trr(vb_ + (16 * (v_ >> 2)) * VSTR + (v_ & 3) * 64), trr(vb_ + (16 * (v_ >> 2) + 8) * VSTR + (v_ & 3) * 64)); } \
                      __builtin_amdgcn_sched_barrier(0); \
                      if (i_ & 1) s1 = MFMA32(kfr[i_], qfl[i_ >> 1], i_ == 1 ? negm : s1); else s0 = MFMA32(kfr[i_], qfl[i_ >> 1], i_ == 0 ? negm : s0); \
                      __builtin_amdgcn_sched_barrier(0); } \
                  float mxa, mxb, rm, delta = 0.f, alpha = 1.f; f32x2 ps2 = {0.f, 0.f}; \
                _Pragma("unroll") \
                  for (int i_ = 0; i_ < 16; ++i_) { \
                      if (i_ + 2 < 16) { const int v_ = i_ + 2; vfr[v_] = cat8(trr(vb_ + (16 * (v_ >> 2)) * VSTR + (v_ & 3) * 64), trr(vb_ + (16 * (v_ >> 2) + 8) * VSTR + (v_ & 3) * 64)); } \
                      __builtin_amdgcn_sched_barrier(0); \
                      o[i_ & 3] = MFMA32(vfr[i_], pfp[i_ >> 2], o[i_ & 3]); \
                        \
                      if (i_ == 0) { mxa = max3f(s0[0], s0[1], s1[0]); mxb = max3f(s0[2], s0[3], s1[1]); mxa = max3f(mxa, s1[2], s1[3]); } \
                      if (i_ >= 1 && i_ <= 3) { const int r = 4 * i_; mxa = max3f(mxa, s0[r], s0[r + 1]); mxb = max3f(mxb, s0[r + 2], s0[r + 3]); mxa = max3f(mxa, s1[r], s1[r + 1]); mxb = max3f(mxb, s1[r + 2], s1[r + 3]); } \
                      if (i_ == 3) { rm = max3f(mxa, mxb, mxa); rm = max3f(rm, shx(rm, 32, lane), rm); } \
                      if (i_ == 4) { \
                          if (first || __any(rm > ATT_THR)) { delta = first ? rm : max3f(rm, 0.f, 0.f); const f32x2 mm2 = {delta, delta}; \
                              _Pragma("unroll") \
                              for (int r = 0; r < 16; r += 2) { const f32x2 a_ = (f32x2){s0[r], s0[r + 1]} - mm2, b_ = (f32x2){s1[r], s1[r + 1]} - mm2; s0[r] = a_.x; s0[r + 1] = a_.y; s1[r] = b_.x; s1[r + 1] = b_.y; } \
                              alpha = first ? 1.f : ex2(-delta); mref = first ? delta : mref + delta; first = false; \
                              _Pragma("unroll") \
                              for (int r = 0; r < 16; ++r) negm[r] = -mref; } } \
                      if (i_ >= 5) { const int e0 = (i_ - 5) * 3; \
                          _Pragma("unroll") \
                          for (int e_ = e0; e_ < e0 + 3 && e_ < 32; ++e_) { if (e_ < 16) s0[e_] = ex2(s0[e_]); else s1[e_ - 16] = ex2(s1[e_ - 16]); } } \
                      __builtin_amdgcn_sched_barrier(0); } \
                    \
                _Pragma("unroll") \
                  for (int r = 0; r < 16; r += 2) ps2 += (f32x2){s0[r], s0[r + 1]} + (f32x2){s1[r], s1[r + 1]}; \
                  lrun = lrun * alpha + (ps2.x + ps2.y); alpha_prev = alpha; \
                  pfp[0] = pack8(s0, 0); pfp[1] = pack8(s0, 8); pfp[2] = pack8(s1, 0); pfp[3] = pack8(s1, 8); } \
                { LAS unsigned char* vd_ = lds + VBASE + ((T_ + 2) & 3) * VBYTES; \
                  *(LAS u32x4*)(lds + ks_stage + kst_off) = KW_; *(LAS u32x4*)(vd_ + vst_off0) = V0W_; *(LAS u32x4*)(vd_ + vst_off1) = V1W_; } \
                LBAR(); \
                ks_cur = (ks_cur == 2 * KBYTES) ? 0 : ks_cur + KBYTES; ks_stage = (ks_stage == 2 * KBYTES) ? 0 : ks_stage + KBYTES; \
            } while (0)
            for (int t = 0; t < NT; t += 2) { ATT_ITER(t, krA, vA0, vA1, krA, vA0, vA1); ATT_ITER(t + 1, krA, vA0, vA1, krA, vA0, vA1); }
#undef ATT_ITER
            {
#pragma unroll
                for (int d0 = 0; d0 < 4; ++d0)
#pragma unroll
                    for (int r = 0; r < 16; ++r) o[d0][r] *= alpha_prev;
                LAS unsigned char* vb_ = lds + VBASE + ((NT - 1) & 3) * VBYTES + vtr_off;
#pragma unroll
                for (int ks = 0; ks < 4; ++ks)
#pragma unroll
                    for (int d0 = 0; d0 < 4; ++d0) { LAS unsigned char* vp = vb_ + (16 * ks) * VSTR + d0 * 64;
                        const bf16x8 vf = cat8(trr(vp), trr(vp + 8 * VSTR)); o[d0] = MFMA32(vf, pfp[ks], o[d0]); } }
            lrun += shx(lrun, 32, lane);
            const float inv = 1.f / lrun;
            GAS float* o1p = (GAS float*)(o1s + tid); asm volatile("" : "+v"(o1p));
            if (c == 0) {
#pragma unroll
                for (int d0 = 0; d0 < 4; ++d0)
#pragma unroll
                    for (int r = 0; r < 16; ++r) o1p[(d0 * 16 + r) * 512] = o[d0][r] * inv;
            } else {
                float ss = 0.f;
#pragma unroll
                for (int d0 = 0; d0 < 4; ++d0)
#pragma unroll
                    for (int r = 0; r < 16; ++r) { const float v = o1p[(d0 * 16 + r) * 512] - lam * (o[d0][r] * inv); o[d0][r] = v; ss += v * v; }
                ss += shx(ss, 32, lane);
                const float rstd = rsqrtf(ss * (1.f / 128.f) + 1e-5f) * oscale;
                GAS bf16* orow = (GAS bf16*)(OB + (rowbase + q0 + l31) * DM + h * 128); asm volatile("" : "+v"(orow));
#pragma unroll
                for (int d0 = 0; d0 < 4; ++d0)
#pragma unroll
                    for (int rg = 0; rg < 4; ++rg) { const int d = 32 * d0 + 8 * rg + 4 * hh; const f32x4 w4 = *(GAS const f32x4*)(subln + d);
                        u32x2 wv; wv.x = cvtpk(o[d0][4 * rg] * rstd * w4.x, o[d0][4 * rg + 1] * rstd * w4.y); wv.y = cvtpk(o[d0][4 * rg + 2] * rstd * w4.z, o[d0][4 * rg + 3] * rstd * w4.w);
                        *(GAS u32x2*)(orow + d) = wv; }
            }
        }
    }
}

__device__ __forceinline__ void scan_phase(LAS unsigned char* lds, const bf16* Q, const bf16* K, const bf16* V, bf16* OF, bf16* OBK, int S, int nbatch, int vcu, int G, const float* decay, const int wave) {
    const int n = S / 128, nunits = nbatch * 64, per = (nunits + G - 1) / G;
    constexpr int KSTR = 576, VSTR = 192, RSTR = 528, KT = 0, VT = 128 * KSTR, RT = VT + 128 * VSTR;
    for (int it = 0; it < per; ++it) {
    int tid_l = tid_of(wave); asm volatile("" : "+v"(tid_l));
    const int tid = tid_l, lane = tid & 63, w = __builtin_amdgcn_readfirstlane(tid >> 6), l31 = lane & 31, hh = lane >> 5;
    const int i15 = lane & 15, qq = i15 >> 2, pp = i15 & 3, cg16 = 16 * ((lane >> 4) & 1) + 4 * pp;
    const int tb = w >> 1, nbk = w & 1;
        const int u = vcu * per + it; if (u >= nunits) break;
        const int dir = u & 1, j = (u >> 1) & 7, h = (u >> 4) & 3, b = u >> 6;
        const float lg2 = -__expf(((GAS const float*)decay)[dir * 4 + h]) * LOG2E;
        const float cd = ex2(lg2 * 128.f);
        bf16* OD = dir ? OBK : OF;
        f32x16 racc[2];
#pragma unroll
        for (int r = 0; r < 16; ++r) { racc[0][r] = 0.f; racc[1][r] = 0.f; }
        u32x4 kreg[8], vreg[2];
        { const int c = dir ? n - 1 : 0; const size_t rowb = (size_t)b * S + (size_t)c * 128;
#pragma unroll
          for (int ii = 0; ii < 8; ++ii) { const int idx = tid + 512 * ii, row = idx >> 5, ch = idx & 31; kreg[ii] = *(GAS const u32x4*)(K + (rowb + row) * DM + h * 256 + ch * 8); }
#pragma unroll
          for (int ii = 0; ii < 2; ++ii) { const int idx = tid + 512 * ii, row = idx >> 3, ch = idx & 7; vreg[ii] = *(GAS const u32x4*)(V + (rowb + row) * 2048 + h * 512 + j * 64 + ch * 8); } }
        bf16x8 qfr[8];
        { const int c = dir ? n - 1 : 0; GAS const bf16* qp = (GAS const bf16*)(Q + ((((size_t)b * S + (size_t)c * 128 + 32 * tb) >> 5) * 4 + h) * 8192 + hh * 256 + l31 * 8);
#pragma unroll
          for (int ks = 0; ks < 8; ++ks) qfr[ks] = *(GAS const bf16x8*)(qp + 512 * ks); }
        __syncthreads();
        for (int step = 0; step < n; ++step) {
            const int c = dir ? n - 1 - step : step; const size_t rowb = (size_t)b * S + (size_t)c * 128;
            bf16x8 qlate[8];
            { GAS const bf16* qp = (GAS const bf16*)(Q + (((rowb + 32 * tb) >> 5) * 4 + h) * 8192 + hh * 256 + l31 * 8);
#pragma unroll
              for (int ks = 0; ks < 8; ++ks) qlate[ks] = *(GAS const bf16x8*)(qp + 512 * (8 + ks)); }
            asm volatile("" ::: "memory");
#pragma unroll
            for (int ii = 0; ii < 8; ++ii) { const int idx = tid + 512 * ii, row = idx >> 5, ch = idx & 31; *(LAS u32x4*)(lds + KT + row * KSTR + ch * 16) = kreg[ii]; }
#pragma unroll
            for (int ii = 0; ii < 2; ++ii) { const int idx = tid + 512 * ii, row = idx >> 3, ch = idx & 7;
                const float z = ex2(lg2 * (float)(dir ? row : 127 - row)); const u32x4 v = vreg[ii]; u32x4 o;
                o.x = cvtpk(__uint_as_float(v.x << 16) * z, __uint_as_float(v.x & 0xffff0000u) * z); o.y = cvtpk(__uint_as_float(v.y << 16) * z, __uint_as_float(v.y & 0xffff0000u) * z);
                o.z = cvtpk(__uint_as_float(v.z << 16) * z, __uint_as_float(v.z & 0xffff0000u) * z); o.w = cvtpk(__uint_as_float(v.w << 16) * z, __uint_as_float(v.w & 0xffff0000u) * z);
                *(LAS u32x4*)(lds + VT + row * VSTR + ch * 16) = o; }
#pragma unroll
            for (int nb2 = 0; nb2 < 2; ++nb2)
#pragma unroll
                for (int rg = 0; rg < 4; ++rg) { u32x2 wv; wv.x = cvtpk(racc[nb2][4 * rg], racc[nb2][4 * rg + 1]); wv.y = cvtpk(racc[nb2][4 * rg + 2], racc[nb2][4 * rg + 3]);
                    *(LAS u32x2*)(lds + RT + (32 * nb2 + l31) * RSTR + (32 * w + 8 * rg + 4 * hh) * 2) = wv; }
            LBAR();
            if (step + 1 < n) { const int c2 = dir ? c - 1 : c + 1; const size_t rb2 = (size_t)b * S + (size_t)c2 * 128;
#pragma unroll
                for (int ii = 0; ii < 8; ++ii) { const int idx = tid + 512 * ii, row = idx >> 5, ch = idx & 31; kreg[ii] = *(GAS const u32x4*)(K + (rb2 + row) * DM + h * 256 + ch * 8); }
#pragma unroll
                for (int ii = 0; ii < 2; ++ii) { const int idx = tid + 512 * ii, row = idx >> 3, ch = idx & 7; vreg[ii] = *(GAS const u32x4*)(V + (rb2 + row) * 2048 + h * 512 + j * 64 + ch * 8); } }
            { f32x16 acc;
#pragma unroll
              for (int r = 0; r < 16; ++r) acc[r] = 0.f;
              LAS unsigned char* rp = lds + RT + (32 * nbk + l31) * RSTR + 16 * hh;
#pragma unroll
              for (int ks = 0; ks < 8; ++ks) { const bf16x8 bfr = *(LAS bf16x8*)(rp + 32 * ks); acc = MFMA32(bfr, qfr[ks], acc); }
#pragma unroll
              for (int ks = 0; ks < 8; ++ks) { const bf16x8 bfr = *(LAS bf16x8*)(rp + 32 * (8 + ks)); acc = MFMA32(bfr, qlate[ks], acc); }
              if (step + 1 < n) { const int c2 = dir ? c - 1 : c + 1; GAS const bf16* qp = (GAS const bf16*)(Q + ((((size_t)b * S + (size_t)c2 * 128 + 32 * tb) >> 5) * 4 + h) * 8192 + hh * 256 + l31 * 8);
#pragma unroll
                  for (int ks = 0; ks < 8; ++ks) qfr[ks] = *(GAS const bf16x8*)(qp + 512 * ks); }
              const int tok = 32 * tb + l31; const float xi = ex2(lg2 * (float)(dir ? 128 - tok : tok + 1));
              GAS bf16* op = (GAS bf16*)(OD + (rowb + 16 * j + 8 * nbk + hh) * 2048 + h * 512 + tok * 4);
#pragma unroll
              for (int rg = 0; rg < 4; ++rg) { u32x2 wv; wv.x = cvtpk(acc[4 * rg] * xi, acc[4 * rg + 1] * xi); wv.y = cvtpk(acc[4 * rg + 2] * xi, acc[4 * rg + 3] * xi); *(GAS u32x2*)(op + (size_t)(2 * rg) * 2048) = wv; } }
#pragma unroll
            for (int r = 0; r < 16; ++r) { racc[0][r] *= cd; racc[1][r] *= cd; }
#pragma unroll
            for (int ks = 0; ks < 8; ++ks) { const int row = 16 * ks + 8 * hh + qq;
                LAS unsigned char* kp = lds + KT + row * KSTR + (32 * w + cg16) * 2; const bf16x8 af = cat8(trr(kp), trr(kp + 4 * KSTR));
                LAS unsigned char* vp = lds + VT + row * VSTR + cg16 * 2; const bf16x8 b0 = cat8(trr(vp), trr(vp + 4 * VSTR)), b1 = cat8(trr(vp + 64), trr(vp + 64 + 4 * VSTR));
                racc[0] = MFMA32(af, b0, racc[0]); racc[1] = MFMA32(af, b1, racc[1]); }
            LBAR();
        }
    }
}

__device__ __forceinline__ void intra_phase(LAS unsigned char* lds, const bf16* Q, const bf16* K, const bf16* V, bf16* OF, const bf16* OBK, int S, int nbatch, int vcu, int G, const float* decay, const int wave, const bool do_store = true) {
    const int n = S / 128, nunits = nbatch * 4 * n, per = (nunits + G - 1) / G;
    constexpr int KSTR = 528, VSTR = 320, KT = 0, VT = 128 * KSTR, SSB = VT + 128 * VSTR;
    for (int it = 0; it < per; ++it) {
    int tid_l = tid_of(wave); asm volatile("" : "+v"(tid_l));
    const int tid = tid_l, lane = tid & 63, w = __builtin_amdgcn_readfirstlane(tid >> 6), l31 = lane & 31, hh = lane >> 5;
    const int i15 = lane & 15, qq = i15 >> 2, pp = i15 & 3, cg16 = 16 * ((lane >> 4) & 1) + 4 * pp;
    const int qb = w >> 1, par = w & 1;
        const int u = vcu * per + it; if (u >= nunits) break;
        const int c = u % n, bh = u / n, h = bh & 3, b = bh >> 2;
        const float lgf2 = -__expf(((GAS const float*)decay)[h]) * LOG2E, lgb2 = -__expf(((GAS const float*)decay)[4 + h]) * LOG2E;
        const size_t rowb = (size_t)b * S + (size_t)c * 128;
        __syncthreads();
#pragma unroll
        for (int ii = 0; ii < 8; ++ii) { const int idx = tid + 512 * ii, row = idx >> 5, ch = idx & 31; *(LAS u32x4*)(lds + KT + row * KSTR + ch * 16) = *(GAS const u32x4*)(K + (rowb + row) * DM + h * 256 + ch * 8); }
        u32x4 vreg[4];
#pragma unroll
        for (int ii = 0; ii < 4; ++ii) { const int idx = tid + 512 * ii, row = idx >> 4, ch = idx & 15; vreg[ii] = *(GAS const u32x4*)(V + (rowb + row) * 2048 + h * 512 + ch * 8); }
        __syncthreads();
        bf16x8 pf[8];
        { f32x16 X[4];
#pragma unroll
          for (int k4 = 0; k4 < 4; ++k4)
#pragma unroll
              for (int r = 0; r < 16; ++r) X[k4][r] = 0.f;
          GAS const bf16* qp = (GAS const bf16*)(Q + (((rowb + 32 * qb) >> 5) * 4 + h) * 8192 + hh * 256 + l31 * 8); LAS unsigned char* kp = lds + KT + l31 * KSTR + 16 * hh;
#pragma unroll
          for (int ks = 0; ks < 16; ++ks) { const bf16x8 bq = *(GAS const bf16x8*)(qp + 512 * ks);
#pragma unroll
              for (int k4 = 0; k4 < 4; ++k4) { const bf16x8 a = *(LAS bf16x8*)(kp + 32 * k4 * KSTR + 32 * ks); X[k4] = MFMA32(a, bq, X[k4]); } }
          const int iq = 32 * qb + l31;
#pragma unroll
          for (int k4 = 0; k4 < 4; ++k4) {
#pragma unroll
              for (int r = 0; r < 16; ++r) { const int d = iq - (32 * k4 + crow(r, hh)); X[k4][r] *= ex2(d >= 0 ? lgf2 * (float)d : -lgb2 * (float)d); }
              pf[2 * k4] = pack8(X[k4], 0); pf[2 * k4 + 1] = pack8(X[k4], 8); } }
        f32x16 z[8];
#pragma unroll
        for (int t = 0; t < 8; ++t)
#pragma unroll
            for (int r = 0; r < 16; ++r) z[t][r] = 0.f;
#pragma unroll
        for (int p = 0; p < 4; ++p) {
#pragma unroll
            for (int ii = 0; ii < 4; ++ii) { const int idx = tid + 512 * ii, row = idx >> 4, ch = idx & 15; *(LAS u32x4*)(lds + VT + row * VSTR + ch * 16) = vreg[ii]; }
            LBAR();
            if (p < 3) {
#pragma unroll
                for (int ii = 0; ii < 4; ++ii) { const int idx = tid + 512 * ii, row = idx >> 4, ch = idx & 15; vreg[ii] = *(GAS const u32x4*)(V + (rowb + row) * 2048 + h * 512 + (p + 1) * 128 + ch * 8); } }
#pragma unroll
            for (int bi = 0; bi < 2; ++bi) { const int blk = 2 * bi + par;
#pragma unroll
                for (int ks = 0; ks < 8; ++ks) { LAS unsigned char* vp = lds + VT + (16 * ks + 4 * hh + qq) * VSTR + (32 * blk + cg16) * 2;
                    const bf16x8 vf = cat8(trr(vp), trr(vp + 8 * VSTR)); z[2 * p + bi] = MFMA32(vf, pf[ks], z[2 * p + bi]); } }
            LBAR();
        }
        size_t ebase = (rowb + 32 * qb + l31) * 2048 + h * 512 + 32 * par + 4 * hh; asm volatile("" : "+v"(ebase));
        size_t xbase = (rowb + 8 * par + hh) * 2048 + h * 512 + (32 * qb + l31) * 4; asm volatile("" : "+v"(xbase));
        float ssq = 0.f;
#pragma unroll
        for (int t = 0; t < 8; ++t) { const int co = 128 * (t >> 1) + 64 * (t & 1);
#pragma unroll
            for (int rg = 0; rg < 4; ++rg) { const size_t xo_ = xbase + (size_t)((co >> 2) + 2 * rg) * 2048; const u32x2 a_ = *(GAS const u32x2*)(OF + xo_), b_ = *(GAS const u32x2*)(OBK + xo_);
                z[t][4 * rg] += __uint_as_float(a_.x << 16) + __uint_as_float(b_.x << 16); z[t][4 * rg + 1] += __uint_as_float(a_.x & 0xffff0000u) + __uint_as_float(b_.x & 0xffff0000u);
                z[t][4 * rg + 2] += __uint_as_float(a_.y << 16) + __uint_as_float(b_.y << 16); z[t][4 * rg + 3] += __uint_as_float(a_.y & 0xffff0000u) + __uint_as_float(b_.y & 0xffff0000u);
                ssq += z[t][4 * rg] * z[t][4 * rg] + z[t][4 * rg + 1] * z[t][4 * rg + 1] + z[t][4 * rg + 2] * z[t][4 * rg + 2] + z[t][4 * rg + 3] * z[t][4 * rg + 3]; }
            asm volatile("" ::: "memory"); }
        ssq += shx(ssq, 32, lane);
        LAS float* ssb = (LAS float*)(lds + SSB);
        if (hh == 0) ssb[w * 32 + l31] = ssq;
        __syncthreads();
        const float rstd = rsqrtf((ssq + ssb[(w ^ 1) * 32 + l31]) * (1.f / 512.f) + 1e-6f);
        asm volatile("" : "+v"(ebase));
#pragma unroll
        for (int t = 0; t < 8; ++t) { const int co = 128 * (t >> 1) + 64 * (t & 1);
#pragma unroll
            for (int rg = 0; rg < 4; ++rg) { u32x2 wv; wv.x = cvtpk(z[t][4 * rg] * rstd, z[t][4 * rg + 1] * rstd); wv.y = cvtpk(z[t][4 * rg + 2] * rstd, z[t][4 * rg + 3] * rstd); if (do_store) *(GAS u32x2*)(OF + ebase + co + 8 * rg) = wv; }
            asm volatile("" ::: "memory"); }
    }
}

#define XB_TMO      128
#define XB_XCNT(j)  (256  + 64 * (j))
#define XB_XSUB(j)  (1280 + 64 * (j))
#define XB_XGEN(j)  (2304 + 64 * (j))
#define XB_TOP      3328
#define XB_TOPGEN   3392
#define XCD_BAR_WORDS 3456
#define XB_SPIN_CAP (1u << 18)

__device__ __forceinline__ unsigned xb_ld(unsigned* p)              { return __hip_atomic_load(p, __ATOMIC_RELAXED, __HIP_MEMORY_SCOPE_AGENT); }
__device__ __forceinline__ unsigned xb_add(unsigned* p, unsigned v) { return __hip_atomic_fetch_add(p, v, __ATOMIC_RELAXED, __HIP_MEMORY_SCOPE_AGENT); }
__device__ __forceinline__ unsigned xb_xcc_id() { return (unsigned)__builtin_amdgcn_s_getreg((3 << 11) | 20) & 0xFu; }
#define XB_SPIN(cond, bar) do { unsigned _sp = 0; while (cond) { __builtin_amdgcn_s_sleep(1); \
    if ((++_sp & 255u) == 0u) { if (xb_ld(&(bar)[XB_TMO])) break; if (_sp > XB_SPIN_CAP) { atomicAdd(&(bar)[XB_TMO], 1u); break; } } } } while (0)

struct XcdBarrier {
    unsigned* bar; unsigned x;
    volatile LAS unsigned* st;
};

__device__ __forceinline__ XcdBarrier xcd_barrier_post(unsigned* bar, volatile LAS unsigned* st, const bool tid0) {
    XcdBarrier b; b.bar = bar; b.x = xb_xcc_id(); b.st = st;
    if (tid0) (void)xb_add(&bar[XB_XCNT(b.x)], 1u);
    return b;
}
__device__ __forceinline__ void xcd_barrier_complete(unsigned* bar, unsigned x, unsigned& nloc, unsigned& nx) {
    const unsigned G = gridDim.x * gridDim.y * gridDim.z;
    unsigned sum, cnt, mine, sp = 0u;
    for (;;) {
        sum = 0u; cnt = 0u; mine = 0u;
#pragma unroll
        for (unsigned j = 0; j < 16; ++j) { const unsigned c = xb_ld(&bar[XB_XCNT(j)]); sum += c; cnt += (c > 0u) ? 1u : 0u; mine = (j == x) ? c : mine; }
        if (sum == G) break;
        __builtin_amdgcn_s_sleep(1);
        if ((++sp & 255u) == 0u) { if (xb_ld(&bar[XB_TMO])) break; if (sp > XB_SPIN_CAP) { atomicAdd(&bar[XB_TMO], 1u); break; } }
    }
    nloc = mine > 0u ? mine : 1u; nx = cnt > 0u ? cnt : 1u;
}

__device__ __forceinline__ void xcd_barrier(const XcdBarrier& b, const bool tid0) {
    asm volatile("s_waitcnt vmcnt(0)" ::: "memory");
    __syncthreads();
    if (tid0) {
        unsigned* bar = b.bar;
        __builtin_amdgcn_s_waitcnt(0);
        unsigned nloc = b.st[0], nx = b.st[1];
        if (nloc == 0u) { xcd_barrier_complete(bar, b.x, nloc, nx); b.st[0] = nloc; b.st[1] = nx; }
        const unsigned old = xb_add(&bar[XB_XSUB(b.x)], 1u);
        const unsigned gen = old / nloc;
        if (old + 1u == (gen + 1u) * nloc) {
            __builtin_amdgcn_fence(__ATOMIC_RELEASE, "agent");
            asm volatile("s_waitcnt vmcnt(0)" ::: "memory");
            const unsigned og = xb_add(&bar[XB_TOP], 1u);
            const unsigned tg = og / nx;
            if (og + 1u == (tg + 1u) * nx) xb_add(&bar[XB_TOPGEN], 1u);
            else XB_SPIN(xb_ld(&bar[XB_TOPGEN]) == tg, bar);
            __builtin_amdgcn_fence(__ATOMIC_ACQUIRE, "agent");
            xb_add(&bar[XB_XGEN(b.x)], 1u);
            asm volatile("s_waitcnt vmcnt(0)" ::: "memory");
        } else {
            XB_SPIN(xb_ld(&bar[XB_XGEN(b.x)]) == gen, bar);
            __builtin_amdgcn_fence(__ATOMIC_ACQUIRE, "agent");
            asm volatile("s_waitcnt vmcnt(0)" ::: "memory");
        }
    }
    __syncthreads();
}

__device__ __forceinline__ void gbar(unsigned* ctr, unsigned target, const int wave) {
    asm volatile("s_waitcnt vmcnt(0)" ::: "memory");
    __syncthreads();
    int t_ = tid_of(wave); asm volatile("" : "+v"(t_));
    if (t_ == 0) {
        __builtin_amdgcn_fence(__ATOMIC_RELEASE, "agent");
        asm volatile("s_waitcnt vmcnt(0) lgkmcnt(0)" ::: "memory");
        __hip_atomic_fetch_add(ctr, 1u, __ATOMIC_RELAXED, __HIP_MEMORY_SCOPE_AGENT);
        while (__hip_atomic_load(ctr, __ATOMIC_RELAXED, __HIP_MEMORY_SCOPE_AGENT) < target) __builtin_amdgcn_s_sleep(2);
        __builtin_amdgcn_fence(__ATOMIC_ACQUIRE, "agent");
        asm volatile("s_waitcnt vmcnt(0) lgkmcnt(0)" ::: "memory");
    }
    __syncthreads();
}
#define GSYNC() do { nsync += (unsigned)Gn; gbar(gctr, nsync, wave); } while (0)

#define GEMM_CALL(EPI_T, A_, B_, M_, N_, K_, E_) do { pg8::Gemm g_{(const pg8::bf16_t*)(A_), (const pg8::bf16_t*)(B_), (M_), (N_), (K_)}; pg8::StaticOrder S_; S_.init((M_), (N_), Gn, (int)blockIdx.x); \
    pg8::gemm_phase<EPI_T, pg8::StaticOrder, true, true>(lds, g_, S_, (E_), wave); } while (0)

#ifdef DBG
__device__ __forceinline__ void dbg_acc(unsigned char* ws, int id, float err2, float ref2, int lane) { if (lane == 0) { atomicAdd((float*)(ws + WS_CTL + 1024) + 2 * id, err2); atomicAdd((float*)(ws + WS_CTL + 1024) + 2 * id + 1, ref2); } }
__device__ __forceinline__ float wsum_d(float v) { for (int o = 1; o < 64; o <<= 1) v += __shfl_xor(v, o); return v; }
__device__ __forceinline__ float dbg_dot(const bf16* arow, const float* W, int K, int N, int col, int lane) { float a = 0.f; for (int k = lane; k < K; k += 64) a += bf2f(arow[k]) * W[(size_t)k * N + col]; return wsum_d(a); }
__device__ __forceinline__ void dbg_gemm(unsigned char* ws, int id, const bf16* A, const float* W, int K, int N, const void* O, int ldo, int mode, int gwv, int lane) {
    if (gwv >= 256) return;
    const int row = (gwv * 2731 + 17) % TG, col = (gwv * 977 + 5) % N;
    float ref = dbg_dot(A + (size_t)row * K, W, K, N, col, lane), got;
    if (mode == 0) got = ((const float*)O)[(size_t)row * ldo + col]; else if (mode == 2) got = bf2f(((const bf16*)O)[(size_t)row * ldo + col]); else { ref = fmaxf(ref, 0.f); ref *= ref; got = bf2f(((const bf16*)O)[(size_t)row * ldo + col]); }
    dbg_acc(ws, id, (got - ref) * (got - ref), ref * ref, lane);
}
__device__ __forceinline__ void dbg_attn_qkv(unsigned char* ws, int id, const bf16* A, const float* W, const bf16* Qb, const bf16* Kb, const bf16* Vb, int S, int gwv, int lane) {
    if (gwv >= 256) return;
    const int row = (gwv * 2731 + 17) % TG, col = (gwv * 1549 + 3) % 3072, region = col >> 10, cr = col & 1023, d = cr & 63, s = row % S;
    float x = dbg_dot(A + (size_t)row * 1024, W, 1024, 3072, col, lane), ref, got;
    if (region == 2) { ref = x; got = bf2f(Vb[(size_t)row * 1024 + cr]); }
    else { const int pc = d < 32 ? col + 32 : col - 32; const float xp = dbg_dot(A + (size_t)row * 1024, W, 1024, 3072, pc, lane);
        const float inv = ex2(-13.287712379549449f * (float)(2 * (d & 31)) / 64.0f); const double ad = (double)((float)s * inv); const float ang = (float)(ad - 6.283185307179586 * floor(ad / 6.283185307179586)); const float rot = d < 32 ? -xp : xp;
        ref = x * __cosf(ang) + rot * __sinf(ang); if (region == 0) ref *= 0.125f * LOG2E; got = bf2f((region == 0 ? Qb : Kb)[(size_t)row * 1024 + cr]); }
    dbg_acc(ws, id, (got - ref) * (got - ref), ref * ref, lane);
}
__device__ __forceinline__ void dbg_ret_qkv(unsigned char* ws, int id, const bf16* A, const float* W, const bf16* Qb, const bf16* Kb, const bf16* Vb, int S, int gwv, int lane) {
    if (gwv >= 256) return;
    const int row = (gwv * 2731 + 17) % TG, col = (gwv * 1549 + 3) % 4096, s = row % S;
    float x = dbg_dot(A + (size_t)row * 1024, W, 1024, 6144, col, lane), ref, got;
    if (col >= 2048) { ref = x; got = bf2f(Vb[(size_t)row * 2048 + col - 2048]); }
    else { const float xp = dbg_dot(A + (size_t)row * 1024, W, 1024, 6144, col ^ 1, lane); const int pi = (col & 255) >> 1;
        const float a = ex2(-13.287712379549449f * (float)pi / 127.0f); const double ad = (double)((float)s * a); const float ang = (float)(ad - 6.283185307179586 * floor(ad / 6.283185307179586)); const float rot = (col & 1) ? xp : -xp;
        ref = x * __cosf(ang) + rot * __sinf(ang); if (col >= 1024) ref *= 0.0625f; got = bf2f((col < 1024 ? Qb : Kb)[(size_t)row * 1024 + (col & 1023)]); }
    dbg_acc(ws, id, (got - ref) * (got - ref), ref * ref, lane);
}
__device__ __forceinline__ void dbg_attn(unsigned char* ws, int id, const bf16* Qb, const bf16* Kb, const bf16* Vb, const bf16* OB, int S, int NB, float lam, float oscale, const float* subln, int gwv, int lane) {
    if (gwv >= 32) return;
    const int b = gwv % NB, s = (gwv * 389 + 7) % S, h = (gwv * 5 + 1) & 7; const size_t row = (size_t)b * S + s, rb = (size_t)b * S;
    float of0 = 0.f, of1 = 0.f;
    for (int c = 0; c < 2; ++c) {
        const float q = bf2f(Qb[row * 1024 + h * 128 + c * 64 + lane]);
        float mr = -1e30f, l = 0.f, o0 = 0.f, o1 = 0.f;
        for (int m = 0; m < S; ++m) {
            const float sc = wsum_d(q * bf2f(Kb[(rb + m) * 1024 + h * 128 + c * 64 + lane]));
            const float mn = fmaxf(mr, sc), al = exp2f(mr - mn), p = exp2f(sc - mn); mr = mn;
            l = l * al + p; o0 = o0 * al + p * bf2f(Vb[(rb + m) * 1024 + h * 128 + lane]); o1 = o1 * al + p * bf2f(Vb[(rb + m) * 1024 + h * 128 + 64 + lane]);
        }
        if (c == 0) { of0 = o0 / l; of1 = o1 / l; } else { of0 -= lam * o0 / l; of1 -= lam * o1 / l; }
    }
    const float ss = wsum_d(of0 * of0 + of1 * of1), r = rsqrtf(ss / 128.f + 1e-5f) * oscale;
    const float r0 = of0 * r * subln[lane], r1 = of1 * r * subln[64 + lane];
    const float g0 = bf2f(OB[row * 1024 + h * 128 + lane]), g1 = bf2f(OB[row * 1024 + h * 128 + 64 + lane]);
    dbg_acc(ws, id, wsum_d((g0 - r0) * (g0 - r0) + (g1 - r1) * (g1 - r1)), wsum_d(r0 * r0 + r1 * r1), lane);
}
__device__ __forceinline__ void dbg_ret(unsigned char* ws, int id, const bf16* Qb, const bf16* Kb, const bf16* Vb, const bf16* OB, int S, int NB, const float* decay, int gwv, int lane) {
    if (gwv >= 32) return;
    const int b = gwv % NB, n = (gwv * 389 + 7) % S, h = (gwv * 3 + 1) & 3; const size_t row = (size_t)b * S + n, rb = (size_t)b * S;
    const float lgf = -expf(decay[h]), lgb = -expf(decay[4 + h]);
    float q[4], o[8];
#pragma unroll
    for (int t = 0; t < 4; ++t) q[t] = bf2f(Qb[row * 1024 + h * 256 + lane + 64 * t]);
#pragma unroll
    for (int t = 0; t < 8; ++t) o[t] = 0.f;
    for (int m = 0; m < S; ++m) {
        float a = 0.f;
#pragma unroll
        for (int t = 0; t < 4; ++t) a += q[t] * bf2f(Kb[(rb + m) * 1024 + h * 256 + lane + 64 * t]);
        a = wsum_d(a) * (m <= n ? expf(lgf * (float)(n - m)) : expf(lgb * (float)(m - n)));
#pragma unroll
        for (int t = 0; t < 8; ++t) o[t] += a * bf2f(Vb[(rb + m) * 2048 + h * 512 + lane + 64 * t]);
    }
    float ss = 0.f;
#pragma unroll
    for (int t = 0; t < 8; ++t) ss += o[t] * o[t];
    const float r = rsqrtf(wsum_d(ss) / 512.f + 1e-6f); float e2 = 0.f, r2 = 0.f;
#pragma unroll
    for (int t = 0; t < 8; ++t) { const float rf = o[t] * r, gt = bf2f(OB[row * 2048 + h * 512 + lane + 64 * t]); e2 += (gt - rf) * (gt - rf); r2 += rf * rf; }
    dbg_acc(ws, id, wsum_d(e2), wsum_d(r2), lane);
}

__device__ __forceinline__ void dbg_rp(unsigned char* ws, int id, const float* xold, const float* xnew, const float* m, const float* wpost, const float* wpre, const bf16* hb, int gwv, int lane) {
    if (gwv >= 64) return;
    const int row = (gwv * 2731 + 17) % TG; float e2 = 0.f, r2 = 0.f, ss = 0.f, xs[16];
    if (m) { for (int k = lane; k < 1024; k += 64) { const float v = m[(size_t)row * 1024 + k]; ss += v * v; } }
    const float r = rsqrtf(wsum_d(ss) / 1024.f + 1e-6f); float s2 = 0.f;
#pragma unroll
    for (int t = 0; t < 16; ++t) { const int k = lane + 64 * t; float v = xold ? xold[(size_t)row * 1024 + k] : xnew[(size_t)row * 1024 + k]; if (m) v += m[(size_t)row * 1024 + k] * r * wpost[k]; xs[t] = v; s2 += v * v;
        if (xold) { const float g = xnew[(size_t)row * 1024 + k]; e2 += (g - v) * (g - v); r2 += v * v; } }
    const float rr = rsqrtf(wsum_d(s2) / 1024.f + 1e-6f);
#pragma unroll
    for (int t = 0; t < 16; ++t) { const int k = lane + 64 * t; const float rf = xs[t] * rr * (wpre ? wpre[k] : 1.f), g = bf2f(hb[(size_t)row * 1024 + k]); e2 += (g - rf) * (g - rf); r2 += rf * rf; }
    dbg_acc(ws, id, wsum_d(e2), wsum_d(r2), lane);
}
#endif

#ifndef REP_MASK
#define REP_MASK 0
#endif
#ifndef DBG_MASK
#define DBG_MASK 255
#endif
#ifndef DBG_G
#define DBG_G 0
#endif
#ifndef DBG_TOL
#define DBG_TOL 1e-3f
#endif
#define PT_OFF 146944
__device__ __forceinline__ unsigned long long ldpk(int k) { unsigned a = (unsigned)(PT_OFF + 8 * k); asm volatile("" : "+s"(a)); const unsigned long long v = *(LAS unsigned long long*)a;
    const unsigned lo = __builtin_amdgcn_readfirstlane((unsigned)v), hi = __builtin_amdgcn_readfirstlane((unsigned)(v >> 32)); return ((unsigned long long)hi << 32) | lo; }
#define PIN(k) ((const float*)ldpk(k))
#define WSP ((unsigned char*)ldpk(23))
#define GW (vcu * 8 + wave)
#define NGW (Gn * 8)
#define GCTR ((unsigned*)(WSP + WS_CTL))
#undef GSYNC
#define XBAR_WORDS ((unsigned*)(WSP + WS_CTL + 16384))
#define XBAR_ST ((volatile LAS unsigned*)(lds + PT_OFF + 320))
#define GSYNC() do { int t_ = tid_of(wave); asm volatile("" : "+v"(t_)); XcdBarrier xb_; xb_.bar = XBAR_WORDS; xb_.x = xb_xcc_id(); xb_.st = XBAR_ST; xcd_barrier(xb_, t_ == 0); } while (0)
#define XP ((float*)ldpk(22) + (size_t)g * TG * DM)
#define WBP ((bf16*)(WSP + WS_W))
#define HBP ((bf16*)(WSP + WS_HB))
#define PBP ((bf16*)(WSP + WS_PB))
#define OBP ((bf16*)(WSP + WS_OB))
#define BIGP (WSP + WS_BIG)
__global__ void __launch_bounds__(512) fwd_mega(Params P) {
    extern __shared__ __attribute__((aligned(16))) unsigned char lds_raw[];
    LAS unsigned char* lds = (LAS unsigned char*)lds_raw;
    cg::grid_group grid = cg::this_grid();
    const int wave = __builtin_amdgcn_readfirstlane(threadIdx.x >> 6);
    const int Gn = gridDim.x, bx = blockIdx.x, vcu = (Gn % 8 == 0) ? (bx % 8) * (Gn / 8) + bx / 8 : bx;
    { LAS unsigned long long* PT = (LAS unsigned long long*)(lds + PT_OFF);
      if (threadIdx.x < 22) PT[threadIdx.x] = (unsigned long long)P.in[threadIdx.x];
      if (threadIdx.x == 22) PT[22] = (unsigned long long)P.out;
      if (threadIdx.x == 23) PT[23] = (unsigned long long)P.ws; }
    if (threadIdx.x >= 32 && threadIdx.x < 40) ((LAS unsigned long long*)(lds + PT_OFF + 256))[threadIdx.x - 32] = 0ull;
    if (threadIdx.x == 40) { ((LAS unsigned*)(lds + PT_OFF + 320))[0] = 0u; ((LAS unsigned*)(lds + PT_OFF + 320))[1] = 0u; }
    __syncthreads();
    (void)xcd_barrier_post((unsigned*)(ldpk(23) + WS_CTL + 16384), (volatile LAS unsigned*)(lds + PT_OFF + 320), threadIdx.x == 0);
    unsigned nsync = 0;

    { unsigned char* ws = WSP; bf16* Wb = (bf16*)(ws + WS_W);
      float* rc = (float*)(ws + WS_TAB + TAB_RC); float* rs = (float*)(ws + WS_TAB + TAB_RS); float* xc = (float*)(ws + WS_TAB + TAB_XC); float* xs = (float*)(ws + WS_TAB + TAB_XS);
      int tid_t = tid_of(wave); asm volatile("" : "+v"(tid_t)); const int gt = (vcu * 512 + tid_t), NT_ = Gn * 512;
#ifndef NO_TAB
      for (int idx = gt; idx < 8192 * 32; idx += NT_) { const int s = idx >> 5, j = idx & 31; const float inv = 1.0f / powf(10000.0f, (float)(2 * j) / 64.0f); const float ang = (float)s * inv; float sn, cs; sincosf(ang, &sn, &cs); rc[idx] = cs; rs[idx] = sn; }
      for (int idx = gt; idx < 8192 * 128; idx += NT_) { const int s = idx >> 7, i = idx & 127; const float a = 1.0f / powf(10000.0f, (float)i / 127.0f); const float ang = (float)s * a; float sn, cs; sincosf(ang, &sn, &cs); xc[idx] = cs; xs[idx] = sn; }
#endif
      LAS float* scr = (LAS float*)(lds + wave * 16384);
#pragma unroll 1
      for (int mi = 0; mi < 32; ++mi) {
          const int kind = mi >> 2, li = mi & 3;
          int pin, K, N, permN = 0; size_t soff, doff;
          switch (kind) {
              case 0: if (li >= 2) continue; pin = 8; K = 1024; N = 3072; permN = 2048; soff = (size_t)li * 1024 * 3072; doff = W_QKV + (size_t)li * 3 * MEL; break;
              case 1: if (li >= 2) continue; pin = 9; K = 1024; N = 1024; soff = (size_t)li * MEL; doff = W_O + (size_t)li * MEL; break;
              case 2: if (li >= 2) continue; pin = 15; K = 1024; N = 6144; soff = (size_t)li * 1024 * 6144; doff = W_RIN + (size_t)li * 6 * MEL; break;
              case 3: if (li >= 2) continue; pin = 16; K = 2048; N = 1024; soff = (size_t)li * 2 * MEL; doff = W_ROUT + (size_t)li * 2 * MEL; break;
              case 4: pin = 18; K = 1024; N = 4096; soff = (size_t)li * 4 * MEL; doff = W_MIN + (size_t)li * 4 * MEL; break;
              case 5: pin = 19; K = 4096; N = 1024; soff = (size_t)li * 4 * MEL; doff = W_MOUT + (size_t)li * 4 * MEL; break;
              case 6: pin = 20; K = 256; N = 1024; soff = (size_t)li * 262144; doff = W_PROJ + (size_t)li * 262144; break;
              default: pin = 21; K = 1024; N = 1024; soff = (size_t)li * MEL; doff = W_GATE + (size_t)li * MEL; break;
          }
          conv_matrix(PIN(pin) + soff, K, N, Wb + doff, permN, scr, GW, NGW, wave);
      }
    }
    grid.sync();
#pragma unroll 1
    for (int step2 = 0; step2 < 2 * 4 * 13 * 2; ++step2) {
        const int step = step2 >> 1;
        if (step2 & 1) { const int ph_ = step % 13, i_ = (step % 52) / 13; if (!(((REP_MASK & 2) && (ph_ == 1 || ph_ == 5 || ph_ == 7 || ph_ == 8)) || ((REP_MASK & 1) && ph_ == 2 && !(i_ & 1)) || ((REP_MASK & 4) && ph_ == 2 && (i_ & 1)))) continue; }
        const int g = step / 52, i = (step % 52) / 13, ph = step % 13, j = i >> 1, ret = i & 1;
#ifdef TIMING
        const unsigned long long t0_ = __builtin_amdgcn_s_memrealtime();
#endif
        const int S = g ? 8192 : 2048, NB = g ? 4 : 16, smask = S - 1;
        switch (ph) {
        case 0: { if (i != 0) continue; rowpass<false, true, true, false>(PIN(g), XP, nullptr, nullptr, PIN(4), HBP, nullptr, nullptr, GW, NGW, wave); } break;
        case 1: {
            unsigned char* B_ = BIGP; unsigned char* ws = WSP;
            if (!ret) { EpiAttnQKV E{(bf16*)B_, (bf16*)(B_ + 64 * MiB), (bf16*)(B_ + 128 * MiB), (const float*)(ws + WS_TAB + TAB_RC), (const float*)(ws + WS_TAB + TAB_RS), smask};
                GEMM_CALL(EpiAttnQKV, HBP, WBP + W_QKV + (size_t)j * 3 * MEL, TG, 3072, 1024, E); }
            else { EpiRetQKV E{(bf16*)B_, (bf16*)(B_ + 64 * MiB), (bf16*)(B_ + 128 * MiB), (const float*)(ws + WS_TAB + TAB_XC), (const float*)(ws + WS_TAB + TAB_XS), smask};
                GEMM_CALL(EpiRetQKV, HBP, WBP + W_RIN + (size_t)j * 6 * MEL, TG, 4096, 1024, E); }
        } break;
        case 2: {
            unsigned char* B_ = BIGP;
            if (!ret) {
                GAS const float* lq1 = (GAS const float*)(PIN(10) + j * 64); GAS const float* lk1 = (GAS const float*)(PIN(11) + j * 64); GAS const float* lq2 = (GAS const float*)(PIN(12) + j * 64); GAS const float* lk2 = (GAS const float*)(PIN(13) + j * 64);
                float d1 = 0.f, d2 = 0.f;
                for (int k = 0; k < 64; ++k) { d1 += lq1[k] * lk1[k]; d2 += lq2[k] * lk2[k]; }
                const float lam_init = 0.8f - 0.6f * expf(-0.3f * (float)i); const float lam = expf(d1) - expf(d2) + lam_init;
#ifndef NO_ATTN
                attn_phase(lds, (const bf16*)B_, (const bf16*)(B_ + 64 * MiB), (const bf16*)(B_ + 128 * MiB), OBP, S, NB, vcu, Gn, lam, 1.0f - lam_init, PIN(14) + j * 128, (float*)(B_ + 256 * MiB) + (size_t)blockIdx.x * 32768, wave);
#endif
            } else {
#ifndef NO_SCAN
                scan_phase(lds, (const bf16*)B_, (const bf16*)(B_ + 64 * MiB), (const bf16*)(B_ + 128 * MiB), OBP, (bf16*)(B_ + 256 * MiB), S, NB, vcu, Gn, PIN(17) + j * 8, wave);
#endif
            }
        } break;
        case 3: { if (!ret) continue;
#ifndef NO_INTRA
            unsigned char* B_ = BIGP;
#if (REP_MASK & 8)
            intra_phase(lds, (const bf16*)B_, (const bf16*)(B_ + 64 * MiB), (const bf16*)(B_ + 128 * MiB), OBP, (const bf16*)(B_ + 256 * MiB), S, NB, vcu, Gn, PIN(17) + j * 8, wave, false);
#endif
            intra_phase(lds, (const bf16*)B_, (const bf16*)(B_ + 64 * MiB), (const bf16*)(B_ + 128 * MiB), OBP, (const bf16*)(B_ + 256 * MiB), S, NB, vcu, Gn, PIN(17) + j * 8, wave);
#endif
        } break;
        case 4: { if (!ret) continue; EpiSiluMul E{OBP, 2048}; GEMM_CALL(EpiSiluMul, HBP, WBP + W_RIN + (size_t)j * 6 * MEL + (size_t)4096 * 1024, TG, 2048, 1024, E); } break;
        case 5: case 8: {
            unsigned char* B_ = BIGP; const bf16* A_; const bf16* W_; int K_; bf16* O_;
            if (ph == 5) { A_ = OBP; K_ = ret ? 2048 : 1024; W_ = WBP + (ret ? W_ROUT + (size_t)j * 2 * MEL : W_O + (size_t)j * MEL); O_ = (bf16*)B_; }
            else { A_ = (const bf16*)B_; K_ = 4096; W_ = WBP + W_MOUT + (size_t)i * 4 * MEL; O_ = (bf16*)(B_ + 256 * MiB); }
            EpiBf16Plain E{O_, DM}; GEMM_CALL(EpiBf16Plain, A_, W_, TG, 1024, K_, E);
        } break;
        case 10: {
            EpiBf16NP E{(bf16*)BIGP, DM}; GEMM_CALL(EpiBf16NP, PBP, WBP + W_PROJ + (size_t)i * 262144, TG, 1024, 256, E);
#ifndef PROJ_SYNC
            continue;
#endif
        } break;
        case 6: { float* x = XP; rowpass<true, true, true, false>(x, x, (const bf16*)BIGP, PIN(5) + i * DM, PIN(6) + i * DM, HBP, nullptr, nullptr, GW, NGW, wave); } break;
        case 7: { EpiRelu2 E{(bf16*)BIGP, FFD}; GEMM_CALL(EpiRelu2, HBP, WBP + W_MIN + (size_t)i * 4 * MEL, TG, 4096, 1024, E); } break;
        case 9: { float* x = XP; rowpass<true, true, false, true>(x, x, (const bf16*)(BIGP + 256 * MiB), PIN(7) + i * DM, nullptr, HBP, PIN(2 + g) + (size_t)i * TG * 256, PBP, GW, NGW, wave); } break;
        case 11: { EpiGate E{XP, (const bf16*)BIGP}; GEMM_CALL(EpiGate, HBP, WBP + W_GATE + (size_t)i * MEL, TG, 1024, 1024, E); } break;
        default: { if (i == 3) continue; rowpass<false, false, true, false>(XP, nullptr, nullptr, nullptr, PIN(4) + (i + 1) * DM, HBP, nullptr, nullptr, GW, NGW, wave); } break;
        }
#ifdef TIMING
        const unsigned long long t1_ = __builtin_amdgcn_s_memrealtime();
#endif
        GSYNC();
#ifdef TIMING
        { const unsigned long long t2_ = __builtin_amdgcn_s_memrealtime(); LAS unsigned long long* TA = (LAS unsigned long long*)(lds + PT_OFF + 256);
          const int cat = (ph == 0 || ph == 6 || ph == 9 || ph == 12) ? 4 : (ph == 2 ? (ret ? 2 : 1) : (ph == 3 ? 3 : 0));
          if (tid_of(wave) == 0) { TA[cat] += t1_ - t0_; TA[5] += t2_ - t1_; TA[6] += t2_ - t0_; } }
#endif
#ifdef DBG
        if (g == DBG_G) {
            int lane = tid_of(wave) & 63, gwv = (int)blockIdx.x * 8 + wave; asm volatile("" : "+v"(lane), "+s"(gwv)); unsigned char* ws = WSP; unsigned char* B_ = ws + WS_BIG;
            const bf16* Qb = (const bf16*)B_; const bf16* Kb = (const bf16*)(B_ + 64 * MiB); const bf16* Vb = (const bf16*)(B_ + 128 * MiB);
            const int hi_ = i >> 1;
            bool did = true;
            if (!ret && ph == 1) dbg_attn_qkv(ws, hi_ ? 14 : 2, HBP, PIN(8) + (size_t)j * 1024 * 3072, Qb, Kb, Vb, S, gwv, lane);
            else if (!ret && ph == 2) { const float* lq1 = PIN(10) + j * 64; const float* lk1 = PIN(11) + j * 64; const float* lq2 = PIN(12) + j * 64; const float* lk2 = PIN(13) + j * 64; float d1 = 0.f, d2 = 0.f;
                for (int k = 0; k < 64; ++k) { d1 += lq1[k] * lk1[k]; d2 += lq2[k] * lk2[k]; }
                const float lam_init = 0.8f - 0.6f * expf(-0.3f * (float)i); dbg_attn(ws, hi_ ? 14 : 3, Qb, Kb, Vb, OBP, S, NB, expf(d1) - expf(d2) + lam_init, 1.0f - lam_init, PIN(14) + j * 128, gwv, lane); }
            else if (!ret && ph == 5) dbg_gemm(ws, hi_ ? 14 : 4, OBP, PIN(9) + (size_t)j * MEL, 1024, 1024, B_, 1024, 2, gwv, lane);
            else if (i == 0 && ph == 6) dbg_rp(ws, 5, PIN(g), XP, nullptr, PIN(5), PIN(6), HBP, gwv, lane);
            else if (i == 0 && ph == 7) dbg_gemm(ws, 6, HBP, PIN(18), 1024, 4096, B_, 4096, 1, gwv, lane);
            else if (i == 0 && ph == 8) dbg_gemm(ws, 7, (const bf16*)B_, PIN(19), 4096, 1024, B_ + 256 * MiB, 1024, 2, gwv, lane);
            else if (i == 0 && ph == 9) dbg_rp(ws, 8, nullptr, XP, nullptr, nullptr, nullptr, HBP, gwv, lane);
            else if (i == 0 && ph == 11) dbg_gemm(ws, 9, PBP, PIN(20), 256, 1024, B_, 1024, 2, gwv, lane);
            else if (ret && ph == 1) dbg_ret_qkv(ws, hi_ ? 14 : 10, HBP, PIN(15) + (size_t)j * 1024 * 6144, Qb, Kb, Vb, S, gwv, lane);
            else if (ret && ph == 3) dbg_ret(ws, hi_ ? 14 : 11, Qb, Kb, Vb, OBP, S, NB, PIN(17) + j * 8, gwv, lane);
            else if (ret && ph == 5) dbg_gemm(ws, hi_ ? 14 : 13, OBP, PIN(16) + (size_t)j * 2 * MEL, 2048, 1024, B_, 1024, 2, gwv, lane);
            else if (i == 3 && ph == 11) dbg_acc(ws, 15, 1.f, 1.f, lane);
            else did = false;
            if (did) GSYNC();
        }
#endif
    }
#ifdef TIMING
    { unsigned char* ws = WSP; float* tw = (float*)(ws + WS_CTL + 2048); LAS unsigned long long* TA = (LAS unsigned long long*)(lds + PT_OFF + 256);
      if (blockIdx.x == 0 && tid_of(wave) == 0) { tw[0] = (float)TA[TIMING_A] * 0.01f; tw[1] = (float)TA[TIMING_B] / (float)TA[6]; }
      GSYNC();
      const float C = __hip_atomic_load(tw, __ATOMIC_RELAXED, __HIP_MEMORY_SCOPE_AGENT), f = __hip_atomic_load(tw + 1, __ATOMIC_RELAXED, __HIP_MEMORY_SCOPE_AGENT);
      float* o = (float*)ldpk(22); const size_t nh = (size_t)TG * DM, nf = (size_t)(f * (float)nh);
      for (size_t idx = (size_t)blockIdx.x * 512 + tid_of(wave); idx < nf; idx += (size_t)Gn * 512) { o[idx] = C; o[nh + idx] = C; } }
#endif
#ifdef DBG
    { unsigned char* ws = WSP; const float* acc = (const float*)(ws + WS_CTL + 1024); int bad = -1;
      for (int id = 15; id >= 0; --id) { const float e = __hip_atomic_load(acc + 2 * id, __ATOMIC_RELAXED, __HIP_MEMORY_SCOPE_AGENT), r = __hip_atomic_load(acc + 2 * id + 1, __ATOMIC_RELAXED, __HIP_MEMORY_SCOPE_AGENT); if (r > 0.f && !(e <= DBG_TOL * r)) bad = id; }
      if (bad >= 0) { float C = 100.f; for (int k = 0; k < bad; ++k) C *= 4.f;
#ifdef DBG_RATIO
          C = 1000.f * fminf(fmaxf(__hip_atomic_load(acc + 2 * bad, __ATOMIC_RELAXED, __HIP_MEMORY_SCOPE_AGENT) / __hip_atomic_load(acc + 2 * bad + 1, __ATOMIC_RELAXED, __HIP_MEMORY_SCOPE_AGENT), 1e-3f), 1e3f);
#endif
 float* o = (float*)ldpk(22); const size_t n = (size_t)2 * TG * DM;
          for (size_t idx = (size_t)blockIdx.x * 512 + tid_of(wave); idx < n; idx += (size_t)Gn * 512) o[idx] = C; } }
#endif
}

extern "C" void kernel_launch(void* const* d_in, const int* in_sizes, int n_in, void* d_out, int out_size, void* d_ws, size_t ws_size, hipStream_t stream) {
    static int grid_blocks = 0;
    if (!grid_blocks) {
        int dev = 0, cus = 0, per_cu = 0;
        (void)hipGetDevice(&dev);
        (void)hipDeviceGetAttribute(&cus, hipDeviceAttributeMultiprocessorCount, dev);
        (void)hipFuncSetAttribute((const void*)fwd_mega, hipFuncAttributeMaxDynamicSharedMemorySize, LDS_BYTES);
        (void)hipOccupancyMaxActiveBlocksPerMultiprocessor(&per_cu, (const void*)fwd_mega, 512, LDS_BYTES);
        if (per_cu < 1) per_cu = 1;
        grid_blocks = cus * per_cu;
        if (ws_size < WS_END || n_in != 22) { fprintf(stderr, "kernel_launch: workspace %zu < %zu or n_in %d != 22\n", ws_size, (size_t)WS_END, n_in); }
    }
    (void)hipMemsetAsync((char*)d_ws + WS_CTL, 0, 65536, stream);
    Params p{};
    for (int i = 0; i < 22; ++i) p.in[i] = (const float*)d_in[i];
    p.out = (float*)d_out; p.ws = (unsigned char*)d_ws;
    void* args[] = {&p};
    hipError_t e = hipLaunchCooperativeKernel((void*)fwd_mega, dim3(grid_blocks), dim3(512), args, LDS_BYTES, stream);
    if (e != hipSuccess) fprintf(stderr, "cooperative launch failed: %s (grid %d)\n", hipGetErrorString(e), grid_blocks);
}
```

```cpp
#include <hip/hip_runtime.h>
#include <hip/hip_cooperative_groups.h>
#include <cstdio>
#include <cstdint>
namespace pg8 {
#define PG8_LAS __attribute__((address_space(3)))
typedef unsigned short bf16_t;
typedef short bf16x8 __attribute__((ext_vector_type(8)));
typedef float f32x4 __attribute__((ext_vector_type(4)));
typedef unsigned u32x4 __attribute__((ext_vector_type(4)));
constexpr int BM = 256, BK = 64, HALF = 128, HTB = HALF * BK * 2  , STAGE_BYTES = 8 * HTB, NXCD = 8, WGM = 8;

__host__ __device__ __forceinline__ int lds_byte(int r, int c) { const int st = (r >> 4) * 2 + (c >> 5), rr = r & 15, cc = c & 31, ob = rr * 64 + cc * 2; return st * 1024 + (ob ^ (((ob >> 9) & 1) << 5)); }
__host__ __device__ __forceinline__ void stage_rc(int b, int& R, int& C) { const int st = b / 1024, sb = b % 1024, swz = sb ^ (((sb >> 9) & 1) << 5); R = (st >> 1) * 16 + swz / 64; C = (st & 1) * 32 + (swz % 64) / 2; }
__host__ __device__ __forceinline__ int perm32(int rho) { const int n = rho >> 4, i = rho & 15; return 8 * (i >> 2) + 4 * n + (i & 3); }

struct Unit { int pm, pn; };
struct Gemm { const bf16_t* A; const bf16_t* Bt; int M, N, K; };

struct StaticOrder {
    int nM, nN, nwg, G, c;
    __host__ __device__ void init(int M, int N, int G_, int c_) { nM = M / BM; nN = N / BM; nwg = nM * nN; G = G_; c = c_; }
    __host__ __device__ bool next(int i, Unit& u) const {
        const long L = (long)i * G + c; if (L >= nwg) return false;
        int wgid = (int)L; { const int q = nwg / NXCD, r = nwg % NXCD, xcd = wgid % NXCD, off = wgid / NXCD; wgid = (xcd < r ? xcd * (q + 1) : r * (q + 1) + (xcd - r) * q) + off; }
        const int nig = WGM * nN, gid = wgid / nig, fm = gid * WGM, gsz = (nM - fm) < WGM ? (nM - fm) : WGM;
        u.pm = fm + ((wgid % nig) % gsz); u.pn = (wgid % nig) / gsz; return true;
    }
    __device__ __forceinline__ void a_ready(const Unit&) const {}
    __device__ __forceinline__ void done(const Unit&) const {}
};

__device__ __forceinline__ unsigned cvt_pk_bf16(float lo, float hi) { unsigned r; asm volatile("v_cvt_pk_bf16_f32 %0, %1, %2" : "=v"(r) : "v"(lo), "v"(hi)); return r; }
typedef float f32x2 __attribute__((ext_vector_type(2)));
template <class Epi, class Sched, bool ALIGN_EPI = false, bool SP2 = false>
__device__ __forceinline__ void gemm_phase(PG8_LAS unsigned char* lds, const Gemm g, const Sched& S, const Epi& E, const int wave_id) {
    int tid_l; asm volatile("v_mbcnt_lo_u32_b32 %0, -1, 0\n\tv_mbcnt_hi_u32_b32 %0, -1, %0" : "=v"(tid_l)); tid_l += wave_id * 64; asm volatile("" : "+v"(tid_l));
    const int tid = tid_l, wid = __builtin_amdgcn_readfirstlane(tid >> 6), lane = tid & 63, wr = wid >> 2, wc = wid & 3, fr = lane & 15, fq = lane >> 4;
    const int K = g.K, nt = K / BK;
    unsigned voffA[2], voffB[2];
#pragma unroll
    for (int i = 0; i < 2; ++i) { int R, C; stage_rc(tid * 16 + i * 8192, R, C); const int Rb = Epi::PERM ? ((R & ~31) + perm32(R & 31)) : R;
        voffA[i] = (unsigned)(R * K + C) * 2u; voffB[i] = (unsigned)(Rb * K + C) * 2u; }
    const size_t kstep = (size_t)(BK * 2);
    const size_t hstep = (size_t)HALF * K * 2;
    const size_t tstep = 2 * hstep;
    const unsigned ldsw = (unsigned)wid * 1024u;
    const int aoff = lds_byte(wr * 64 + fr, fq * 8), boff = lds_byte(wc * 32 + fr, fq * 8);
#define PG8_SA(b, h) (((b) * 2 + (h)) * HTB)
#define PG8_SB(b, h) ((4 + (b) * 2 + (h)) * HTB)
#define PG8_STAGE(bufoff, gbase, voff) do { _Pragma("unroll") for (int _i = 0; _i < 2; ++_i) \
        __builtin_amdgcn_global_load_lds((const unsigned*)((const char*)(gbase) + (voff)[_i]), (PG8_LAS unsigned*)(lds + (bufoff) + ldsw + _i * 8192), 16, 0, 0); } while (0)
#define PG8_LDA(dst, b, h) do { _Pragma("unroll") for (int m = 0; m < 4; ++m) _Pragma("unroll") for (int k = 0; k < 2; ++k) dst[m][k] = *(const PG8_LAS bf16x8*)(lds + PG8_SA(b, h) + aoff + m * 2048 + k * 1024); } while (0)
#define PG8_LDB(dst, b, h) do { _Pragma("unroll") for (int n = 0; n < 2; ++n) _Pragma("unroll") for (int k = 0; k < 2; ++k) dst[n][k] = *(const PG8_LAS bf16x8*)(lds + PG8_SB(b, h) + boff + n * 2048 + k * 1024); } while (0)
#define PG8_MMA(ai, bj, At, Bt) do { __builtin_amdgcn_s_setprio(1); _Pragma("unroll") for (int m = 0; m < 4; ++m) _Pragma("unroll") for (int n = 0; n < 2; ++n) _Pragma("unroll") for (int k = 0; k < 2; ++k) \
        acc[ai][bj][m][n] = __builtin_amdgcn_mfma_f32_16x16x32_bf16(Bt[n][k], At[m][k], acc[ai][bj][m][n], 0, 0, 0); __builtin_amdgcn_s_setprio(0); } while (0)
#define PG8_WAIT_V(n) asm volatile("s_waitcnt vmcnt(" #n ")" ::: "memory")
#define PG8_WAIT_L(n) asm volatile("s_waitcnt lgkmcnt(" #n ")" ::: "memory")
#define PG8_BAR __builtin_amdgcn_s_barrier()
#define PG8_SCHED __builtin_amdgcn_sched_barrier(0)
    Unit cur, nxt; int ui = 0;
    if (!S.next(0, cur)) return;
    f32x4 acc[2][2][4][2];
#pragma unroll
    for (int a = 0; a < 2; ++a)
#pragma unroll
        for (int b = 0; b < 2; ++b)
#pragma unroll
            for (int m = 0; m < 4; ++m)
#pragma unroll
                for (int n = 0; n < 2; ++n) acc[a][b][m][n] = (f32x4){0.f, 0.f, 0.f, 0.f};
    bf16x8 At[4][2], B0[2][2], B1[2][2];
    const char* cA = (const char*)g.A + (size_t)cur.pm * tstep; const char* cB = (const char*)g.Bt + (size_t)cur.pn * tstep;
    S.a_ready(cur);
    if constexpr (SP2) {
        PG8_STAGE(PG8_SB(0, 0), cB, voffB); PG8_STAGE(PG8_SB(0, 1), cB + hstep, voffB); PG8_STAGE(PG8_SA(0, 0), cA, voffA); PG8_STAGE(PG8_SA(0, 1), cA + hstep, voffA);
        if (wr == 1) PG8_BAR;
        PG8_WAIT_V(2); PG8_BAR;
        PG8_STAGE(PG8_SB(1, 0), cB + kstep, voffB); PG8_STAGE(PG8_SA(1, 0), cA + kstep, voffA); PG8_STAGE(PG8_SB(1, 1), cB + hstep + kstep, voffB);
        PG8_WAIT_V(6); PG8_BAR;
    } else {
        PG8_STAGE(PG8_SB(0, 0), cB, voffB); PG8_STAGE(PG8_SA(0, 0), cA, voffA); PG8_STAGE(PG8_SB(0, 1), cB + hstep, voffB); PG8_STAGE(PG8_SA(0, 1), cA + hstep, voffA);
        if (wr == 1) PG8_BAR;
        PG8_WAIT_V(4); PG8_BAR;
        PG8_STAGE(PG8_SB(1, 0), cB + kstep, voffB); PG8_STAGE(PG8_SA(1, 0), cA + kstep, voffA); PG8_STAGE(PG8_SB(1, 1), cB + hstep + kstep, voffB);
        PG8_WAIT_V(6); PG8_BAR;
    }
    for (;;) {
        const bool has_next = S.next(ui + 1, nxt);
        const char* nA = has_next ? (const char*)g.A + (size_t)nxt.pm * tstep : cA; const char* nB = has_next ? (const char*)g.Bt + (size_t)nxt.pn * tstep : cB;
        for (int t = 0; t < nt; t += 2) {
            const bool last = (t == nt - 2);
            const char* a1 = cA + (size_t)(t + 1) * kstep;
            const char* a2 = last ? nA : cA + (size_t)(t + 2) * kstep; const char* b2 = last ? nB : cB + (size_t)(t + 2) * kstep;
            const char* a3 = a2 + kstep; const char* b3 = b2 + kstep;
            if (last && has_next) S.a_ready(nxt);
            if constexpr (SP2) {
            PG8_LDB(B0, 0, 0); PG8_LDB(B1, 0, 1); PG8_SCHED; PG8_LDA(At, 0, 0); PG8_STAGE(PG8_SA(1, 1), a1 + hstep, voffA);
            PG8_WAIT_V(8); PG8_WAIT_L(0); PG8_BAR; PG8_MMA(0, 0, At, B0); PG8_MMA(0, 1, At, B1); PG8_BAR; PG8_SCHED;
            PG8_LDA(At, 0, 1); PG8_STAGE(PG8_SB(0, 0), b2, voffB); PG8_STAGE(PG8_SB(0, 1), b2 + hstep, voffB); PG8_STAGE(PG8_SA(0, 0), a2, voffA);
            PG8_WAIT_V(8); PG8_WAIT_L(0); PG8_BAR; PG8_MMA(1, 0, At, B0); PG8_MMA(1, 1, At, B1); PG8_BAR; PG8_SCHED;
            PG8_LDB(B0, 1, 0); PG8_LDB(B1, 1, 1); PG8_SCHED; PG8_LDA(At, 1, 0); PG8_STAGE(PG8_SA(0, 1), a2 + hstep, voffA);
            PG8_WAIT_V(8); PG8_WAIT_L(0); PG8_BAR; PG8_MMA(0, 0, At, B0); PG8_MMA(0, 1, At, B1); PG8_BAR; PG8_SCHED;
            PG8_LDA(At, 1, 1); PG8_STAGE(PG8_SB(1, 0), b3, voffB); PG8_STAGE(PG8_SB(1, 1), b3 + hstep, voffB); PG8_STAGE(PG8_SA(1, 0), a3, voffA);
            PG8_WAIT_V(8); PG8_WAIT_L(0); PG8_BAR; PG8_MMA(1, 0, At, B0); PG8_MMA(1, 1, At, B1); PG8_BAR; PG8_SCHED;
            } else {
            PG8_LDB(B0, 0, 0); PG8_SCHED; PG8_LDA(At, 0, 0); PG8_STAGE(PG8_SA(1, 1), a1 + hstep, voffA);
            PG8_WAIT_L(8); PG8_BAR; PG8_WAIT_L(0); PG8_MMA(0, 0, At, B0); PG8_BAR; PG8_SCHED;
            PG8_LDB(B1, 0, 1); PG8_STAGE(PG8_SB(0, 0), b2, voffB);
            PG8_BAR; PG8_WAIT_L(0); PG8_MMA(0, 1, At, B1); PG8_BAR;
            PG8_LDA(At, 0, 1); PG8_STAGE(PG8_SA(0, 0), a2, voffA);
            PG8_BAR; PG8_WAIT_L(0); PG8_MMA(1, 0, At, B0); PG8_BAR; PG8_SCHED;
            PG8_STAGE(PG8_SB(0, 1), b2 + hstep, voffB);
            PG8_WAIT_V(6); PG8_BAR; PG8_MMA(1, 1, At, B1); PG8_BAR;
            PG8_LDB(B0, 1, 0); PG8_SCHED; PG8_LDA(At, 1, 0); PG8_STAGE(PG8_SA(0, 1), a2 + hstep, voffA);
            PG8_WAIT_L(8); PG8_BAR; PG8_WAIT_L(0); PG8_MMA(0, 0, At, B0); PG8_BAR; PG8_SCHED;
            PG8_LDB(B1, 1, 1); PG8_STAGE(PG8_SB(1, 0), b3, voffB);
            PG8_BAR; PG8_WAIT_L(0); PG8_MMA(0, 1, At, B1); PG8_BAR;
            PG8_LDA(At, 1, 1); PG8_STAGE(PG8_SA(1, 0), a3, voffA);
            PG8_BAR; PG8_WAIT_L(0); PG8_MMA(1, 0, At, B0); PG8_BAR; PG8_SCHED;
            PG8_STAGE(PG8_SB(1, 1), b3 + hstep, voffB);
            PG8_WAIT_V(6); PG8_BAR; PG8_MMA(1, 1, At, B1); PG8_BAR;
            }
        }
        if constexpr (ALIGN_EPI) { if (wr == 0) PG8_BAR; }
        if constexpr (!Epi::AFTER_DRAIN) { E(acc, cur, wr, wc, fr, fq); S.done(cur); }
        if (!has_next) break;
#pragma unroll
        for (int a = 0; a < 2; ++a)
#pragma unroll
            for (int b = 0; b < 2; ++b)
#pragma unroll
                for (int m = 0; m < 4; ++m)
#pragma unroll
                    for (int n = 0; n < 2; ++n) acc[a][b][m][n] = (f32x4){0.f, 0.f, 0.f, 0.f};
        cur = nxt; cA = nA; cB = nB; ++ui;
        if constexpr (ALIGN_EPI) { if (wr == 1) PG8_BAR; }
    }
    PG8_WAIT_V(0);
    if constexpr (!ALIGN_EPI) { if (wr == 0) PG8_BAR; }
    PG8_BAR;
    if constexpr (Epi::AFTER_DRAIN) { E.fused(acc, cur, wr, wc, fr, fq, lds, wid, lane); S.done(cur); }
#undef PG8_SA
#undef PG8_SB
#undef PG8_STAGE
#undef PG8_LDA
#undef PG8_LDB
#undef PG8_MMA
#undef PG8_WAIT_V
#undef PG8_WAIT_L
#undef PG8_BAR
#undef PG8_SCHED
}
}

namespace cg = cooperative_groups;
#define LAS __attribute__((address_space(3)))
#define GAS __attribute__((address_space(1)))
typedef unsigned short bf16;
typedef short bf16x8 __attribute__((ext_vector_type(8)));
typedef short s16x4 __attribute__((ext_vector_type(4)));
typedef float f32x2 __attribute__((ext_vector_type(2)));
typedef float f32x4 __attribute__((ext_vector_type(4)));
typedef float f32x16 __attribute__((ext_vector_type(16)));
typedef unsigned u32x2 __attribute__((ext_vector_type(2)));
typedef unsigned u32x4 __attribute__((ext_vector_type(4)));

constexpr int DM = 1024, TG = 32768, FFD = 4096;
constexpr size_t MiB = (size_t)1 << 20;
constexpr size_t WS_CTL = 0, WS_TAB = 1 * MiB, WS_W = 12 * MiB, WS_HB = 136 * MiB, WS_PB = 200 * MiB, WS_OB = 216 * MiB, WS_BIG = 344 * MiB, WS_END = 728 * MiB;
constexpr size_t TAB_RC = 0, TAB_RS = 1 * MiB, TAB_XC = 2 * MiB, TAB_XS = 6 * MiB;
constexpr size_t MEL = 1048576;
constexpr size_t W_QKV = 0, W_O = 6 * MEL, W_RIN = 8 * MEL, W_ROUT = 20 * MEL, W_MIN = 24 * MEL, W_MOUT = 40 * MEL, W_PROJ = 56 * MEL, W_GATE = 57 * MEL;
constexpr float LOG2E = 1.4426950408889634f;
constexpr int LDS_BYTES = 147456;

struct Params { const float* in[22]; float* out; unsigned char* ws; };

__device__ __forceinline__ unsigned cvtpk(float lo, float hi) { typedef __bf16 b2 __attribute__((ext_vector_type(2))); f32x2 v = {lo, hi}; b2 b = __builtin_convertvector(v, b2); return __builtin_bit_cast(unsigned, b); }
__device__ __forceinline__ float bf2f(unsigned short b) { return __uint_as_float(((unsigned)b) << 16); }
__device__ __forceinline__ unsigned short f2bf(float f) { return (unsigned short)(cvtpk(f, 0.f) & 0xffffu); }
__device__ __forceinline__ float shx(float v, int o, int lane) { return __int_as_float(__builtin_amdgcn_ds_bpermute((lane ^ o) << 2, __float_as_int(v))); }
__device__ __forceinline__ float wave_sum(float v, int lane) {
#pragma unroll
    for (int o = 1; o < 64; o <<= 1) v += shx(v, o, lane);
    return v;
}
__device__ __forceinline__ int crow(int r, int hh) { return (r & 3) + 8 * (r >> 2) + 4 * hh; }
__device__ __forceinline__ s16x4 trr(LAS unsigned char* p) { return __builtin_bit_cast(s16x4, __builtin_amdgcn_ds_read_tr16_b64_v4i16((LAS s16x4*)p)); }
__device__ __forceinline__ bf16x8 cat8(s16x4 lo, s16x4 hi) { return (bf16x8){lo[0], lo[1], lo[2], lo[3], hi[0], hi[1], hi[2], hi[3]}; }
__device__ __forceinline__ bf16x8 pack8(const f32x16& v, int b) { u32x4 w; w.x = cvtpk(v[b], v[b + 1]); w.y = cvtpk(v[b + 2], v[b + 3]); w.z = cvtpk(v[b + 4], v[b + 5]); w.w = cvtpk(v[b + 6], v[b + 7]); return __builtin_bit_cast(bf16x8, w); }
#define LBAR() do { asm volatile("s_waitcnt lgkmcnt(0)" ::: "memory"); __builtin_amdgcn_s_barrier(); asm volatile("" ::: "memory"); } while (0)
#ifndef ATT_THR
#define ATT_THR 6.0f
#endif
#ifndef PPSEL
#define PPSEL(w) ((w) >= 4)
#endif
__device__ __forceinline__ void glds16(const void* gsrc, unsigned lds_dst) { unsigned keep;
    asm volatile("s_mov_b32 %0, m0\n\ts_mov_b32 m0, %2\n\ts_nop 0\n\tglobal_load_lds_dwordx4 %1, off\n\ts_mov_b32 m0, %0" : "=&s"(keep) : "v"(gsrc), "s"(lds_dst) : "memory"); }
#define MFMA32(a, b, c) __builtin_amdgcn_mfma_f32_32x32x16_bf16((a), (b), (c), 0, 0, 0)
__device__ __forceinline__ int tid_of(int wave) { int l; asm volatile("v_mbcnt_lo_u32_b32 %0, -1, 0\n\tv_mbcnt_hi_u32_b32 %0, -1, %0" : "=v"(l)); return wave * 64 + l; }
__device__ __forceinline__ float max3f(float a, float b, float c) { float r; asm("v_max3_f32 %0, %1, %2, %3" : "=v"(r) : "v"(a), "v"(b), "v"(c)); return r; }
__device__ __forceinline__ float ex2(float x) { return __builtin_amdgcn_exp2f(x); }

__device__ __forceinline__ int qk_perm(int n) { const int d = n & 63; return (n & ~63) | (((d >> 4) & 1) << 5) | ((d >> 5) << 4) | (d & 15); }
__device__ __forceinline__ void conv_item(const float* W, int K, int N, bf16* WT, int permN, LAS float* scr, int item, int lane) {
    const int nblk = N / 32, kb = item / nblk, nb = item % nblk, k0 = 64 * kb, n0 = 32 * nb;
#pragma unroll 8
    for (int i = 0; i < 32; ++i) { const int kk = 2 * i + (lane >> 5); scr[kk * 33 + (lane & 31)] = ((GAS const float*)W)[(size_t)(k0 + kk) * N + n0 + (lane & 31)]; }
    asm volatile("s_waitcnt lgkmcnt(0)" ::: "memory");
    const int c = lane & 7;
#pragma unroll
    for (int j = 0; j < 4; ++j) { const int n = (lane >> 3) + 8 * j; const LAS float* s = scr + (8 * c) * 33 + n;
        u32x4 o; o.x = cvtpk(s[0 * 33], s[1 * 33]); o.y = cvtpk(s[2 * 33], s[3 * 33]); o.z = cvtpk(s[4 * 33], s[5 * 33]); o.w = cvtpk(s[6 * 33], s[7 * 33]);
        const int nn = n0 + n, dst = nn < permN ? qk_perm(nn) : nn;
        *(GAS u32x4*)(WT + (size_t)dst * K + k0 + 8 * c) = o; }
    asm volatile("s_waitcnt lgkmcnt(0)" ::: "memory");
}
__device__ __forceinline__ void conv_matrix(const float* W, int K, int N, bf16* WT, int permN, LAS float* scr, int gw, int NGW, const int wave) {
    int lane = tid_of(wave) & 63; asm volatile("" : "+v"(lane));
    const int items = (K / 64) * (N / 32);
    for (int it = gw; it < items; it += NGW) conv_item(W, K, N, WT, permN, scr, it, lane);
}

template <bool HAS_M, bool STORE_X, bool HAS_WPRE, bool HAS_P>
__device__ __forceinline__ void rowpass(const float* xsrc, float* xdst, const bf16* m, const float* wpost, const float* wpre, bf16* hb, const float* psrc, bf16* pb, int gw, int NGW, const int wave) {
    int lane = tid_of(wave) & 63; asm volatile("" : "+v"(lane));
    constexpr int RB = 4;
    for (int row0 = gw; row0 < TG; row0 += RB * NGW) {
        f32x4 v[RB][4]; u32x2 mw[RB][4]; f32x4 pv[RB];
#pragma unroll
        for (int q = 0; q < RB; ++q) { const int row = min(row0 + q * NGW, TG - 1);
            GAS const f32x4* xr = (GAS const f32x4*)(xsrc + (size_t)row * DM) + lane;
#pragma unroll
            for (int j = 0; j < 4; ++j) v[q][j] = xr[64 * j];
            if constexpr (HAS_M) { GAS const u32x2* mr = (GAS const u32x2*)(m + (size_t)row * DM) + lane;
#pragma unroll
                for (int j = 0; j < 4; ++j) mw[q][j] = mr[64 * j]; }
            if constexpr (HAS_P) pv[q] = ((GAS const f32x4*)(psrc + (size_t)row * 256))[lane]; }
        f32x4 wp[4], wq[4];
#pragma unroll
        for (int j = 0; j < 4; ++j) { if constexpr (HAS_M) wp[j] = ((GAS const f32x4*)wpost)[lane + 64 * j]; if constexpr (HAS_WPRE) wq[j] = ((GAS const f32x4*)wpre)[lane + 64 * j]; }
#pragma unroll
        for (int q = 0; q < RB; ++q) { const int row = row0 + q * NGW; if (row >= TG) break;
            if constexpr (HAS_M) {
                f32x4 mm[4]; float ss = 0.f;
#pragma unroll
                for (int j = 0; j < 4; ++j) { const u32x2 w_ = mw[q][j]; mm[j].x = __uint_as_float(w_.x << 16); mm[j].y = __uint_as_float(w_.x & 0xffff0000u); mm[j].z = __uint_as_float(w_.y << 16); mm[j].w = __uint_as_float(w_.y & 0xffff0000u);
                    ss += mm[j].x * mm[j].x + mm[j].y * mm[j].y + mm[j].z * mm[j].z + mm[j].w * mm[j].w; }
                const float r = rsqrtf(wave_sum(ss, lane) * (1.f / DM) + 1e-6f);
#pragma unroll
                for (int j = 0; j < 4; ++j) v[q][j] += mm[j] * r * wp[j];
            }
            if constexpr (STORE_X) { GAS f32x4* xo = (GAS f32x4*)(xdst + (size_t)row * DM) + lane;
#pragma unroll
                for (int j = 0; j < 4; ++j) xo[64 * j] = v[q][j]; }
            {
                float ss = 0.f;
#pragma unroll
                for (int j = 0; j < 4; ++j) ss += v[q][j].x * v[q][j].x + v[q][j].y * v[q][j].y + v[q][j].z * v[q][j].z + v[q][j].w * v[q][j].w;
                const float r = rsqrtf(wave_sum(ss, lane) * (1.f / DM) + 1e-6f);
                GAS u32x2* ho = (GAS u32x2*)(hb + (size_t)row * DM) + lane;
#pragma unroll
                for (int j = 0; j < 4; ++j) { f32x4 o = v[q][j] * r; if constexpr (HAS_WPRE) o *= wq[j]; u32x2 w; w.x = cvtpk(o.x, o.y); w.y = cvtpk(o.z, o.w); ho[64 * j] = w; }
            }
            if constexpr (HAS_P) { u32x2 w; w.x = cvtpk(pv[q].x, pv[q].y); w.y = cvtpk(pv[q].z, pv[q].w); ((GAS u32x2*)(pb + (size_t)row * 256))[lane] = w; }
        }
    }
}

#define EPI_LOOP_AIM for (int ai = 0; ai < 2; ++ai) for (int m = 0; m < 4; ++m)
struct EpiF32 {
    static constexpr bool PERM = false, AFTER_DRAIN = false; float* O; int ldc;
    __device__ __forceinline__ void operator()(const pg8::f32x4 (&acc)[2][2][4][2], const pg8::Unit& u, int wr, int wc, int fr, int fq) const {
        const int row0 = u.pm * 256 + wr * 64 + fr, col0 = u.pn * 256 + wc * 32 + 4 * fq;
#pragma unroll
        for (int ai = 0; ai < 2; ++ai)
#pragma unroll
            for (int m = 0; m < 4; ++m) { GAS float* rp = (GAS float*)(O + (size_t)(row0 + ai * 128 + m * 16) * ldc + col0);
#pragma unroll
                for (int bj = 0; bj < 2; ++bj)
#pragma unroll
                    for (int n = 0; n < 2; ++n) *(GAS f32x4*)(rp + bj * 128 + n * 16) = acc[ai][bj][m][n]; }
    }
};
struct EpiBf16Plain {
    static constexpr bool PERM = true, AFTER_DRAIN = false; bf16* O; int ldc;
    __device__ __forceinline__ void operator()(const pg8::f32x4 (&acc)[2][2][4][2], const pg8::Unit& u, int wr, int wc, int fr, int fq) const {
        const int row0 = u.pm * 256 + wr * 64 + fr, col0 = u.pn * 256 + wc * 32 + 8 * fq;
#pragma unroll
        for (int ai = 0; ai < 2; ++ai)
#pragma unroll
            for (int m = 0; m < 4; ++m) { GAS bf16* rp = (GAS bf16*)(O + (size_t)(row0 + ai * 128 + m * 16) * ldc + col0);
#pragma unroll
                for (int bj = 0; bj < 2; ++bj) { f32x4 v0 = acc[ai][bj][m][0], v1 = acc[ai][bj][m][1];
                    u32x4 w; w.x = cvtpk(v0.x, v0.y); w.y = cvtpk(v0.z, v0.w); w.z = cvtpk(v1.x, v1.y); w.w = cvtpk(v1.z, v1.w); *(GAS u32x4*)(rp + bj * 128) = w; } }
    }
};
struct EpiRelu2 {
    static constexpr bool PERM = true, AFTER_DRAIN = false; bf16* O; int ldc;
    __device__ __forceinline__ void operator()(const pg8::f32x4 (&acc)[2][2][4][2], const pg8::Unit& u, int wr, int wc, int fr, int fq) const {
        const int row0 = u.pm * 256 + wr * 64 + fr, col0 = u.pn * 256 + wc * 32 + 8 * fq;
#pragma unroll
        for (int ai = 0; ai < 2; ++ai)
#pragma unroll
            for (int m = 0; m < 4; ++m) { GAS bf16* rp = (GAS bf16*)(O + (size_t)(row0 + ai * 128 + m * 16) * ldc + col0);
#pragma unroll
                for (int bj = 0; bj < 2; ++bj) { f32x4 v0 = acc[ai][bj][m][0], v1 = acc[ai][bj][m][1];
                    v0.x = fmaxf(v0.x, 0.f); v0.y = fmaxf(v0.y, 0.f); v0.z = fmaxf(v0.z, 0.f); v0.w = fmaxf(v0.w, 0.f); v1.x = fmaxf(v1.x, 0.f); v1.y = fmaxf(v1.y, 0.f); v1.z = fmaxf(v1.z, 0.f); v1.w = fmaxf(v1.w, 0.f); v0 = v0 * v0; v1 = v1 * v1;
                    u32x4 w; w.x = cvtpk(v0.x, v0.y); w.y = cvtpk(v0.z, v0.w); w.z = cvtpk(v1.x, v1.y); w.w = cvtpk(v1.z, v1.w); *(GAS u32x4*)(rp + bj * 128) = w; } }
    }
};
struct EpiBf16NP {
    static constexpr bool PERM = false, AFTER_DRAIN = false; bf16* O; int ldc;
    __device__ __forceinline__ void operator()(const pg8::f32x4 (&acc)[2][2][4][2], const pg8::Unit& u, int wr, int wc, int fr, int fq) const {
        const int row0 = u.pm * 256 + wr * 64 + fr, col0 = u.pn * 256 + wc * 32 + 4 * fq;
#pragma unroll
        for (int ai = 0; ai < 2; ++ai)
#pragma unroll
            for (int m = 0; m < 4; ++m) { GAS bf16* rp = (GAS bf16*)(O + (size_t)(row0 + ai * 128 + m * 16) * ldc + col0);
#pragma unroll
                for (int bj = 0; bj < 2; ++bj)
#pragma unroll
                    for (int n = 0; n < 2; ++n) { const f32x4 v = acc[ai][bj][m][n]; u32x2 w; w.x = cvtpk(v.x, v.y); w.y = cvtpk(v.z, v.w); *(GAS u32x2*)(rp + bj * 128 + n * 16) = w; } }
    }
};
struct EpiGate {
    static constexpr bool PERM = false, AFTER_DRAIN = false; float* X; const bf16* PR;
    __device__ __forceinline__ void operator()(const pg8::f32x4 (&acc)[2][2][4][2], const pg8::Unit& u, int wr, int wc, int fr, int fq) const {
        const int row0 = u.pm * 256 + wr * 64 + fr, col0 = u.pn * 256 + wc * 32 + 4 * fq;
#pragma unroll
        for (int ai = 0; ai < 2; ++ai)
#pragma unroll
            for (int m = 0; m < 4; ++m) { const size_t off = (size_t)(row0 + ai * 128 + m * 16) * DM + col0;
#pragma unroll
                for (int bj = 0; bj < 2; ++bj)
#pragma unroll
                    for (int n = 0; n < 2; ++n) { const f32x4 a = acc[ai][bj][m][n]; const u32x2 prw = *(GAS const u32x2*)(PR + off + bj * 128 + n * 16); f32x4 pr; pr.x = __uint_as_float(prw.x << 16); pr.y = __uint_as_float(prw.x & 0xffff0000u); pr.z = __uint_as_float(prw.y << 16); pr.w = __uint_as_float(prw.y & 0xffff0000u); f32x4 xv = *(GAS const f32x4*)(X + off + bj * 128 + n * 16);
                        xv.x += pr.x / (1.f + __expf(-a.x)); xv.y += pr.y / (1.f + __expf(-a.y)); xv.z += pr.z / (1.f + __expf(-a.z)); xv.w += pr.w / (1.f + __expf(-a.w));
                        *(GAS f32x4*)(X + off + bj * 128 + n * 16) = xv; } }
    }
};
struct EpiSiluMul {
    static constexpr bool PERM = false, AFTER_DRAIN = false; bf16* O; int ldc;
    __device__ __forceinline__ void operator()(const pg8::f32x4 (&acc)[2][2][4][2], const pg8::Unit& u, int wr, int wc, int fr, int fq) const {
        const int row0 = u.pm * 256 + wr * 64 + fr, col0 = u.pn * 256 + wc * 32 + 4 * fq;
#pragma unroll
        for (int ai = 0; ai < 2; ++ai)
#pragma unroll
            for (int m = 0; m < 4; ++m) { GAS bf16* rp = (GAS bf16*)(O + (size_t)(row0 + ai * 128 + m * 16) * ldc + col0);
#pragma unroll
                for (int bj = 0; bj < 2; ++bj)
#pragma unroll
                    for (int n = 0; n < 2; ++n) { const f32x4 a = acc[ai][bj][m][n]; u32x2 w = *(GAS const u32x2*)(rp + bj * 128 + n * 16);
                        const float o0 = __uint_as_float(w.x << 16) * a.x / (1.f + __expf(-a.x)), o1 = __uint_as_float(w.x & 0xffff0000u) * a.y / (1.f + __expf(-a.y));
                        const float o2 = __uint_as_float(w.y << 16) * a.z / (1.f + __expf(-a.z)), o3 = __uint_as_float(w.y & 0xffff0000u) * a.w / (1.f + __expf(-a.w));
                        w.x = cvtpk(o0, o1); w.y = cvtpk(o2, o3); *(GAS u32x2*)(rp + bj * 128 + n * 16) = w; } }
    }
};
struct EpiAttnQKV {
    static constexpr bool PERM = false, AFTER_DRAIN = false; bf16 *Q, *K, *V; const float *rc, *rs; int smask;
    __device__ __forceinline__ void operator()(const pg8::f32x4 (&acc)[2][2][4][2], const pg8::Unit& u, int wr, int wc, int fr, int fq) const {
        const int row0 = u.pm * 256 + wr * 64 + fr, region = u.pn >> 2, colt = (u.pn & 3) * 256;
        if (region == 2) {
            const int col0 = colt + wc * 32 + 4 * fq;
#pragma unroll
            for (int ai = 0; ai < 2; ++ai)
#pragma unroll
                for (int m = 0; m < 4; ++m) { GAS bf16* rp = (GAS bf16*)(V + (size_t)(row0 + ai * 128 + m * 16) * DM + col0);
#pragma unroll
                    for (int bj = 0; bj < 2; ++bj)
#pragma unroll
                        for (int n = 0; n < 2; ++n) { const f32x4 v = acc[ai][bj][m][n]; u32x2 w; w.x = cvtpk(v.x, v.y); w.y = cvtpk(v.z, v.w); *(GAS u32x2*)(rp + bj * 128 + n * 16) = w; } }
        } else {
            bf16* dst = region == 0 ? Q : K; const float sc = region == 0 ? 0.125f * LOG2E : 1.f; const int g = wc & 1, d1 = 16 * g + 4 * fq;
#pragma unroll
            for (int ai = 0; ai < 2; ++ai)
#pragma unroll
                for (int m = 0; m < 4; ++m) { const int row = row0 + ai * 128 + m * 16, s = row & smask;
                    const f32x4 c4 = *(GAS const f32x4*)(rc + s * 32 + d1) * sc, s4 = *(GAS const f32x4*)(rs + s * 32 + d1) * sc;
#pragma unroll
                    for (int bj = 0; bj < 2; ++bj) { const int cb = colt + bj * 128 + (wc >> 1) * 64;
                        const f32x4 x1 = acc[ai][bj][m][0], x2 = acc[ai][bj][m][1]; const f32x4 o1 = x1 * c4 - x2 * s4, o2 = x2 * c4 + x1 * s4;
                        u32x2 w; w.x = cvtpk(o1.x, o1.y); w.y = cvtpk(o1.z, o1.w); *(GAS u32x2*)(dst + (size_t)row * DM + cb + d1) = w;
                        w.x = cvtpk(o2.x, o2.y); w.y = cvtpk(o2.z, o2.w); *(GAS u32x2*)(dst + (size_t)row * DM + cb + d1 + 32) = w; } }
        }
    }
};
struct EpiRetQKV {
    static constexpr bool PERM = false, AFTER_DRAIN = false; bf16 *Q, *K, *V; const float *xc, *xs; int smask;
    __device__ __forceinline__ void operator()(const pg8::f32x4 (&acc)[2][2][4][2], const pg8::Unit& u, int wr, int wc, int fr, int fq) const {
        const int row0 = u.pm * 256 + wr * 64 + fr;
        if (u.pn >= 8) {
            const int col0 = (u.pn - 8) * 256 + wc * 32 + 4 * fq;
#pragma unroll
            for (int ai = 0; ai < 2; ++ai)
#pragma unroll
                for (int m = 0; m < 4; ++m) { GAS bf16* rp = (GAS bf16*)(V + (size_t)(row0 + ai * 128 + m * 16) * 2048 + col0);
#pragma unroll
                    for (int bj = 0; bj < 2; ++bj)
#pragma unroll
                        for (int n = 0; n < 2; ++n) { const f32x4 v = acc[ai][bj][m][n]; u32x2 w; w.x = cvtpk(v.x, v.y); w.y = cvtpk(v.z, v.w); *(GAS u32x2*)(rp + bj * 128 + n * 16) = w; } }
        } else {
            bf16* dst = u.pn < 4 ? Q : K; const float sc = u.pn < 4 ? 1.f : 0.0625f; const int col0 = (u.pn & 3) * 256 + wc * 32 + 4 * fq;
#pragma unroll
            for (int ai = 0; ai < 2; ++ai)
#pragma unroll
                for (int m = 0; m < 4; ++m) { const int row = row0 + ai * 128 + m * 16, s = row & smask;
#pragma unroll
                    for (int bj = 0; bj < 2; ++bj)
#pragma unroll
                        for (int n = 0; n < 2; ++n) { const int col = col0 + bj * 128 + n * 16, pi = (col & 255) >> 1;
                            const f32x2 c2 = *(GAS const f32x2*)(xc + s * 128 + pi) * sc, s2 = *(GAS const f32x2*)(xs + s * 128 + pi) * sc; const f32x4 x = acc[ai][bj][m][n];
                            u32x2 w; w.x = cvtpk(x.x * c2.x - x.y * s2.x, x.y * c2.x + x.x * s2.x); w.y = cvtpk(x.z * c2.y - x.w * s2.y, x.w * c2.y + x.z * s2.y);
                            const size_t qoff = u.pn < 4 ? ((((size_t)(row >> 5) * 4 + (col >> 8)) * 16 + ((col & 255) >> 4)) * 512 + (((col & 255) >> 3) & 1) * 256 + (row & 31) * 8 + (col & 7)) : ((size_t)row * DM + col);
                            *(GAS u32x2*)(dst + qoff) = w; } }
        }
    }
};

__device__ __forceinline__ void attn_phase(LAS unsigned char* lds, const bf16* Q, const bf16* K, const bf16* V, bf16* OB, int S, int nbatch, int vcu, int G, float lam, float oscale, const float* subln, float* o1s, const int wave) {
    lam = __uint_as_float(__builtin_amdgcn_readfirstlane(__float_as_uint(lam))); oscale = __uint_as_float(__builtin_amdgcn_readfirstlane(__float_as_uint(oscale)));
    const int nqb = S / 256, nunits = nbatch * 8 * nqb, per = (nunits + G - 1) / G;
    constexpr int KSTR = 128, VSTR = 256, QSTR = 144, KBYTES = 64 * KSTR, VBYTES = 64 * VSTR, VBASE = 3 * KBYTES, QBASE = VBASE + 4 * VBYTES;

    for (int it = 0; it < per; ++it) {
    int tid_l = tid_of(wave); asm volatile("" : "+v"(tid_l));
    const int tid = tid_l, lane = tid & 63, w = __builtin_amdgcn_readfirstlane(tid >> 6), l31 = lane & 31, hh = lane >> 5;
    const int i15 = lane & 15, qq = i15 >> 2, pp = i15 & 3;
    const int vtr_off = (4 * hh + qq) * VSTR + 32 * ((lane >> 4) & 1) + 8 * pp;
    const int kfr_off = l31 * KSTR, xk = l31 & 7;
    const size_t kdoff = (size_t)(8 * w + (lane >> 3)) * DM + (((lane & 7) ^ (lane >> 3)) << 3);
    const size_t vdoff = (size_t)(8 * w + (lane >> 4)) * DM + ((((((lane & 15) >> 2) ^ ((lane >> 4) & 3)) << 2) | (lane & 3)) << 3);
        const int u = vcu * per + it; if (u >= nunits) break;
        const int qb = u % nqb, bh = u / nqb, h = bh & 7, b = bh >> 3;
        const size_t rowbase = (size_t)b * S; const int q0 = qb * 256 + w * 32;
#pragma unroll 1
        for (int c = 0; c < 2; ++c) {
            const bf16* Kg = K + rowbase * DM + h * 128 + c * 64; const bf16* Vg = V + rowbase * DM + h * 128;
            size_t kdo = kdoff, vdo = vdoff; asm volatile("" : "+v"(kdo), "+v"(vdo));
            bf16x8 qf[4];
#pragma unroll
            for (int ds = 0; ds < 4; ++ds) qf[ds] = *(GAS const bf16x8*)(Q + (rowbase + q0 + l31) * DM + h * 128 + c * 64 + ds * 16 + hh * 8);
            LAS unsigned char* qst_ = lds + QBASE + w * (32 * QSTR) + l31 * QSTR + hh * 16;
            const int NT = S / 64;
#define ATT_DMA_K(TILE, SLOT) glds16((const void*)(Kg + kdo + (size_t)(TILE) * 64 * DM), (unsigned)__builtin_amdgcn_readfirstlane((int)(unsigned)(size_t)(lds + (SLOT) * KBYTES + w * 1024)))
#define ATT_DMA_V(TILE, SLOT) do { glds16((const void*)(Vg + vdo + (size_t)(TILE) * 64 * DM), (unsigned)__builtin_amdgcn_readfirstlane((int)(unsigned)(size_t)(lds + VBASE + (SLOT) * VBYTES + w * 2048))); \
                glds16((const void*)(Vg + vdo + ((size_t)(TILE) * 64 + 4) * DM), (unsigned)__builtin_amdgcn_readfirstlane((int)(unsigned)(size_t)(lds + VBASE + (SLOT) * VBYTES + w * 2048 + 1024))); } while (0)
            __syncthreads();
            ATT_DMA_K(0, 0); ATT_DMA_K(1, 1); ATT_DMA_V(0, 0); ATT_DMA_V(1, 1);
            {   unsigned z0_ = 0u; asm volatile("" : "+v"(z0_)); const u32x4 zz = {z0_, z0_, z0_, z0_};
                *(LAS u32x4*)(lds + VBASE + 3 * VBYTES + tid * 16) = zz; *(LAS u32x4*)(lds + VBASE + 3 * VBYTES + 8192 + tid * 16) = zz; }
            asm volatile("s_waitcnt vmcnt(0)" ::: "memory");
            __syncthreads();
            f32x16 o[4]; float zf_ = 0.f; asm volatile("" : "+v"(zf_));
#pragma unroll
            for (int d0 = 0; d0 < 4; ++d0)
#pragma unroll
                for (int r = 0; r < 16; ++r) o[d0][r] = zf_;
            float lrun = 0.f, alpha_prev = 1.f;
            f32x16 s0, s1;
#pragma unroll
            for (int ds = 0; ds < 4; ++ds) *(LAS bf16x8*)(qst_ + ds * 32) = qf[ds];
            bf16x8 pfp[4];
#pragma unroll
            for (int k4 = 0; k4 < 4; ++k4) pfp[k4] = (bf16x8){0, 0, 0, 0, 0, 0, 0, 0};
            float mref = -1e30f; f32x16 negm;
#pragma unroll
            for (int r = 0; r < 16; ++r) negm[r] = zf_;
            bool first = true;
            int ks_cur = 0, ks_stage = 2 * KBYTES;
#define KFA(I_) (kb_ + ((I_) & 1) * 32 * KSTR + ((((I_) & ~1) + hh) ^ xk) * 16)
#define VFA(V_) (vb_ + (16 * ((V_) >> 2)) * VSTR + ((((V_) & 3) ^ qq) << 6))
#define ATT_ITER(T_, KW_, V0W_, V1W_, KL_, V0L_, V1L_) do { \
                if (__any(alpha_prev != 1.f)) { \
                _Pragma("unroll") \
                    for (int d0 = 0; d0 < 4; ++d0) \
                _Pragma("unroll") \
                        for (int r = 0; r < 16; ++r) o[d0][r] *= alpha_prev; } \
                { const int tk = (T_ + 2 < NT) ? T_ + 2 : NT - 1; \
                  glds16((const void*)(Kg + kdo + (size_t)tk * 64 * DM), (unsigned)__builtin_amdgcn_readfirstlane((int)(unsigned)(size_t)(lds + ks_stage + w * 1024))); \
                  LAS unsigned char* vds_ = lds + VBASE + ((T_ + 2) & 3) * VBYTES + w * 2048; \
                  glds16((const void*)(Vg + vdo + (size_t)tk * 64 * DM), (unsigned)__builtin_amdgcn_readfirstlane((int)(unsigned)(size_t)(vds_))); \
                  glds16((const void*)(Vg + vdo + ((size_t)tk * 64 + 4) * DM), (unsigned)__builtin_amdgcn_readfirstlane((int)(unsigned)(size_t)(vds_ + 1024))); } \
                { LAS unsigned char* kb_ = lds + ks_cur + kfr_off; LAS unsigned char* vb_ = lds + VBASE + ((T_ + 3) & 3) * VBYTES + vtr_off; \
                  bf16x8 kfr[8], vfr[16], qfl[4]; \
                  qfl[0] = *(LAS bf16x8*)(qst_); \
                  kfr[0] = *(LAS bf16x8*)KFA(0); kfr[1] = *(LAS bf16x8*)KFA(1); \
                _Pragma("unroll") \
                  for (int i_ = 0; i_ < 8; ++i_) { \
                      if (i_ + 2 < 8) { kfr[i_ + 2] = *(LAS bf16x8*)KFA(i_ + 2); if (!(i_ & 1)) qfl[(i_ + 2) >> 1] = *(LAS bf16x8*)(qst_ + ((i_ + 2) >> 1) * 32); } \
                      else { const int v_ = i_ - 6; vfr[v_] = cat8(trr(VFA(v_)), trr(VFA(v_) + 8 * VSTR)); } \
                      __builtin_amdgcn_sched_barrier(0); \
                      if (i_ & 1) s1 = MFMA32(kfr[i_], qfl[i_ >> 1], i_ == 1 ? negm : s1); else s0 = MFMA32(kfr[i_], qfl[i_ >> 1], i_ == 0 ? negm : s0); \
                      __builtin_amdgcn_sched_barrier(0); } \
                  float mxa, mxb, rm, delta = 0.f, alpha = 1.f; f32x2 ps2 = {0.f, 0.f}; \
                _Pragma("unroll") \
                  for (int i_ = 0; i_ < 16; ++i_) { \
                      if (i_ + 2 < 16) { const int v_ = i_ + 2; vfr[v_] = cat8(trr(VFA(v_)), trr(VFA(v_) + 8 * VSTR)); } \
                      __builtin_amdgcn_sched_barrier(0); \
                      o[i_ & 3] = MFMA32(vfr[i_], pfp[i_ >> 2], o[i_ & 3]); \
                        \
                      if (i_ == 0) { mxa = max3f(s0[0], s0[1], s1[0]); mxb = max3f(s0[2], s0[3], s1[1]); mxa = max3f(mxa, s1[2], s1[3]); } \
                      if (i_ >= 1 && i_ <= 3) { const int r = 4 * i_; mxa = max3f(mxa, s0[r], s0[r + 1]); mxb = max3f(mxb, s0[r + 2], s0[r + 3]); mxa = max3f(mxa, s1[r], s1[r + 1]); mxb = max3f(mxb, s1[r + 2], s1[r + 3]); } \
                      if (i_ == 3) { rm = max3f(mxa, mxb, mxa); rm = max3f(rm, shx(rm, 32, lane), rm); } \
                      if (i_ == 4) { \
                          if (first || __any(rm > ATT_THR)) { delta = first ? rm : max3f(rm, 0.f, 0.f); const f32x2 mm2 = {delta, delta}; \
                              _Pragma("unroll") \
                              for (int r = 0; r < 16; r += 2) { const f32x2 a_ = (f32x2){s0[r], s0[r + 1]} - mm2, b_ = (f32x2){s1[r], s1[r + 1]} - mm2; s0[r] = a_.x; s0[r + 1] = a_.y; s1[r] = b_.x; s1[r + 1] = b_.y; } \
                              alpha = first ? 1.f : ex2(-delta); mref = first ? delta : mref + delta; first = false; \
                              _Pragma("unroll") \
                              for (int r = 0; r < 16; ++r) negm[r] = -mref; } } \
                      if (i_ >= 5) { const int e0 = (i_ - 5) * 3; \
                          _Pragma("unroll") \
                          for (int e_ = e0; e_ < e0 + 3 && e_ < 32; ++e_) { if (e_ < 16) s0[e_] = ex2(s0[e_]); else s1[e_ - 16] = ex2(s1[e_ - 16]); } } \
                      __builtin_amdgcn_sched_barrier(0); } \
                    \
                _Pragma("unroll") \
                  for (int r = 0; r < 16; r += 2) ps2 += (f32x2){s0[r], s0[r + 1]} + (f32x2){s1[r], s1[r + 1]}; \
                  lrun = lrun * alpha + (ps2.x + ps2.y); alpha_prev = alpha; \
                  pfp[0] = pack8(s0, 0); pfp[1] = pack8(s0, 8); pfp[2] = pack8(s1, 0); pfp[3] = pack8(s1, 8); } \
                asm volatile("s_waitcnt vmcnt(3)" ::: "memory"); \
                LBAR(); \
                ks_cur = (ks_cur == 2 * KBYTES) ? 0 : ks_cur + KBYTES; ks_stage = (ks_stage == 2 * KBYTES) ? 0 : ks_stage + KBYTES; \
            } while (0)
            for (int t = 0; t < NT; t += 2) { ATT_ITER(t, 0, 0, 0, 0, 0, 0); ATT_ITER(t + 1, 0, 0, 0, 0, 0, 0); }
            asm volatile("s_waitcnt vmcnt(0)" ::: "memory");
#undef ATT_ITER
#undef KFA
#undef VFA
#undef ATT_DMA_K
#undef ATT_DMA_V
            {
#pragma unroll
                for (int d0 = 0; d0 < 4; ++d0)
#pragma unroll
                    for (int r = 0; r < 16; ++r) o[d0][r] *= alpha_prev;
                LAS unsigned char* vb_ = lds + VBASE + ((NT - 1) & 3) * VBYTES + vtr_off;
#pragma unroll
                for (int ks = 0; ks < 4; ++ks)
#pragma unroll
                    for (int d0 = 0; d0 < 4; ++d0) { LAS unsigned char* vp = vb_ + (16 * ks) * VSTR + ((d0 ^ qq) << 6);
                        const bf16x8 vf = cat8(trr(vp), trr(vp + 8 * VSTR)); o[d0] = MFMA32(vf, pfp[ks], o[d0]); } }
            lrun += shx(lrun, 32, lane);
            const float inv = 1.f / lrun;
            GAS float* o1p = (GAS float*)(o1s + tid); asm volatile("" : "+v"(o1p));
            if (c == 0) {
#pragma unroll
                for (int d0 = 0; d0 < 4; ++d0)
#pragma unroll
                    for (int r = 0; r < 16; ++r) o1p[(d0 * 16 + r) * 512] = o[d0][r] * inv;
            } else {
                float ss = 0.f;
#pragma unroll
                for (int d0 = 0; d0 < 4; ++d0)
#pragma unroll
                    for (int r = 0; r < 16; ++r) { const float v = o1p[(d0 * 16 + r) * 512] - lam * (o[d0][r] * inv); o[d0][r] = v; ss += v * v; }
                ss += shx(ss, 32, lane);
                const float rstd = rsqrtf(ss * (1.f / 128.f) + 1e-5f) * oscale;
                GAS bf16* orow = (GAS bf16*)(OB + (rowbase + q0 + l31) * DM + h * 128); asm volatile("" : "+v"(orow));
#pragma unroll
                for (int d0 = 0; d0 < 4; ++d0)
#pragma unroll
                    for (int rg = 0; rg < 4; ++rg) { const int d = 32 * d0 + 8 * rg + 4 * hh; const f32x4 w4 = *(GAS const f32x4*)(subln + d);
                        u32x2 wv; wv.x = cvtpk(o[d0][4 * rg] * rstd * w4.x, o[d0][4 * rg + 1] * rstd * w4.y); wv.y = cvtpk(o[d0][4 * rg + 2] * rstd * w4.z, o[d0][4 * rg + 3] * rstd * w4.w);
                        *(GAS u32x2*)(orow + d) = wv; }
            }
        }
    }
}

__device__ __forceinline__ void scan_phase(LAS unsigned char* lds, const bf16* Q, const bf16* K, const bf16* V, bf16* OF, bf16* OBK, int S, int nbatch, int vcu, int G, const float* decay, const int wave) {
    const int n = S / 128, nunits = nbatch * 64, per = (nunits + G - 1) / G;
    constexpr int KSTR = 576, VSTR = 192, RSTR = 528, KT = 0, VT = 128 * KSTR, RT = VT + 128 * VSTR;
    for (int it = 0; it < per; ++it) {
    int tid_l = tid_of(wave); asm volatile("" : "+v"(tid_l));
    const int tid = tid_l, lane = tid & 63, w = __builtin_amdgcn_readfirstlane(tid >> 6), l31 = lane & 31, hh = lane >> 5;
    const int i15 = lane & 15, qq = i15 >> 2, pp = i15 & 3, cg16 = 16 * ((lane >> 4) & 1) + 4 * pp;
    const int tb = w >> 1, nbk = w & 1;
        const int u = vcu * per + it; if (u >= nunits) break;
        const int dir = u & 1, j = (u >> 1) & 7, h = (u >> 4) & 3, b = u >> 6;
        const float lg2 = -__expf(((GAS const float*)decay)[dir * 4 + h]) * LOG2E;
        const float cd = ex2(lg2 * 128.f);
        bf16* OD = dir ? OBK : OF;
        f32x16 racc[2];
#pragma unroll
        for (int r = 0; r < 16; ++r) { racc[0][r] = 0.f; racc[1][r] = 0.f; }
        u32x4 kreg[8], vreg[2];
        { const int c = dir ? n - 1 : 0; const size_t rowb = (size_t)b * S + (size_t)c * 128;
#pragma unroll
          for (int ii = 0; ii < 8; ++ii) { const int idx = tid + 512 * ii, row = idx >> 5, ch = idx & 31; kreg[ii] = *(GAS const u32x4*)(K + (rowb + row) * DM + h * 256 + ch * 8); }
#pragma unroll
          for (int ii = 0; ii < 2; ++ii) { const int idx = tid + 512 * ii, row = idx >> 3, ch = idx & 7; vreg[ii] = *(GAS const u32x4*)(V + (rowb + row) * 2048 + h * 512 + j * 64 + ch * 8); } }
        bf16x8 qfr[8];
        { const int c = dir ? n - 1 : 0; GAS const bf16* qp = (GAS const bf16*)(Q + ((((size_t)b * S + (size_t)c * 128 + 32 * tb) >> 5) * 4 + h) * 8192 + hh * 256 + l31 * 8);
#pragma unroll
          for (int ks = 0; ks < 8; ++ks) qfr[ks] = *(GAS const bf16x8*)(qp + 512 * ks); }
        __syncthreads();
        for (int step = 0; step < n; ++step) {
            const int c = dir ? n - 1 - step : step; const size_t rowb = (size_t)b * S + (size_t)c * 128;
            bf16x8 qlate[8];
            { GAS const bf16* qp = (GAS const bf16*)(Q + (((rowb + 32 * tb) >> 5) * 4 + h) * 8192 + hh * 256 + l31 * 8);
#pragma unroll
              for (int ks = 0; ks < 8; ++ks) qlate[ks] = *(GAS const bf16x8*)(qp + 512 * (8 + ks)); }
            asm volatile("" ::: "memory");
#pragma unroll
            for (int ii = 0; ii < 8; ++ii) { const int idx = tid + 512 * ii, row = idx >> 5, ch = idx & 31; *(LAS u32x4*)(lds + KT + row * KSTR + ch * 16) = kreg[ii]; }
#pragma unroll
            for (int ii = 0; ii < 2; ++ii) { const int idx = tid + 512 * ii, row = idx >> 3, ch = idx & 7;
                const float z = ex2(lg2 * (float)(dir ? row : 127 - row)); const u32x4 v = vreg[ii]; u32x4 o;
                o.x = cvtpk(__uint_as_float(v.x << 16) * z, __uint_as_float(v.x & 0xffff0000u) * z); o.y = cvtpk(__uint_as_float(v.y << 16) * z, __uint_as_float(v.y & 0xffff0000u) * z);
                o.z = cvtpk(__uint_as_float(v.z << 16) * z, __uint_as_float(v.z & 0xffff0000u) * z); o.w = cvtpk(__uint_as_float(v.w << 16) * z, __uint_as_float(v.w & 0xffff0000u) * z);
                *(LAS u32x4*)(lds + VT + row * VSTR + ch * 16) = o; }
#pragma unroll
            for (int nb2 = 0; nb2 < 2; ++nb2)
#pragma unroll
                for (int rg = 0; rg < 4; ++rg) { u32x2 wv; wv.x = cvtpk(racc[nb2][4 * rg], racc[nb2][4 * rg + 1]); wv.y = cvtpk(racc[nb2][4 * rg + 2], racc[nb2][4 * rg + 3]);
                    *(LAS u32x2*)(lds + RT + (32 * nb2 + l31) * RSTR + (32 * w + 8 * rg + 4 * hh) * 2) = wv; }
            LBAR();
            if (step + 1 < n) { const int c2 = dir ? c - 1 : c + 1; const size_t rb2 = (size_t)b * S + (size_t)c2 * 128;
#pragma unroll
                for (int ii = 0; ii < 8; ++ii) { const int idx = tid + 512 * ii, row = idx >> 5, ch = idx & 31; kreg[ii] = *(GAS const u32x4*)(K + (rb2 + row) * DM + h * 256 + ch * 8); }
#pragma unroll
                for (int ii = 0; ii < 2; ++ii) { const int idx = tid + 512 * ii, row = idx >> 3, ch = idx & 7; vreg[ii] = *(GAS const u32x4*)(V + (rb2 + row) * 2048 + h * 512 + j * 64 + ch * 8); } }
            { f32x16 acc;
#pragma unroll
              for (int r = 0; r < 16; ++r) acc[r] = 0.f;
              LAS unsigned char* rp = lds + RT + (32 * nbk + l31) * RSTR + 16 * hh;
#pragma unroll
              for (int ks = 0; ks < 8; ++ks) { const bf16x8 bfr = *(LAS bf16x8*)(rp + 32 * ks); acc = MFMA32(bfr, qfr[ks], acc); }
#pragma unroll
              for (int ks = 0; ks < 8; ++ks) { const bf16x8 bfr = *(LAS bf16x8*)(rp + 32 * (8 + ks)); acc = MFMA32(bfr, qlate[ks], acc); }
              if (step + 1 < n) { const int c2 = dir ? c - 1 : c + 1; GAS const bf16* qp = (GAS const bf16*)(Q + ((((size_t)b * S + (size_t)c2 * 128 + 32 * tb) >> 5) * 4 + h) * 8192 + hh * 256 + l31 * 8);
#pragma unroll
                  for (int ks = 0; ks < 8; ++ks) qfr[ks] = *(GAS const bf16x8*)(qp + 512 * ks); }
              const int tok = 32 * tb + l31; const float xi = ex2(lg2 * (float)(dir ? 128 - tok : tok + 1));
              GAS bf16* op = (GAS bf16*)(OD + (rowb + 16 * j + 8 * nbk + hh) * 2048 + h * 512 + tok * 4);
#pragma unroll
              for (int rg = 0; rg < 4; ++rg) { u32x2 wv; wv.x = cvtpk(acc[4 * rg] * xi, acc[4 * rg + 1] * xi); wv.y = cvtpk(acc[4 * rg + 2] * xi, acc[4 * rg + 3] * xi); *(GAS u32x2*)(op + (size_t)(2 * rg) * 2048) = wv; } }
#pragma unroll
            for (int r = 0; r < 16; ++r) { racc[0][r] *= cd; racc[1][r] *= cd; }
#pragma unroll
            for (int ks = 0; ks < 8; ++ks) { const int row = 16 * ks + 8 * hh + qq;
                LAS unsigned char* kp = lds + KT + row * KSTR + (32 * w + cg16) * 2; const bf16x8 af = cat8(trr(kp), trr(kp + 4 * KSTR));
                LAS unsigned char* vp = lds + VT + row * VSTR + cg16 * 2; const bf16x8 b0 = cat8(trr(vp), trr(vp + 4 * VSTR)), b1 = cat8(trr(vp + 64), trr(vp + 64 + 4 * VSTR));
                racc[0] = MFMA32(af, b0, racc[0]); racc[1] = MFMA32(af, b1, racc[1]); }
            LBAR();
        }
    }
}

__device__ __forceinline__ void intra_phase(LAS unsigned char* lds, const bf16* Q, const bf16* K, const bf16* V, bf16* OF, const bf16* OBK, int S, int nbatch, int vcu, int G, const float* decay, const int wave, const bool do_store = true) {
    const int n = S / 128, nunits = nbatch * 4 * n, per = (nunits + G - 1) / G;
    constexpr int KSTR = 528, VSTR = 320, KT = 0, VT = 128 * KSTR, SSB = VT + 128 * VSTR;
    for (int it = 0; it < per; ++it) {
    int tid_l = tid_of(wave); asm volatile("" : "+v"(tid_l));
    const int tid = tid_l, lane = tid & 63, w = __builtin_amdgcn_readfirstlane(tid >> 6), l31 = lane & 31, hh = lane >> 5;
    const int i15 = lane & 15, qq = i15 >> 2, pp = i15 & 3, cg16 = 16 * ((lane >> 4) & 1) + 4 * pp;
    const int qb = w >> 1, par = w & 1;
        const int u = vcu * per + it; if (u >= nunits) break;
        const int c = u % n, bh = u / n, h = bh & 3, b = bh >> 2;
        const float lgf2 = -__expf(((GAS const float*)decay)[h]) * LOG2E, lgb2 = -__expf(((GAS const float*)decay)[4 + h]) * LOG2E;
        const size_t rowb = (size_t)b * S + (size_t)c * 128;
        __syncthreads();
#pragma unroll
        for (int ii = 0; ii < 8; ++ii) { const int idx = tid + 512 * ii, row = idx >> 5, ch = idx & 31; *(LAS u32x4*)(lds + KT + row * KSTR + ch * 16) = *(GAS const u32x4*)(K + (rowb + row) * DM + h * 256 + ch * 8); }
        u32x4 vreg[4];
#pragma unroll
        for (int ii = 0; ii < 4; ++ii) { const int idx = tid + 512 * ii, row = idx >> 4, ch = idx & 15; vreg[ii] = *(GAS const u32x4*)(V + (rowb + row) * 2048 + h * 512 + ch * 8); }
        __syncthreads();
        bf16x8 pf[8];
        { f32x16 X[4];
#pragma unroll
          for (int k4 = 0; k4 < 4; ++k4)
#pragma unroll
              for (int r = 0; r < 16; ++r) X[k4][r] = 0.f;
          GAS const bf16* qp = (GAS const bf16*)(Q + (((rowb + 32 * qb) >> 5) * 4 + h) * 8192 + hh * 256 + l31 * 8); LAS unsigned char* kp = lds + KT + l31 * KSTR + 16 * hh;
#pragma unroll
          for (int ks = 0; ks < 16; ++ks) { const bf16x8 bq = *(GAS const bf16x8*)(qp + 512 * ks);
#pragma unroll
              for (int k4 = 0; k4 < 4; ++k4) { const bf16x8 a = *(LAS bf16x8*)(kp + 32 * k4 * KSTR + 32 * ks); X[k4] = MFMA32(a, bq, X[k4]); } }
          const int iq = 32 * qb + l31;
#pragma unroll
          for (int k4 = 0; k4 < 4; ++k4) {
#pragma unroll
              for (int r = 0; r < 16; ++r) { const int d = iq - (32 * k4 + crow(r, hh)); X[k4][r] *= ex2(d >= 0 ? lgf2 * (float)d : -lgb2 * (float)d); }
              pf[2 * k4] = pack8(X[k4], 0); pf[2 * k4 + 1] = pack8(X[k4], 8); } }
        f32x16 z[8];
#pragma unroll
        for (int t = 0; t < 8; ++t)
#pragma unroll
            for (int r = 0; r < 16; ++r) z[t][r] = 0.f;
#pragma unroll
        for (int p = 0; p < 4; ++p) {
#pragma unroll
            for (int ii = 0; ii < 4; ++ii) { const int idx = tid + 512 * ii, row = idx >> 4, ch = idx & 15; *(LAS u32x4*)(lds + VT + row * VSTR + ch * 16) = vreg[ii]; }
            LBAR();
            if (p < 3) {
#pragma unroll
                for (int ii = 0; ii < 4; ++ii) { const int idx = tid + 512 * ii, row = idx >> 4, ch = idx & 15; vreg[ii] = *(GAS const u32x4*)(V + (rowb + row) * 2048 + h * 512 + (p + 1) * 128 + ch * 8); } }
#pragma unroll
            for (int bi = 0; bi < 2; ++bi) { const int blk = 2 * bi + par;
#pragma unroll
                for (int ks = 0; ks < 8; ++ks) { LAS unsigned char* vp = lds + VT + (16 * ks + 4 * hh + qq) * VSTR + (32 * blk + cg16) * 2;
                    const bf16x8 vf = cat8(trr(vp), trr(vp + 8 * VSTR)); z[2 * p + bi] = MFMA32(vf, pf[ks], z[2 * p + bi]); } }
            LBAR();
        }
        size_t ebase = (rowb + 32 * qb + l31) * 2048 + h * 512 + 32 * par + 4 * hh; asm volatile("" : "+v"(ebase));
        size_t xbase = (rowb + 8 * par + hh) * 2048 + h * 512 + (32 * qb + l31) * 4; asm volatile("" : "+v"(xbase));
        float ssq = 0.f;
#pragma unroll
        for (int t = 0; t < 8; ++t) { const int co = 128 * (t >> 1) + 64 * (t & 1);
#pragma unroll
            for (int rg = 0; rg < 4; ++rg) { const size_t xo_ = xbase + (size_t)((co >> 2) + 2 * rg) * 2048; const u32x2 a_ = *(GAS const u32x2*)(OF + xo_), b_ = *(GAS const u32x2*)(OBK + xo_);
                z[t][4 * rg] += __uint_as_float(a_.x << 16) + __uint_as_float(b_.x << 16); z[t][4 * rg + 1] += __uint_as_float(a_.x & 0xffff0000u) + __uint_as_float(b_.x & 0xffff0000u);
                z[t][4 * rg + 2] += __uint_as_float(a_.y << 16) + __uint_as_float(b_.y << 16); z[t][4 * rg + 3] += __uint_as_float(a_.y & 0xffff0000u) + __uint_as_float(b_.y & 0xffff0000u);
                ssq += z[t][4 * rg] * z[t][4 * rg] + z[t][4 * rg + 1] * z[t][4 * rg + 1] + z[t][4 * rg + 2] * z[t][4 * rg + 2] + z[t][4 * rg + 3] * z[t][4 * rg + 3]; }
            asm volatile("" ::: "memory"); }
        ssq += shx(ssq, 32, lane);
        LAS float* ssb = (LAS float*)(lds + SSB);
        if (hh == 0) ssb[w * 32 + l31] = ssq;
        __syncthreads();
        const float rstd = rsqrtf((ssq + ssb[(w ^ 1) * 32 + l31]) * (1.f / 512.f) + 1e-6f);
        asm volatile("" : "+v"(ebase));
#pragma unroll
        for (int t = 0; t < 8; ++t) { const int co = 128 * (t >> 1) + 64 * (t & 1);
#pragma unroll
            for (int rg = 0; rg < 4; ++rg) { u32x2 wv; wv.x = cvtpk(z[t][4 * rg] * rstd, z[t][4 * rg + 1] * rstd); wv.y = cvtpk(z[t][4 * rg + 2] * rstd, z[t][4 * rg + 3] * rstd); if (do_store) *(GAS u32x2*)(OF + ebase + co + 8 * rg) = wv; }
            asm volatile("" ::: "memory"); }
    }
}

#define XB_TMO      128
#define XB_XCNT(j)  (256  + 64 * (j))
#define XB_XSUB(j)  (1280 + 64 * (j))
#define XB_XGEN(j)  (2304 + 64 * (j))
#define XB_TOP      3328
#define XB_TOPGEN   3392
#define XCD_BAR_WORDS 3456
#define XB_SPIN_CAP (1u << 18)

__device__ __forceinline__ unsigned xb_ld(unsigned* p)              { return __hip_atomic_load(p, __ATOMIC_RELAXED, __HIP_MEMORY_SCOPE_AGENT); }
__device__ __forceinline__ unsigned xb_add(unsigned* p, unsigned v) { return __hip_atomic_fetch_add(p, v, __ATOMIC_RELAXED, __HIP_MEMORY_SCOPE_AGENT); }
__device__ __forceinline__ unsigned xb_xcc_id() { return (unsigned)__builtin_amdgcn_s_getreg((3 << 11) | 20) & 0xFu; }
#define XB_SPIN(cond, bar) do { unsigned _sp = 0; while (cond) { __builtin_amdgcn_s_sleep(1); \
    if ((++_sp & 255u) == 0u) { if (xb_ld(&(bar)[XB_TMO])) break; if (_sp > XB_SPIN_CAP) { atomicAdd(&(bar)[XB_TMO], 1u); break; } } } } while (0)

struct XcdBarrier {
    unsigned* bar; unsigned x;
    volatile LAS unsigned* st;
};

__device__ __forceinline__ XcdBarrier xcd_barrier_post(unsigned* bar, volatile LAS unsigned* st, const bool tid0) {
    XcdBarrier b; b.bar = bar; b.x = xb_xcc_id(); b.st = st;
    if (tid0) (void)xb_add(&bar[XB_XCNT(b.x)], 1u);
    return b;
}
__device__ __forceinline__ void xcd_barrier_complete(unsigned* bar, unsigned x, unsigned& nloc, unsigned& nx) {
    const unsigned G = gridDim.x * gridDim.y * gridDim.z;
    unsigned sum, cnt, mine, sp = 0u;
    for (;;) {
        sum = 0u; cnt = 0u; mine = 0u;
#pragma unroll
        for (unsigned j = 0; j < 16; ++j) { const unsigned c = xb_ld(&bar[XB_XCNT(j)]); sum += c; cnt += (c > 0u) ? 1u : 0u; mine = (j == x) ? c : mine; }
        if (sum == G) break;
        __builtin_amdgcn_s_sleep(1);
        if ((++sp & 255u) == 0u) { if (xb_ld(&bar[XB_TMO])) break; if (sp > XB_SPIN_CAP) { atomicAdd(&bar[XB_TMO], 1u); break; } }
    }
    nloc = mine > 0u ? mine : 1u; nx = cnt > 0u ? cnt : 1u;
}

__device__ __forceinline__ void xcd_barrier(const XcdBarrier& b, const bool tid0) {
    asm volatile("s_waitcnt vmcnt(0)" ::: "memory");
    __syncthreads();
    if (tid0) {
        unsigned* bar = b.bar;
        __builtin_amdgcn_s_waitcnt(0);
        unsigned nloc = b.st[0], nx = b.st[1];
        if (nloc == 0u) { xcd_barrier_complete(bar, b.x, nloc, nx); b.st[0] = nloc; b.st[1] = nx; }
        const unsigned old = xb_add(&bar[XB_XSUB(b.x)], 1u);
        const unsigned gen = old / nloc;
        if (old + 1u == (gen + 1u) * nloc) {
            __builtin_amdgcn_fence(__ATOMIC_RELEASE, "agent");
            asm volatile("s_waitcnt vmcnt(0)" ::: "memory");
            const unsigned og = xb_add(&bar[XB_TOP], 1u);
            const unsigned tg = og / nx;
            if (og + 1u == (tg + 1u) * nx) xb_add(&bar[XB_TOPGEN], 1u);
            else XB_SPIN(xb_ld(&bar[XB_TOPGEN]) == tg, bar);
            __builtin_amdgcn_fence(__ATOMIC_ACQUIRE, "agent");
            xb_add(&bar[XB_XGEN(b.x)], 1u);
            asm volatile("s_waitcnt vmcnt(0)" ::: "memory");
        } else {
            XB_SPIN(xb_ld(&bar[XB_XGEN(b.x)]) == gen, bar);
            __builtin_amdgcn_fence(__ATOMIC_ACQUIRE, "agent");
            asm volatile("s_waitcnt vmcnt(0)" ::: "memory");
        }
    }
    __syncthreads();
}

__device__ __forceinline__ void gbar(unsigned* ctr, unsigned target, const int wave) {
    asm volatile("s_waitcnt vmcnt(0)" ::: "memory");
    __syncthreads();
    int t_ = tid_of(wave); asm volatile("" : "+v"(t_));
    if (t_ == 0) {
        __builtin_amdgcn_fence(__ATOMIC_RELEASE, "agent");
        asm volatile("s_waitcnt vmcnt(0) lgkmcnt(0)" ::: "memory");
        __hip_atomic_fetch_add(ctr, 1u, __ATOMIC_RELAXED, __HIP_MEMORY_SCOPE_AGENT);
        while (__hip_atomic_load(ctr, __ATOMIC_RELAXED, __HIP_MEMORY_SCOPE_AGENT) < target) __builtin_amdgcn_s_sleep(2);
        __builtin_amdgcn_fence(__ATOMIC_ACQUIRE, "agent");
        asm volatile("s_waitcnt vmcnt(0) lgkmcnt(0)" ::: "memory");
    }
    __syncthreads();
}
#define GSYNC() do { nsync += (unsigned)Gn; gbar(gctr, nsync, wave); } while (0)

#define GEMM_CALL(EPI_T, A_, B_, M_, N_, K_, E_) do { pg8::Gemm g_{(const pg8::bf16_t*)(A_), (const pg8::bf16_t*)(B_), (M_), (N_), (K_)}; pg8::StaticOrder S_; S_.init((M_), (N_), Gn, (int)blockIdx.x); \
    pg8::gemm_phase<EPI_T, pg8::StaticOrder, true, true>(lds, g_, S_, (E_), wave); } while (0)

#ifdef DBG
__device__ __forceinline__ void dbg_acc(unsigned char* ws, int id, float err2, float ref2, int lane) { if (lane == 0) { atomicAdd((float*)(ws + WS_CTL + 1024) + 2 * id, err2); atomicAdd((float*)(ws + WS_CTL + 1024) + 2 * id + 1, ref2); } }
__device__ __forceinline__ float wsum_d(float v) { for (int o = 1; o < 64; o <<= 1) v += __shfl_xor(v, o); return v; }
__device__ __forceinline__ float dbg_dot(const bf16* arow, const float* W, int K, int N, int col, int lane) { float a = 0.f; for (int k = lane; k < K; k += 64) a += bf2f(arow[k]) * W[(size_t)k * N + col]; return wsum_d(a); }
__device__ __forceinline__ void dbg_gemm(unsigned char* ws, int id, const bf16* A, const float* W, int K, int N, const void* O, int ldo, int mode, int gwv, int lane) {
    if (gwv >= 256) return;
    const int row = (gwv * 2731 + 17) % TG, col = (gwv * 977 + 5) % N;
    float ref = dbg_dot(A + (size_t)row * K, W, K, N, col, lane), got;
    if (mode == 0) got = ((const float*)O)[(size_t)row * ldo + col]; else if (mode == 2) got = bf2f(((const bf16*)O)[(size_t)row * ldo + col]); else { ref = fmaxf(ref, 0.f); ref *= ref; got = bf2f(((const bf16*)O)[(size_t)row * ldo + col]); }
    dbg_acc(ws, id, (got - ref) * (got - ref), ref * ref, lane);
}
__device__ __forceinline__ void dbg_attn_qkv(unsigned char* ws, int id, const bf16* A, const float* W, const bf16* Qb, const bf16* Kb, const bf16* Vb, int S, int gwv, int lane) {
    if (gwv >= 256) return;
    const int row = (gwv * 2731 + 17) % TG, col = (gwv * 1549 + 3) % 3072, region = col >> 10, cr = col & 1023, d = cr & 63, s = row % S;
    float x = dbg_dot(A + (size_t)row * 1024, W, 1024, 3072, col, lane), ref, got;
    if (region == 2) { ref = x; got = bf2f(Vb[(size_t)row * 1024 + cr]); }
    else { const int pc = d < 32 ? col + 32 : col - 32; const float xp = dbg_dot(A + (size_t)row * 1024, W, 1024, 3072, pc, lane);
        const float inv = ex2(-13.287712379549449f * (float)(2 * (d & 31)) / 64.0f); const double ad = (double)((float)s * inv); const float ang = (float)(ad - 6.283185307179586 * floor(ad / 6.283185307179586)); const float rot = d < 32 ? -xp : xp;
        ref = x * __cosf(ang) + rot * __sinf(ang); if (region == 0) ref *= 0.125f * LOG2E; got = bf2f((region == 0 ? Qb : Kb)[(size_t)row * 1024 + cr]); }
    dbg_acc(ws, id, (got - ref) * (got - ref), ref * ref, lane);
}
__device__ __forceinline__ void dbg_ret_qkv(unsigned char* ws, int id, const bf16* A, const float* W, const bf16* Qb, const bf16* Kb, const bf16* Vb, int S, int gwv, int lane) {
    if (gwv >= 256) return;
    const int row = (gwv * 2731 + 17) % TG, col = (gwv * 1549 + 3) % 4096, s = row % S;
    float x = dbg_dot(A + (size_t)row * 1024, W, 1024, 6144, col, lane), ref, got;
    if (col >= 2048) { ref = x; got = bf2f(Vb[(size_t)row * 2048 + col - 2048]); }
    else { const float xp = dbg_dot(A + (size_t)row * 1024, W, 1024, 6144, col ^ 1, lane); const int pi = (col & 255) >> 1;
        const float a = ex2(-13.287712379549449f * (float)pi / 127.0f); const double ad = (double)((float)s * a); const float ang = (float)(ad - 6.283185307179586 * floor(ad / 6.283185307179586)); const float rot = (col & 1) ? xp : -xp;
        ref = x * __cosf(ang) + rot * __sinf(ang); if (col >= 1024) ref *= 0.0625f; got = bf2f((col < 1024 ? Qb : Kb)[(size_t)row * 1024 + (col & 1023)]); }
    dbg_acc(ws, id, (got - ref) * (got - ref), ref * ref, lane);
}
__device__ __forceinline__ void dbg_attn(unsigned char* ws, int id, const bf16* Qb, const bf16* Kb, const bf16* Vb, const bf16* OB, int S, int NB, float lam, float oscale, const float* subln, int gwv, int lane) {
    if (gwv >= 32) return;
    const int b = gwv % NB, s = (gwv * 389 + 7) % S, h = (gwv * 5 + 1) & 7; const size_t row = (size_t)b * S + s, rb = (size_t)b * S;
    float of0 = 0.f, of1 = 0.f;
    for (int c = 0; c < 2; ++c) {
        const float q = bf2f(Qb[row * 1024 + h * 128 + c * 64 + lane]);
        float mr = -1e30f, l = 0.f, o0 = 0.f, o1 = 0.f;
        for (int m = 0; m < S; ++m) {
            const float sc = wsum_d(q * bf2f(Kb[(rb + m) * 1024 + h * 128 + c * 64 + lane]));
            const float mn = fmaxf(mr, sc), al = exp2f(mr - mn), p = exp2f(sc - mn); mr = mn;
            l = l * al + p; o0 = o0 * al + p * bf2f(Vb[(rb + m) * 1024 + h * 128 + lane]); o1 = o1 * al + p * bf2f(Vb[(rb + m) * 1024 + h * 128 + 64 + lane]);
        }
        if (c == 0) { of0 = o0 / l; of1 = o1 / l; } else { of0 -= lam * o0 / l; of1 -= lam * o1 / l; }
    }
    const float ss = wsum_d(of0 * of0 + of1 * of1), r = rsqrtf(ss / 128.f + 1e-5f) * oscale;
    const float r0 = of0 * r * subln[lane], r1 = of1 * r * subln[64 + lane];
    const float g0 = bf2f(OB[row * 1024 + h * 128 + lane]), g1 = bf2f(OB[row * 1024 + h * 128 + 64 + lane]);
    dbg_acc(ws, id, wsum_d((g0 - r0) * (g0 - r0) + (g1 - r1) * (g1 - r1)), wsum_d(r0 * r0 + r1 * r1), lane);
}
__device__ __forceinline__ void dbg_ret(unsigned char* ws, int id, const bf16* Qb, const bf16* Kb, const bf16* Vb, const bf16* OB, int S, int NB, const float* decay, int gwv, int lane) {
    if (gwv >= 32) return;
    const int b = gwv % NB, n = (gwv * 389 + 7) % S, h = (gwv * 3 + 1) & 3; const size_t row = (size_t)b * S + n, rb = (size_t)b * S;
    const float lgf = -expf(decay[h]), lgb = -expf(decay[4 + h]);
    float q[4], o[8];
#pragma unroll
    for (int t = 0; t < 4; ++t) q[t] = bf2f(Qb[row * 1024 + h * 256 + lane + 64 * t]);
#pragma unroll
    for (int t = 0; t < 8; ++t) o[t] = 0.f;
    for (int m = 0; m < S; ++m) {
        float a = 0.f;
#pragma unroll
        for (int t = 0; t < 4; ++t) a += q[t] * bf2f(Kb[(rb + m) * 1024 + h * 256 + lane + 64 * t]);
        a = wsum_d(a) * (m <= n ? expf(lgf * (float)(n - m)) : expf(lgb * (float)(m - n)));
#pragma unroll
        for (int t = 0; t < 8; ++t) o[t] += a * bf2f(Vb[(rb + m) * 2048 + h * 512 + lane + 64 * t]);
    }
    float ss = 0.f;
#pragma unroll
    for (int t = 0; t < 8; ++t) ss += o[t] * o[t];
    const float r = rsqrtf(wsum_d(ss) / 512.f + 1e-6f); float e2 = 0.f, r2 = 0.f;
#pragma unroll
    for (int t = 0; t < 8; ++t) { const float rf = o[t] * r, gt = bf2f(OB[row * 2048 + h * 512 + lane + 64 * t]); e2 += (gt - rf) * (gt - rf); r2 += rf * rf; }
    dbg_acc(ws, id, wsum_d(e2), wsum_d(r2), lane);
}

__device__ __forceinline__ void dbg_rp(unsigned char* ws, int id, const float* xold, const float* xnew, const float* m, const float* wpost, const float* wpre, const bf16* hb, int gwv, int lane) {
    if (gwv >= 64) return;
    const int row = (gwv * 2731 + 17) % TG; float e2 = 0.f, r2 = 0.f, ss = 0.f, xs[16];
    if (m) { for (int k = lane; k < 1024; k += 64) { const float v = m[(size_t)row * 1024 + k]; ss += v * v; } }
    const float r = rsqrtf(wsum_d(ss) / 1024.f + 1e-6f); float s2 = 0.f;
#pragma unroll
    for (int t = 0; t < 16; ++t) { const int k = lane + 64 * t; float v = xold ? xold[(size_t)row * 1024 + k] : xnew[(size_t)row * 1024 + k]; if (m) v += m[(size_t)row * 1024 + k] * r * wpost[k]; xs[t] = v; s2 += v * v;
        if (xold) { const float g = xnew[(size_t)row * 1024 + k]; e2 += (g - v) * (g - v); r2 += v * v; } }
    const float rr = rsqrtf(wsum_d(s2) / 1024.f + 1e-6f);
#pragma unroll
    for (int t = 0; t < 16; ++t) { const int k = lane + 64 * t; const float rf = xs[t] * rr * (wpre ? wpre[k] : 1.f), g = bf2f(hb[(size_t)row * 1024 + k]); e2 += (g - rf) * (g - rf); r2 += rf * rf; }
    dbg_acc(ws, id, wsum_d(e2), wsum_d(r2), lane);
}
#endif

#ifndef REP_MASK
#define REP_MASK 0
#endif
#ifndef DBG_MASK
#define DBG_MASK 255
#endif
#ifndef DBG_G
#define DBG_G 0
#endif
#ifndef DBG_TOL
#define DBG_TOL 1e-3f
#endif
#define PT_OFF 146944
__device__ __forceinline__ unsigned long long ldpk(int k) { unsigned a = (unsigned)(PT_OFF + 8 * k); asm volatile("" : "+s"(a)); const unsigned long long v = *(LAS unsigned long long*)a;
    const unsigned lo = __builtin_amdgcn_readfirstlane((unsigned)v), hi = __builtin_amdgcn_readfirstlane((unsigned)(v >> 32)); return ((unsigned long long)hi << 32) | lo; }
#define PIN(k) ((const float*)ldpk(k))
#define WSP ((unsigned char*)ldpk(23))
#define GW (vcu * 8 + wave)
#define NGW (Gn * 8)
#define GCTR ((unsigned*)(WSP + WS_CTL))
#undef GSYNC
#define XBAR_WORDS ((unsigned*)(WSP + WS_CTL + 16384))
#define XBAR_ST ((volatile LAS unsigned*)(lds + PT_OFF + 320))
#define GSYNC() do { int t_ = tid_of(wave); asm volatile("" : "+v"(t_)); XcdBarrier xb_; xb_.bar = XBAR_WORDS; xb_.x = xb_xcc_id(); xb_.st = XBAR_ST; xcd_barrier(xb_, t_ == 0); } while (0)
#define XP ((float*)ldpk(22) + (size_t)g * TG * DM)
#define WBP ((bf16*)(WSP + WS_W))
#define HBP ((bf16*)(WSP + WS_HB))
#define PBP ((bf16*)(WSP + WS_PB))
#define OBP ((bf16*)(WSP + WS_OB))
#define BIGP (WSP + WS_BIG)
__global__ void __launch_bounds__(512) fwd_mega(Params P) {
    extern __shared__ __attribute__((aligned(16))) unsigned char lds_raw[];
    LAS unsigned char* lds = (LAS unsigned char*)lds_raw;
    cg::grid_group grid = cg::this_grid();
    const int wave = __builtin_amdgcn_readfirstlane(threadIdx.x >> 6);
    const int Gn = gridDim.x, bx = blockIdx.x, vcu = (Gn % 8 == 0) ? (bx % 8) * (Gn / 8) + bx / 8 : bx;
    { LAS unsigned long long* PT = (LAS unsigned long long*)(lds + PT_OFF);
      if (threadIdx.x < 22) PT[threadIdx.x] = (unsigned long long)P.in[threadIdx.x];
      if (threadIdx.x == 22) PT[22] = (unsigned long long)P.out;
      if (threadIdx.x == 23) PT[23] = (unsigned long long)P.ws; }
    if (threadIdx.x >= 32 && threadIdx.x < 40) ((LAS unsigned long long*)(lds + PT_OFF + 256))[threadIdx.x - 32] = 0ull;
    if (threadIdx.x == 40) { ((LAS unsigned*)(lds + PT_OFF + 320))[0] = 0u; ((LAS unsigned*)(lds + PT_OFF + 320))[1] = 0u; }
    __syncthreads();
    (void)xcd_barrier_post((unsigned*)(ldpk(23) + WS_CTL + 16384), (volatile LAS unsigned*)(lds + PT_OFF + 320), threadIdx.x == 0);
    unsigned nsync = 0;

    { unsigned char* ws = WSP; bf16* Wb = (bf16*)(ws + WS_W);
      float* rc = (float*)(ws + WS_TAB + TAB_RC); float* rs = (float*)(ws + WS_TAB + TAB_RS); float* xc = (float*)(ws + WS_TAB + TAB_XC); float* xs = (float*)(ws + WS_TAB + TAB_XS);
      int tid_t = tid_of(wave); asm volatile("" : "+v"(tid_t)); const int gt = (vcu * 512 + tid_t), NT_ = Gn * 512;
#ifndef NO_TAB
      for (int idx = gt; idx < 8192 * 32; idx += NT_) { const int s = idx >> 5, j = idx & 31; const float inv = 1.0f / powf(10000.0f, (float)(2 * j) / 64.0f); const float ang = (float)s * inv; float sn, cs; sincosf(ang, &sn, &cs); rc[idx] = cs; rs[idx] = sn; }
      for (int idx = gt; idx < 8192 * 128; idx += NT_) { const int s = idx >> 7, i = idx & 127; const float a = 1.0f / powf(10000.0f, (float)i / 127.0f); const float ang = (float)s * a; float sn, cs; sincosf(ang, &sn, &cs); xc[idx] = cs; xs[idx] = sn; }
#endif
      LAS float* scr = (LAS float*)(lds + wave * 16384);
#pragma unroll 1
      for (int mi = 0; mi < 32; ++mi) {
          const int kind = mi >> 2, li = mi & 3;
          int pin, K, N, permN = 0; size_t soff, doff;
          switch (kind) {
              case 0: if (li >= 2) continue; pin = 8; K = 1024; N = 3072; permN = 2048; soff = (size_t)li * 1024 * 3072; doff = W_QKV + (size_t)li * 3 * MEL; break;
              case 1: if (li >= 2) continue; pin = 9; K = 1024; N = 1024; soff = (size_t)li * MEL; doff = W_O + (size_t)li * MEL; break;
              case 2: if (li >= 2) continue; pin = 15; K = 1024; N = 6144; soff = (size_t)li * 1024 * 6144; doff = W_RIN + (size_t)li * 6 * MEL; break;
              case 3: if (li >= 2) continue; pin = 16; K = 2048; N = 1024; soff = (size_t)li * 2 * MEL; doff = W_ROUT + (size_t)li * 2 * MEL; break;
              case 4: pin = 18; K = 1024; N = 4096; soff = (size_t)li * 4 * MEL; doff = W_MIN + (size_t)li * 4 * MEL; break;
              case 5: pin = 19; K = 4096; N = 1024; soff = (size_t)li * 4 * MEL; doff = W_MOUT + (size_t)li * 4 * MEL; break;
              case 6: pin = 20; K = 256; N = 1024; soff = (size_t)li * 262144; doff = W_PROJ + (size_t)li * 262144; break;
              default: pin = 21; K = 1024; N = 1024; soff = (size_t)li * MEL; doff = W_GATE + (size_t)li * MEL; break;
          }
          conv_matrix(PIN(pin) + soff, K, N, Wb + doff, permN, scr, GW, NGW, wave);
      }
    }
    grid.sync();
#pragma unroll 1
    for (int step2 = 0; step2 < 2 * 4 * 13 * 2; ++step2) {
        const int step = step2 >> 1;
        if (step2 & 1) { const int ph_ = step % 13, i_ = (step % 52) / 13; if (!(((REP_MASK & 2) && (ph_ == 1 || ph_ == 5 || ph_ == 7 || ph_ == 8)) || ((REP_MASK & 1) && ph_ == 2 && !(i_ & 1)) || ((REP_MASK & 4) && ph_ == 2 && (i_ & 1)))) continue; }
        const int g = step / 52, i = (step % 52) / 13, ph = step % 13, j = i >> 1, ret = i & 1;
#ifdef TIMING
        const unsigned long long t0_ = __builtin_amdgcn_s_memrealtime();
#endif
        const int S = g ? 8192 : 2048, NB = g ? 4 : 16, smask = S - 1;
        switch (ph) {
        case 0: { if (i != 0) continue; rowpass<false, true, true, false>(PIN(g), XP, nullptr, nullptr, PIN(4), HBP, nullptr, nullptr, GW, NGW, wave); } break;
        case 1: {
            unsigned char* B_ = BIGP; unsigned char* ws = WSP;
            if (!ret) { EpiAttnQKV E{(bf16*)B_, (bf16*)(B_ + 64 * MiB), (bf16*)(B_ + 128 * MiB), (const float*)(ws + WS_TAB + TAB_RC), (const float*)(ws + WS_TAB + TAB_RS), smask};
                GEMM_CALL(EpiAttnQKV, HBP, WBP + W_QKV + (size_t)j * 3 * MEL, TG, 3072, 1024, E); }
            else { EpiRetQKV E{(bf16*)B_, (bf16*)(B_ + 64 * MiB), (bf16*)(B_ + 128 * MiB), (const float*)(ws + WS_TAB + TAB_XC), (const float*)(ws + WS_TAB + TAB_XS), smask};
                GEMM_CALL(EpiRetQKV, HBP, WBP + W_RIN + (size_t)j * 6 * MEL, TG, 4096, 1024, E); }
        } break;
        case 2: {
            unsigned char* B_ = BIGP;
            if (!ret) {
                GAS const float* lq1 = (GAS const float*)(PIN(10) + j * 64); GAS const float* lk1 = (GAS const float*)(PIN(11) + j * 64); GAS const float* lq2 = (GAS const float*)(PIN(12) + j * 64); GAS const float* lk2 = (GAS const float*)(PIN(13) + j * 64);
                float d1 = 0.f, d2 = 0.f;
                for (int k = 0; k < 64; ++k) { d1 += lq1[k] * lk1[k]; d2 += lq2[k] * lk2[k]; }
                const float lam_init = 0.8f - 0.6f * expf(-0.3f * (float)i); const float lam = expf(d1) - expf(d2) + lam_init;
#ifndef NO_ATTN
                attn_phase(lds, (const bf16*)B_, (const bf16*)(B_ + 64 * MiB), (const bf16*)(B_ + 128 * MiB), OBP, S, NB, vcu, Gn, lam, 1.0f - lam_init, PIN(14) + j * 128, (float*)(B_ + 256 * MiB) + (size_t)blockIdx.x * 32768, wave);
#endif
            } else {
#ifndef NO_SCAN
                scan_phase(lds, (const bf16*)B_, (const bf16*)(B_ + 64 * MiB), (const bf16*)(B_ + 128 * MiB), OBP, (bf16*)(B_ + 256 * MiB), S, NB, vcu, Gn, PIN(17) + j * 8, wave);
#endif
            }
        } break;
        case 3: { if (!ret) continue;
#ifndef NO_INTRA
            unsigned char* B_ = BIGP;
#if (REP_MASK & 8)
            intra_phase(lds, (const bf16*)B_, (const bf16*)(B_ + 64 * MiB), (const bf16*)(B_ + 128 * MiB), OBP, (const bf16*)(B_ + 256 * MiB), S, NB, vcu, Gn, PIN(17) + j * 8, wave, false);
#endif
            intra_phase(lds, (const bf16*)B_, (const bf16*)(B_ + 64 * MiB), (const bf16*)(B_ + 128 * MiB), OBP, (const bf16*)(B_ + 256 * MiB), S, NB, vcu, Gn, PIN(17) + j * 8, wave);
#endif
        } break;
        case 4: { if (!ret) continue; EpiSiluMul E{OBP, 2048}; GEMM_CALL(EpiSiluMul, HBP, WBP + W_RIN + (size_t)j * 6 * MEL + (size_t)4096 * 1024, TG, 2048, 1024, E); } break;
        case 5: case 8: {
            unsigned char* B_ = BIGP; const bf16* A_; const bf16* W_; int K_; bf16* O_;
            if (ph == 5) { A_ = OBP; K_ = ret ? 2048 : 1024; W_ = WBP + (ret ? W_ROUT + (size_t)j * 2 * MEL : W_O + (size_t)j * MEL); O_ = (bf16*)B_; }
            else { A_ = (const bf16*)B_; K_ = 4096; W_ = WBP + W_MOUT + (size_t)i * 4 * MEL; O_ = (bf16*)(B_ + 256 * MiB); }
            EpiBf16Plain E{O_, DM}; GEMM_CALL(EpiBf16Plain, A_, W_, TG, 1024, K_, E);
        } break;
        case 10: {
            EpiBf16NP E{(bf16*)BIGP, DM}; GEMM_CALL(EpiBf16NP, PBP, WBP + W_PROJ + (size_t)i * 262144, TG, 1024, 256, E);
#ifndef PROJ_SYNC
            continue;
#endif
        } break;
        case 6: { float* x = XP; rowpass<true, true, true, false>(x, x, (const bf16*)BIGP, PIN(5) + i * DM, PIN(6) + i * DM, HBP, nullptr, nullptr, GW, NGW, wave); } break;
        case 7: { EpiRelu2 E{(bf16*)BIGP, FFD}; GEMM_CALL(EpiRelu2, HBP, WBP + W_MIN + (size_t)i * 4 * MEL, TG, 4096, 1024, E); } break;
        case 9: { float* x = XP; rowpass<true, true, false, true>(x, x, (const bf16*)(BIGP + 256 * MiB), PIN(7) + i * DM, nullptr, HBP, PIN(2 + g) + (size_t)i * TG * 256, PBP, GW, NGW, wave); } break;
        case 11: { EpiGate E{XP, (const bf16*)BIGP}; GEMM_CALL(EpiGate, HBP, WBP + W_GATE + (size_t)i * MEL, TG, 1024, 1024, E); } break;
        default: { if (i == 3) continue; rowpass<false, false, true, false>(XP, nullptr, nullptr, nullptr, PIN(4) + (i + 1) * DM, HBP, nullptr, nullptr, GW, NGW, wave); } break;
        }
#ifdef TIMING
        const unsigned long long t1_ = __builtin_amdgcn_s_memrealtime();
#endif
        GSYNC();
#ifdef TIMING
        { const unsigned long long t2_ = __builtin_amdgcn_s_memrealtime(); LAS unsigned long long* TA = (LAS unsigned long long*)(lds + PT_OFF + 256);
          const int cat = (ph == 0 || ph == 6 || ph == 9 || ph == 12) ? 4 : (ph == 2 ? (ret ? 2 : 1) : (ph == 3 ? 3 : 0));
          if (tid_of(wave) == 0) { TA[cat] += t1_ - t0_; TA[5] += t2_ - t1_; TA[6] += t2_ - t0_; } }
#endif
#ifdef DBG
        if (g == DBG_G) {
            int lane = tid_of(wave) & 63, gwv = (int)blockIdx.x * 8 + wave; asm volatile("" : "+v"(lane), "+s"(gwv)); unsigned char* ws = WSP; unsigned char* B_ = ws + WS_BIG;
            const bf16* Qb = (const bf16*)B_; const bf16* Kb = (const bf16*)(B_ + 64 * MiB); const bf16* Vb = (const bf16*)(B_ + 128 * MiB);
            const int hi_ = i >> 1;
            bool did = true;
            if (!ret && ph == 1) dbg_attn_qkv(ws, hi_ ? 14 : 2, HBP, PIN(8) + (size_t)j * 1024 * 3072, Qb, Kb, Vb, S, gwv, lane);
            else if (!ret && ph == 2) { const float* lq1 = PIN(10) + j * 64; const float* lk1 = PIN(11) + j * 64; const float* lq2 = PIN(12) + j * 64; const float* lk2 = PIN(13) + j * 64; float d1 = 0.f, d2 = 0.f;
                for (int k = 0; k < 64; ++k) { d1 += lq1[k] * lk1[k]; d2 += lq2[k] * lk2[k]; }
                const float lam_init = 0.8f - 0.6f * expf(-0.3f * (float)i); dbg_attn(ws, hi_ ? 14 : 3, Qb, Kb, Vb, OBP, S, NB, expf(d1) - expf(d2) + lam_init, 1.0f - lam_init, PIN(14) + j * 128, gwv, lane); }
            else if (!ret && ph == 5) dbg_gemm(ws, hi_ ? 14 : 4, OBP, PIN(9) + (size_t)j * MEL, 1024, 1024, B_, 1024, 2, gwv, lane);
            else if (i == 0 && ph == 6) dbg_rp(ws, 5, PIN(g), XP, nullptr, PIN(5), PIN(6), HBP, gwv, lane);
            else if (i == 0 && ph == 7) dbg_gemm(ws, 6, HBP, PIN(18), 1024, 4096, B_, 4096, 1, gwv, lane);
            else if (i == 0 && ph == 8) dbg_gemm(ws, 7, (const bf16*)B_, PIN(19), 4096, 1024, B_ + 256 * MiB, 1024, 2, gwv, lane);
            else if (i == 0 && ph == 9) dbg_rp(ws, 8, nullptr, XP, nullptr, nullptr, nullptr, HBP, gwv, lane);
            else if (i == 0 && ph == 11) dbg_gemm(ws, 9, PBP, PIN(20), 256, 1024, B_, 1024, 2, gwv, lane);
            else if (ret && ph == 1) dbg_ret_qkv(ws, hi_ ? 14 : 10, HBP, PIN(15) + (size_t)j * 1024 * 6144, Qb, Kb, Vb, S, gwv, lane);
            else if (ret && ph == 3) dbg_ret(ws, hi_ ? 14 : 11, Qb, Kb, Vb, OBP, S, NB, PIN(17) + j * 8, gwv, lane);
            else if (ret && ph == 5) dbg_gemm(ws, hi_ ? 14 : 13, OBP, PIN(16) + (size_t)j * 2 * MEL, 2048, 1024, B_, 1024, 2, gwv, lane);
            else if (i == 3 && ph == 11) dbg_acc(ws, 15, 1.f, 1.f, lane);
            else did = false;
            if (did) GSYNC();
        }
#endif
    }
#ifdef TIMING
    { unsigned char* ws = WSP; float* tw = (float*)(ws + WS_CTL + 2048); LAS unsigned long long* TA = (LAS unsigned long long*)(lds + PT_OFF + 256);
      if (blockIdx.x == 0 && tid_of(wave) == 0) { tw[0] = (float)TA[TIMING_A] * 0.01f; tw[1] = (float)TA[TIMING_B] / (float)TA[6]; }
      GSYNC();
      const float C = __hip_atomic_load(tw, __ATOMIC_RELAXED, __HIP_MEMORY_SCOPE_AGENT), f = __hip_atomic_load(tw + 1, __ATOMIC_RELAXED, __HIP_MEMORY_SCOPE_AGENT);
      float* o = (float*)ldpk(22); const size_t nh = (size_t)TG * DM, nf = (size_t)(f * (float)nh);
      for (size_t idx = (size_t)blockIdx.x * 512 + tid_of(wave); idx < nf; idx += (size_t)Gn * 512) { o[idx] = C; o[nh + idx] = C; } }
#endif
#ifdef DBG
    { unsigned char* ws = WSP; const float* acc = (const float*)(ws + WS_CTL + 1024); int bad = -1;
      for (int id = 15; id >= 0; --id) { const float e = __hip_atomic_load(acc + 2 * id, __ATOMIC_RELAXED, __HIP_MEMORY_SCOPE_AGENT), r = __hip_atomic_load(acc + 2 * id + 1, __ATOMIC_RELAXED, __HIP_MEMORY_SCOPE_AGENT); if (r > 0.f && !(e <= DBG_TOL * r)) bad = id; }
      if (bad >= 0) { float C = 100.f; for (int k = 0; k < bad; ++k) C *= 4.f;
#ifdef DBG_RATIO
          C = 1000.f * fminf(fmaxf(__hip_atomic_load(acc + 2 * bad, __ATOMIC_RELAXED, __HIP_MEMORY_SCOPE_AGENT) / __hip_atomic_load(acc + 2 * bad + 1, __ATOMIC_RELAXED, __HIP_MEMORY_SCOPE_AGENT), 1e-3f), 1e3f);
#endif
 float* o = (float*)ldpk(22); const size_t n = (size_t)2 * TG * DM;
          for (size_t idx = (size_t)blockIdx.x * 512 + tid_of(wave); idx < n; idx += (size_t)Gn * 512) o[idx] = C; } }
#endif
}

extern "C" void kernel_launch(void* const* d_in, const int* in_sizes, int n_in, void* d_out, int out_size, void* d_ws, size_t ws_size, hipStream_t stream) {
    static int grid_blocks = 0;
    if (!grid_blocks) {
        int dev = 0, cus = 0, per_cu = 0;
        (void)hipGetDevice(&dev);
        (void)hipDeviceGetAttribute(&cus, hipDeviceAttributeMultiprocessorCount, dev);
        (void)hipFuncSetAttribute((const void*)fwd_mega, hipFuncAttributeMaxDynamicSharedMemorySize, LDS_BYTES);
        (void)hipOccupancyMaxActiveBlocksPerMultiprocessor(&per_cu, (const void*)fwd_mega, 512, LDS_BYTES);
        if (per_cu < 1) per_cu = 1;
        grid_blocks = cus * per_cu;
        if (ws_size < WS_END || n_in != 22) { fprintf(stderr, "kernel_launch: workspace %zu < %zu or n_in %d != 22\n", ws_size, (size_t)WS_END, n_in); }
    }
    (void)hipMemsetAsync((char*)d_ws + WS_CTL, 0, 65536, stream);
    Params p{};
    for (int i = 0; i < 22; ++i) p.in[i] = (const float*)d_in[i];
    p.out = (float*)d_out; p.ws = (unsigned char*)d_ws;
    void* args[] = {&p};
    hipError_t e = hipLaunchCooperativeKernel((void*)fwd_mega, dim3(grid_blocks), dim3(512), args, LDS_BYTES, stream);
    if (e != hipSuccess) fprintf(stderr, "cooperative launch failed: %s (grid %d)\n", hipGetErrorString(e), grid_blocks);
}
```

```cpp
#include <hip/hip_runtime.h>
#include <hip/hip_cooperative_groups.h>
#include <cstdio>
#include <cstdint>
namespace pg8 {
#define PG8_LAS __attribute__((address_space(3)))
typedef unsigned short bf16_t;
typedef short bf16x8 __attribute__((ext_vector_type(8)));
typedef float f32x4 __attribute__((ext_vector_type(4)));
typedef unsigned u32x4 __attribute__((ext_vector_type(4)));
constexpr int BM = 256, BK = 64, HALF = 128, HTB = HALF * BK * 2  , STAGE_BYTES = 8 * HTB, NXCD = 8, WGM = 8;

__host__ __device__ __forceinline__ int lds_byte(int r, int c) { const int st = (r >> 4) * 2 + (c >> 5), rr = r & 15, cc = c & 31, ob = rr * 64 + cc * 2; return st * 1024 + (ob ^ (((ob >> 9) & 1) << 5)); }
__host__ __device__ __forceinline__ void stage_rc(int b, int& R, int& C) { const int st = b / 1024, sb = b % 1024, swz = sb ^ (((sb >> 9) & 1) << 5); R = (st >> 1) * 16 + swz / 64; C = (st & 1) * 32 + (swz % 64) / 2; }
__host__ __device__ __forceinline__ int perm32(int rho) { const int n = rho >> 4, i = rho & 15; return 8 * (i >> 2) + 4 * n + (i & 3); }

struct Unit { int pm, pn; };
struct Gemm { const bf16_t* A; const bf16_t* Bt; int M, N, K; };

struct StaticOrder {
    int nM, nN, nwg, G, c;
    __host__ __device__ void init(int M, int N, int G_, int c_) { nM = M / BM; nN = N / BM; nwg = nM * nN; G = G_; c = c_; }
    __host__ __device__ bool next(int i, Unit& u) const {
        const long L = (long)i * G + c; if (L >= nwg) return false;
        int wgid = (int)L; { const int q = nwg / NXCD, r = nwg % NXCD, xcd = wgid % NXCD, off = wgid / NXCD; wgid = (xcd < r ? xcd * (q + 1) : r * (q + 1) + (xcd - r) * q) + off; }
        const int nig = WGM * nN, gid = wgid / nig, fm = gid * WGM, gsz = (nM - fm) < WGM ? (nM - fm) : WGM;
        u.pm = fm + ((wgid % nig) % gsz); u.pn = (wgid % nig) / gsz; return true;
    }
    __device__ __forceinline__ void a_ready(const Unit&) const {}
    __device__ __forceinline__ void done(const Unit&) const {}
};

__device__ __forceinline__ unsigned cvt_pk_bf16(float lo, float hi) { unsigned r; asm volatile("v_cvt_pk_bf16_f32 %0, %1, %2" : "=v"(r) : "v"(lo), "v"(hi)); return r; }
typedef float f32x2 __attribute__((ext_vector_type(2)));
template <class Epi, class Sched, bool ALIGN_EPI = false, bool SP2 = false>
__device__ __forceinline__ void gemm_phase(PG8_LAS unsigned char* lds, const Gemm g, const Sched& S, const Epi& E, const int wave_id) {
    int tid_l; asm volatile("v_mbcnt_lo_u32_b32 %0, -1, 0\n\tv_mbcnt_hi_u32_b32 %0, -1, %0" : "=v"(tid_l)); tid_l += wave_id * 64; asm volatile("" : "+v"(tid_l));
    const int tid = tid_l, wid = __builtin_amdgcn_readfirstlane(tid >> 6), lane = tid & 63, wr = wid >> 2, wc = wid & 3, fr = lane & 15, fq = lane >> 4;
    const int K = g.K, nt = K / BK;
    unsigned voffA[2], voffB[2];
#pragma unroll
    for (int i = 0; i < 2; ++i) { int R, C; stage_rc(tid * 16 + i * 8192, R, C); const int Rb = Epi::PERM ? ((R & ~31) + perm32(R & 31)) : R;
        voffA[i] = (unsigned)(R * K + C) * 2u; voffB[i] = (unsigned)(Rb * K + C) * 2u; }
    const size_t kstep = (size_t)(BK * 2);
    const size_t hstep = (size_t)HALF * K * 2;
    const size_t tstep = 2 * hstep;
    const unsigned ldsw = (unsigned)wid * 1024u;
    const int aoff = lds_byte(wr * 64 + fr, fq * 8), boff = lds_byte(wc * 32 + fr, fq * 8);
#define PG8_SA(b, h) (((b) * 2 + (h)) * HTB)
#define PG8_SB(b, h) ((4 + (b) * 2 + (h)) * HTB)
#define PG8_STAGE(bufoff, gbase, voff) do { _Pragma("unroll") for (int _i = 0; _i < 2; ++_i) \
        __builtin_amdgcn_global_load_lds((const unsigned*)((const char*)(gbase) + (voff)[_i]), (PG8_LAS unsigned*)(lds + (bufoff) + ldsw + _i * 8192), 16, 0, 0); } while (0)
#define PG8_LDA(dst, b, h) do { _Pragma("unroll") for (int m = 0; m < 4; ++m) _Pragma("unroll") for (int k = 0; k < 2; ++k) dst[m][k] = *(const PG8_LAS bf16x8*)(lds + PG8_SA(b, h) + aoff + m * 2048 + k * 1024); } while (0)
#define PG8_LDB(dst, b, h) do { _Pragma("unroll") for (int n = 0; n < 2; ++n) _Pragma("unroll") for (int k = 0; k < 2; ++k) dst[n][k] = *(const PG8_LAS bf16x8*)(lds + PG8_SB(b, h) + boff + n * 2048 + k * 1024); } while (0)
#define PG8_MMA(ai, bj, At, Bt) do { __builtin_amdgcn_s_setprio(1); _Pragma("unroll") for (int m = 0; m < 4; ++m) _Pragma("unroll") for (int n = 0; n < 2; ++n) _Pragma("unroll") for (int k = 0; k < 2; ++k) \
        acc[ai][bj][m][n] = __builtin_amdgcn_mfma_f32_16x16x32_bf16(Bt[n][k], At[m][k], acc[ai][bj][m][n], 0, 0, 0); __builtin_amdgcn_s_setprio(0); } while (0)
#define PG8_WAIT_V(n) asm volatile("s_waitcnt vmcnt(" #n ")" ::: "memory")
#define PG8_WAIT_L(n) asm volatile("s_waitcnt lgkmcnt(" #n ")" ::: "memory")
#define PG8_BAR __builtin_amdgcn_s_barrier()
#define PG8_SCHED __builtin_amdgcn_sched_barrier(0)
    Unit cur, nxt; int ui = 0;
    if (!S.next(0, cur)) return;
    f32x4 acc[2][2][4][2];
#pragma unroll
    for (int a = 0; a < 2; ++a)
#pragma unroll
        for (int b = 0; b < 2; ++b)
#pragma unroll
            for (int m = 0; m < 4; ++m)
#pragma unroll
                for (int n = 0; n < 2; ++n) acc[a][b][m][n] = (f32x4){0.f, 0.f, 0.f, 0.f};
    bf16x8 At[4][2], B0[2][2], B1[2][2];
    const char* cA = (const char*)g.A + (size_t)cur.pm * tstep; const char* cB = (const char*)g.Bt + (size_t)cur.pn * tstep;
    S.a_ready(cur);
    if constexpr (SP2) {
        PG8_STAGE(PG8_SB(0, 0), cB, voffB); PG8_STAGE(PG8_SB(0, 1), cB + hstep, voffB); PG8_STAGE(PG8_SA(0, 0), cA, voffA); PG8_STAGE(PG8_SA(0, 1), cA + hstep, voffA);
        if (wr == 1) PG8_BAR;
        PG8_WAIT_V(2); PG8_BAR;
        PG8_STAGE(PG8_SB(1, 0), cB + kstep, voffB); PG8_STAGE(PG8_SA(1, 0), cA + kstep, voffA); PG8_STAGE(PG8_SB(1, 1), cB + hstep + kstep, voffB);
        PG8_WAIT_V(6); PG8_BAR;
    } else {
        PG8_STAGE(PG8_SB(0, 0), cB, voffB); PG8_STAGE(PG8_SA(0, 0), cA, voffA); PG8_STAGE(PG8_SB(0, 1), cB + hstep, voffB); PG8_STAGE(PG8_SA(0, 1), cA + hstep, voffA);
        if (wr == 1) PG8_BAR;
        PG8_WAIT_V(4); PG8_BAR;
        PG8_STAGE(PG8_SB(1, 0), cB + kstep, voffB); PG8_STAGE(PG8_SA(1, 0), cA + kstep, voffA); PG8_STAGE(PG8_SB(1, 1), cB + hstep + kstep, voffB);
        PG8_WAIT_V(6); PG8_BAR;
    }
    for (;;) {
        const bool has_next = S.next(ui + 1, nxt);
        const char* nA = has_next ? (const char*)g.A + (size_t)nxt.pm * tstep : cA; const char* nB = has_next ? (const char*)g.Bt + (size_t)nxt.pn * tstep : cB;
        for (int t = 0; t < nt; t += 2) {
            const bool last = (t == nt - 2);
            const char* a1 = cA + (size_t)(t + 1) * kstep;
            const char* a2 = last ? nA : cA + (size_t)(t + 2) * kstep; const char* b2 = last ? nB : cB + (size_t)(t + 2) * kstep;
            const char* a3 = a2 + kstep; const char* b3 = b2 + kstep;
            if (last && has_next) S.a_ready(nxt);
            if constexpr (SP2) {
            PG8_LDB(B0, 0, 0); PG8_LDB(B1, 0, 1); PG8_SCHED; PG8_LDA(At, 0, 0); PG8_STAGE(PG8_SA(1, 1), a1 + hstep, voffA);
            PG8_WAIT_V(8); PG8_WAIT_L(0); PG8_BAR; PG8_MMA(0, 0, At, B0); PG8_MMA(0, 1, At, B1); PG8_BAR; PG8_SCHED;
            PG8_LDA(At, 0, 1); PG8_STAGE(PG8_SB(0, 0), b2, voffB); PG8_STAGE(PG8_SB(0, 1), b2 + hstep, voffB); PG8_STAGE(PG8_SA(0, 0), a2, voffA);
            PG8_WAIT_V(8); PG8_WAIT_L(0); PG8_BAR; PG8_MMA(1, 0, At, B0); PG8_MMA(1, 1, At, B1); PG8_BAR; PG8_SCHED;
            PG8_LDB(B0, 1, 0); PG8_LDB(B1, 1, 1); PG8_SCHED; PG8_LDA(At, 1, 0); PG8_STAGE(PG8_SA(0, 1), a2 + hstep, voffA);
            PG8_WAIT_V(8); PG8_WAIT_L(0); PG8_BAR; PG8_MMA(0, 0, At, B0); PG8_MMA(0, 1, At, B1); PG8_BAR; PG8_SCHED;
            PG8_LDA(At, 1, 1); PG8_STAGE(PG8_SB(1, 0), b3, voffB); PG8_STAGE(PG8_SB(1, 1), b3 + hstep, voffB); PG8_STAGE(PG8_SA(1, 0), a3, voffA);
            PG8_WAIT_V(8); PG8_WAIT_L(0); PG8_BAR; PG8_MMA(1, 0, At, B0); PG8_MMA(1, 1, At, B1); PG8_BAR; PG8_SCHED;
            } else {
            PG8_LDB(B0, 0, 0); PG8_SCHED; PG8_LDA(At, 0, 0); PG8_STAGE(PG8_SA(1, 1), a1 + hstep, voffA);
            PG8_WAIT_L(8); PG8_BAR; PG8_WAIT_L(0); PG8_MMA(0, 0, At, B0); PG8_BAR; PG8_SCHED;
            PG8_LDB(B1, 0, 1); PG8_STAGE(PG8_SB(0, 0), b2, voffB);
            PG8_BAR; PG8_WAIT_L(0); PG8_MMA(0, 1, At, B1); PG8_BAR;
            PG8_LDA(At, 0, 1); PG8_STAGE(PG8_SA(0, 0), a2, voffA);
            PG8_BAR; PG8_WAIT_L(0); PG8_MMA(1, 0, At, B0); PG8_BAR; PG8_SCHED;
            PG8_STAGE(PG8_SB(0, 1), b2 + hstep, voffB);
            PG8_WAIT_V(6); PG8_BAR; PG8_MMA(1, 1, At, B1); PG8_BAR;
            PG8_LDB(B0, 1, 0); PG8_SCHED; PG8_LDA(At, 1, 0); PG8_STAGE(PG8_SA(0, 1), a2 + hstep, voffA);
            PG8_WAIT_L(8); PG8_BAR; PG8_WAIT_L(0); PG8_MMA(0, 0, At, B0); PG8_BAR; PG8_SCHED;
            PG8_LDB(B1, 1, 1); PG8_STAGE(PG8_SB(1, 0), b3, voffB);
            PG8_BAR; PG8_WAIT_L(0); PG8_MMA(0, 1, At, B1); PG8_BAR;
            PG8_LDA(At, 1, 1); PG8_STAGE(PG8_SA(1, 0), a3, voffA);
            PG8_BAR; PG8_WAIT_L(0); PG8_MMA(1, 0, At, B0); PG8_BAR; PG8_SCHED;
            PG8_STAGE(PG8_SB(1, 1), b3 + hstep, voffB);
            PG8_WAIT_V(6); PG8_BAR; PG8_MMA(1, 1, At, B1); PG8_BAR;
            }
        }
        if constexpr (ALIGN_EPI) { if (wr == 0) PG8_BAR; }
        if constexpr (!Epi::AFTER_DRAIN) { E(acc, cur, wr, wc, fr, fq); S.done(cur); }
        if (!has_next) break;
#pragma unroll
        for (int a = 0; a < 2; ++a)
#pragma unroll
            for (int b = 0; b < 2; ++b)
#pragma unroll
                for (int m = 0; m < 4; ++m)
#pragma unroll
                    for (int n = 0; n < 2; ++n) acc[a][b][m][n] = (f32x4){0.f, 0.f, 0.f, 0.f};
        cur = nxt; cA = nA; cB = nB; ++ui;
        if constexpr (ALIGN_EPI) { if (wr == 1) PG8_BAR; }
    }
    PG8_WAIT_V(0);
    if constexpr (!ALIGN_EPI) { if (wr == 0) PG8_BAR; }
    PG8_BAR;
    if constexpr (Epi::AFTER_DRAIN) { E.fused(acc, cur, wr, wc, fr, fq, lds, wid, lane); S.done(cur); }
#undef PG8_SA
#undef PG8_SB
#undef PG8_STAGE
#undef PG8_LDA
#undef PG8_LDB
#undef PG8_MMA
#undef PG8_WAIT_V
#undef PG8_WAIT_L
#undef PG8_BAR
#undef PG8_SCHED
}
}

namespace cg = cooperative_groups;
#define LAS __attribute__((address_space(3)))
#define GAS __attribute__((address_space(1)))
typedef unsigned short bf16;
typedef short bf16x8 __attribute__((ext_vector_type(8)));
typedef short s16x4 __attribute__((ext_vector_type(4)));
typedef float f32x2 __attribute__((ext_vector_type(2)));
typedef float f32x4 __attribute__((ext_vector_type(4)));
typedef float f32x16 __attribute__((ext_vector_type(16)));
typedef unsigned u32x2 __attribute__((ext_vector_type(2)));
typedef unsigned u32x4 __attribute__((ext_vector_type(4)));

constexpr int DM = 1024, TG = 32768, FFD = 4096;
constexpr size_t MiB = (size_t)1 << 20;
constexpr size_t WS_CTL = 0, WS_TAB = 1 * MiB, WS_W = 12 * MiB, WS_HB = 136 * MiB, WS_PB = 200 * MiB, WS_OB = 216 * MiB, WS_BIG = 344 * MiB, WS_END = 728 * MiB;
constexpr size_t TAB_RC = 0, TAB_RS = 1 * MiB, TAB_XC = 2 * MiB, TAB_XS = 6 * MiB;
constexpr size_t MEL = 1048576;
constexpr size_t W_QKV = 0, W_O = 6 * MEL, W_RIN = 8 * MEL, W_ROUT = 20 * MEL, W_MIN = 24 * MEL, W_MOUT = 40 * MEL, W_PROJ = 56 * MEL, W_GATE = 57 * MEL;
constexpr float LOG2E = 1.4426950408889634f;
constexpr int LDS_BYTES = 147456;

struct Params { const float* in[22]; float* out; unsigned char* ws; };

__device__ __forceinline__ unsigned cvtpk(float lo, float hi) { typedef __bf16 b2 __attribute__((ext_vector_type(2))); f32x2 v = {lo, hi}; b2 b = __builtin_convertvector(v, b2); return __builtin_bit_cast(unsigned, b); }
__device__ __forceinline__ float bf2f(unsigned short b) { return __uint_as_float(((unsigned)b) << 16); }
__device__ __forceinline__ unsigned short f2bf(float f) { return (unsigned short)(cvtpk(f, 0.f) & 0xffffu); }
__device__ __forceinline__ float shx(float v, int o, int lane) { return __int_as_float(__builtin_amdgcn_ds_bpermute((lane ^ o) << 2, __float_as_int(v))); }
__device__ __forceinline__ float wave_sum(float v, int lane) {
#pragma unroll
    for (int o = 1; o < 64; o <<= 1) v += shx(v, o, lane);
    return v;
}
__device__ __forceinline__ int crow(int r, int hh) { return (r & 3) + 8 * (r >> 2) + 4 * hh; }
__device__ __forceinline__ s16x4 trr(LAS unsigned char* p) { return __builtin_bit_cast(s16x4, __builtin_amdgcn_ds_read_tr16_b64_v4i16((LAS s16x4*)p)); }
__device__ __forceinline__ bf16x8 cat8(s16x4 lo, s16x4 hi) { return (bf16x8){lo[0], lo[1], lo[2], lo[3], hi[0], hi[1], hi[2], hi[3]}; }
__device__ __forceinline__ bf16x8 pack8(const f32x16& v, int b) { u32x4 w; w.x = cvtpk(v[b], v[b + 1]); w.y = cvtpk(v[b + 2], v[b + 3]); w.z = cvtpk(v[b + 4], v[b + 5]); w.w = cvtpk(v[b + 6], v[b + 7]); return __builtin_bit_cast(bf16x8, w); }
#define LBAR() do { asm volatile("s_waitcnt lgkmcnt(0)" ::: "memory"); __builtin_amdgcn_s_barrier(); asm volatile("" ::: "memory"); } while (0)
#ifndef ATT_THR
#define ATT_THR 6.0f
#endif
#ifndef PPSEL
#define PPSEL(w) ((w) >= 4)
#endif
__device__ __forceinline__ void glds16(const void* gsrc, unsigned lds_dst) { unsigned keep;
    asm volatile("s_mov_b32 %0, m0\n\ts_mov_b32 m0, %2\n\ts_nop 0\n\tglobal_load_lds_dwordx4 %1, off\n\ts_mov_b32 m0, %0" : "=&s"(keep) : "v"(gsrc), "s"(lds_dst) : "memory"); }
#define MFMA32(a, b, c) __builtin_amdgcn_mfma_f32_32x32x16_bf16((a), (b), (c), 0, 0, 0)
__device__ __forceinline__ int tid_of(int wave) { int l; asm volatile("v_mbcnt_lo_u32_b32 %0, -1, 0\n\tv_mbcnt_hi_u32_b32 %0, -1, %0" : "=v"(l)); return wave * 64 + l; }
__device__ __forceinline__ float max3f(float a, float b, float c) { float r; asm("v_max3_f32 %0, %1, %2, %3" : "=v"(r) : "v"(a), "v"(b), "v"(c)); return r; }
__device__ __forceinline__ float ex2(float x) { return __builtin_amdgcn_exp2f(x); }

__device__ __forceinline__ int qk_perm(int n) { const int d = n & 63; return (n & ~63) | (((d >> 4) & 1) << 5) | ((d >> 5) << 4) | (d & 15); }
__device__ __forceinline__ void conv_item(const float* W, int K, int N, bf16* WT, int permN, LAS float* scr, int item, int lane) {
    const int nblk = N / 32, kb = item / nblk, nb = item % nblk, k0 = 64 * kb, n0 = 32 * nb;
#pragma unroll 8
    for (int i = 0; i < 32; ++i) { const int kk = 2 * i + (lane >> 5); scr[kk * 33 + (lane & 31)] = ((GAS const float*)W)[(size_t)(k0 + kk) * N + n0 + (lane & 31)]; }
    asm volatile("s_waitcnt lgkmcnt(0)" ::: "memory");
    const int c = lane & 7;
#pragma unroll
    for (int j = 0; j < 4; ++j) { const int n = (lane >> 3) + 8 * j; const LAS float* s = scr + (8 * c) * 33 + n;
        u32x4 o; o.x = cvtpk(s[0 * 33], s[1 * 33]); o.y = cvtpk(s[2 * 33], s[3 * 33]); o.z = cvtpk(s[4 * 33], s[5 * 33]); o.w = cvtpk(s[6 * 33], s[7 * 33]);
        const int nn = n0 + n, dst = nn < permN ? qk_perm(nn) : nn;
        *(GAS u32x4*)(WT + (size_t)dst * K + k0 + 8 * c) = o; }
    asm volatile("s_waitcnt lgkmcnt(0)" ::: "memory");
}
__device__ __forceinline__ void conv_matrix(const float* W, int K, int N, bf16* WT, int permN, LAS float* scr, int gw, int NGW, const int wave) {
    int lane = tid_of(wave) & 63; asm volatile("" : "+v"(lane));
    const int items = (K / 64) * (N / 32);
    for (int it = gw; it < items; it += NGW) conv_item(W, K, N, WT, permN, scr, it, lane);
}

template <bool HAS_M, bool STORE_X, bool HAS_WPRE, bool HAS_P>
__device__ __forceinline__ void rowpass(const float* xsrc, float* xdst, const bf16* m, const float* wpost, const float* wpre, bf16* hb, const float* psrc, bf16* pb, int gw, int NGW, const int wave) {
    int lane = tid_of(wave) & 63; asm volatile("" : "+v"(lane));
    constexpr int RB = 4;
    for (int row0 = gw; row0 < TG; row0 += RB * NGW) {
        f32x4 v[RB][4]; u32x2 mw[RB][4]; f32x4 pv[RB];
#pragma unroll
        for (int q = 0; q < RB; ++q) { const int row = min(row0 + q * NGW, TG - 1);
            GAS const f32x4* xr = (GAS const f32x4*)(xsrc + (size_t)row * DM) + lane;
#pragma unroll
            for (int j = 0; j < 4; ++j) v[q][j] = xr[64 * j];
            if constexpr (HAS_M) { GAS const u32x2* mr = (GAS const u32x2*)(m + (size_t)row * DM) + lane;
#pragma unroll
                for (int j = 0; j < 4; ++j) mw[q][j] = mr[64 * j]; }
            if constexpr (HAS_P) pv[q] = ((GAS const f32x4*)(psrc + (size_t)row * 256))[lane]; }
        f32x4 wp[4], wq[4];
#pragma unroll
        for (int j = 0; j < 4; ++j) { if constexpr (HAS_M) wp[j] = ((GAS const f32x4*)wpost)[lane + 64 * j]; if constexpr (HAS_WPRE) wq[j] = ((GAS const f32x4*)wpre)[lane + 64 * j]; }
#pragma unroll
        for (int q = 0; q < RB; ++q) { const int row = row0 + q * NGW; if (row >= TG) break;
            if constexpr (HAS_M) {
                f32x4 mm[4]; float ss = 0.f;
#pragma unroll
                for (int j = 0; j < 4; ++j) { const u32x2 w_ = mw[q][j]; mm[j].x = __uint_as_float(w_.x << 16); mm[j].y = __uint_as_float(w_.x & 0xffff0000u); mm[j].z = __uint_as_float(w_.y << 16); mm[j].w = __uint_as_float(w_.y & 0xffff0000u);
                    ss += mm[j].x * mm[j].x + mm[j].y * mm[j].y + mm[j].z * mm[j].z + mm[j].w * mm[j].w; }
                const float r = rsqrtf(wave_sum(ss, lane) * (1.f / DM) + 1e-6f);
#pragma unroll
                for (int j = 0; j < 4; ++j) v[q][j] += mm[j] * r * wp[j];
            }
            if constexpr (STORE_X) { GAS f32x4* xo = (GAS f32x4*)(xdst + (size_t)row * DM) + lane;
#pragma unroll
                for (int j = 0; j < 4; ++j) xo[64 * j] = v[q][j]; }
            {
                float ss = 0.f;
#pragma unroll
                for (int j = 0; j < 4; ++j) ss += v[q][j].x * v[q][j].x + v[q][j].y * v[q][j].y + v[q][j].z * v[q][j].z + v[q][j].w * v[q][j].w;
                const float r = rsqrtf(wave_sum(ss, lane) * (1.f / DM) + 1e-6f);
                GAS u32x2* ho = (GAS u32x2*)(hb + (size_t)row * DM) + lane;
#pragma unroll
                for (int j = 0; j < 4; ++j) { f32x4 o = v[q][j] * r; if constexpr (HAS_WPRE) o *= wq[j]; u32x2 w; w.x = cvtpk(o.x, o.y); w.y = cvtpk(o.z, o.w); ho[64 * j] = w; }
            }
            if constexpr (HAS_P) { u32x2 w; w.x = cvtpk(pv[q].x, pv[q].y); w.y = cvtpk(pv[q].z, pv[q].w); ((GAS u32x2*)(pb + (size_t)row * 256))[lane] = w; }
        }
    }
}

#define EPI_LOOP_AIM for (int ai = 0; ai < 2; ++ai) for (int m = 0; m < 4; ++m)
struct EpiF32 {
    static constexpr bool PERM = false, AFTER_DRAIN = false; float* O; int ldc;
    __device__ __forceinline__ void operator()(const pg8::f32x4 (&acc)[2][2][4][2], const pg8::Unit& u, int wr, int wc, int fr, int fq) const {
        const int row0 = u.pm * 256 + wr * 64 + fr, col0 = u.pn * 256 + wc * 32 + 4 * fq;
#pragma unroll
        for (int ai = 0; ai < 2; ++ai)
#pragma unroll
            for (int m = 0; m < 4; ++m) { GAS float* rp = (GAS float*)(O + (size_t)(row0 + ai * 128 + m * 16) * ldc + col0);
#pragma unroll
                for (int bj = 0; bj < 2; ++bj)
#pragma unroll
                    for (int n = 0; n < 2; ++n) *(GAS f32x4*)(rp + bj * 128 + n * 16) = acc[ai][bj][m][n]; }
    }
};
struct EpiBf16Plain {
    static constexpr bool PERM = true, AFTER_DRAIN = false; bf16* O; int ldc;
    __device__ __forceinline__ void operator()(const pg8::f32x4 (&acc)[2][2][4][2], const pg8::Unit& u, int wr, int wc, int fr, int fq) const {
        const int row0 = u.pm * 256 + wr * 64 + fr, col0 = u.pn * 256 + wc * 32 + 8 * fq;
#pragma unroll
        for (int ai = 0; ai < 2; ++ai)
#pragma unroll
            for (int m = 0; m < 4; ++m) { GAS bf16* rp = (GAS bf16*)(O + (size_t)(row0 + ai * 128 + m * 16) * ldc + col0);
#pragma unroll
                for (int bj = 0; bj < 2; ++bj) { f32x4 v0 = acc[ai][bj][m][0], v1 = acc[ai][bj][m][1];
                    u32x4 w; w.x = cvtpk(v0.x, v0.y); w.y = cvtpk(v0.z, v0.w); w.z = cvtpk(v1.x, v1.y); w.w = cvtpk(v1.z, v1.w); *(GAS u32x4*)(rp + bj * 128) = w; } }
    }
};
struct EpiRelu2 {
    static constexpr bool PERM = true, AFTER_DRAIN = false; bf16* O; int ldc;
    __device__ __forceinline__ void operator()(const pg8::f32x4 (&acc)[2][2][4][2], const pg8::Unit& u, int wr, int wc, int fr, int fq) const {
        const int row0 = u.pm * 256 + wr * 64 + fr, col0 = u.pn * 256 + wc * 32 + 8 * fq;
#pragma unroll
        for (int ai = 0; ai < 2; ++ai)
#pragma unroll
            for (int m = 0; m < 4; ++m) { GAS bf16* rp = (GAS bf16*)(O + (size_t)(row0 + ai * 128 + m * 16) * ldc + col0);
#pragma unroll
                for (int bj = 0; bj < 2; ++bj) { f32x4 v0 = acc[ai][bj][m][0], v1 = acc[ai][bj][m][1];
                    v0.x = fmaxf(v0.x, 0.f); v0.y = fmaxf(v0.y, 0.f); v0.z = fmaxf(v0.z, 0.f); v0.w = fmaxf(v0.w, 0.f); v1.x = fmaxf(v1.x, 0.f); v1.y = fmaxf(v1.y, 0.f); v1.z = fmaxf(v1.z, 0.f); v1.w = fmaxf(v1.w, 0.f); v0 = v0 * v0; v1 = v1 * v1;
                    u32x4 w; w.x = cvtpk(v0.x, v0.y); w.y = cvtpk(v0.z, v0.w); w.z = cvtpk(v1.x, v1.y); w.w = cvtpk(v1.z, v1.w); *(GAS u32x4*)(rp + bj * 128) = w; } }
    }
};
struct EpiBf16NP {
    static constexpr bool PERM = false, AFTER_DRAIN = false; bf16* O; int ldc;
    __device__ __forceinline__ void operator()(const pg8::f32x4 (&acc)[2][2][4][2], const pg8::Unit& u, int wr, int wc, int fr, int fq) const {
        const int row0 = u.pm * 256 + wr * 64 + fr, col0 = u.pn * 256 + wc * 32 + 4 * fq;
#pragma unroll
        for (int ai = 0; ai < 2; ++ai)
#pragma unroll
            for (int m = 0; m < 4; ++m) { GAS bf16* rp = (GAS bf16*)(O + (size_t)(row0 + ai * 128 + m * 16) * ldc + col0);
#pragma unroll
                for (int bj = 0; bj < 2; ++bj)
#pragma unroll
                    for (int n = 0; n < 2; ++n) { const f32x4 v = acc[ai][bj][m][n]; u32x2 w; w.x = cvtpk(v.x, v.y); w.y = cvtpk(v.z, v.w); *(GAS u32x2*)(rp + bj * 128 + n * 16) = w; } }
    }
};
struct EpiGate {
    static constexpr bool PERM = false, AFTER_DRAIN = false; float* X; const bf16* PR;
    __device__ __forceinline__ void operator()(const pg8::f32x4 (&acc)[2][2][4][2], const pg8::Unit& u, int wr, int wc, int fr, int fq) const {
        const int row0 = u.pm * 256 + wr * 64 + fr, col0 = u.pn * 256 + wc * 32 + 4 * fq;
#pragma unroll
        for (int ai = 0; ai < 2; ++ai)
#pragma unroll
            for (int m = 0; m < 4; ++m) { const size_t off = (size_t)(row0 + ai * 128 + m * 16) * DM + col0;
#pragma unroll
                for (int bj = 0; bj < 2; ++bj)
#pragma unroll
                    for (int n = 0; n < 2; ++n) { const f32x4 a = acc[ai][bj][m][n]; const u32x2 prw = *(GAS const u32x2*)(PR + off + bj * 128 + n * 16); f32x4 pr; pr.x = __uint_as_float(prw.x << 16); pr.y = __uint_as_float(prw.x & 0xffff0000u); pr.z = __uint_as_float(prw.y << 16); pr.w = __uint_as_float(prw.y & 0xffff0000u); f32x4 xv = *(GAS const f32x4*)(X + off + bj * 128 + n * 16);
                        xv.x += pr.x / (1.f + __expf(-a.x)); xv.y += pr.y / (1.f + __expf(-a.y)); xv.z += pr.z / (1.f + __expf(-a.z)); xv.w += pr.w / (1.f + __expf(-a.w));
                        *(GAS f32x4*)(X + off + bj * 128 + n * 16) = xv; } }
    }
};
struct EpiSiluMul {
    static constexpr bool PERM = false, AFTER_DRAIN = false; bf16* O; int ldc;
    __device__ __forceinline__ void operator()(const pg8::f32x4 (&acc)[2][2][4][2], const pg8::Unit& u, int wr, int wc, int fr, int fq) const {
        const int row0 = u.pm * 256 + wr * 64 + fr, col0 = u.pn * 256 + wc * 32 + 4 * fq;
#pragma unroll
        for (int ai = 0; ai < 2; ++ai)
#pragma unroll
            for (int m = 0; m < 4; ++m) { GAS bf16* rp = (GAS bf16*)(O + (size_t)(row0 + ai * 128 + m * 16) * ldc + col0);
#pragma unroll
                for (int bj = 0; bj < 2; ++bj)
#pragma unroll
                    for (int n = 0; n < 2; ++n) { const f32x4 a = acc[ai][bj][m][n]; u32x2 w = *(GAS const u32x2*)(rp + bj * 128 + n * 16);
                        const float o0 = __uint_as_float(w.x << 16) * a.x / (1.f + __expf(-a.x)), o1 = __uint_as_float(w.x & 0xffff0000u) * a.y / (1.f + __expf(-a.y));
                        const float o2 = __uint_as_float(w.y << 16) * a.z / (1.f + __expf(-a.z)), o3 = __uint_as_float(w.y & 0xffff0000u) * a.w / (1.f + __expf(-a.w));
                        w.x = cvtpk(o0, o1); w.y = cvtpk(o2, o3); *(GAS u32x2*)(rp + bj * 128 + n * 16) = w; } }
    }
};
struct EpiAttnQKV {
    static constexpr bool PERM = false, AFTER_DRAIN = false; bf16 *Q, *K, *V; const float *rc, *rs; int smask;
    __device__ __forceinline__ void operator()(const pg8::f32x4 (&acc)[2][2][4][2], const pg8::Unit& u, int wr, int wc, int fr, int fq) const {
        const int row0 = u.pm * 256 + wr * 64 + fr, region = u.pn >> 2, colt = (u.pn & 3) * 256;
        if (region == 2) {
            const int col0 = colt + wc * 32 + 4 * fq;
#pragma unroll
            for (int ai = 0; ai < 2; ++ai)
#pragma unroll
                for (int m = 0; m < 4; ++m) { GAS bf16* rp = (GAS bf16*)(V + (size_t)(row0 + ai * 128 + m * 16) * DM + col0);
#pragma unroll
                    for (int bj = 0; bj < 2; ++bj)
#pragma unroll
                        for (int n = 0; n < 2; ++n) { const f32x4 v = acc[ai][bj][m][n]; u32x2 w; w.x = cvtpk(v.x, v.y); w.y = cvtpk(v.z, v.w); *(GAS u32x2*)(rp + bj * 128 + n * 16) = w; } }
        } else {
            bf16* dst = region == 0 ? Q : K; const float sc = region == 0 ? 0.125f * LOG2E : 1.f; const int g = wc & 1, d1 = 16 * g + 4 * fq;
#pragma unroll
            for (int ai = 0; ai < 2; ++ai)
#pragma unroll
                for (int m = 0; m < 4; ++m) { const int row = row0 + ai * 128 + m * 16, s = row & smask;
                    const f32x4 c4 = *(GAS const f32x4*)(rc + s * 32 + d1) * sc, s4 = *(GAS const f32x4*)(rs + s * 32 + d1) * sc;
#pragma unroll
                    for (int bj = 0; bj < 2; ++bj) { const int cb = colt + bj * 128 + (wc >> 1) * 64;
                        const f32x4 x1 = acc[ai][bj][m][0], x2 = acc[ai][bj][m][1]; const f32x4 o1 = x1 * c4 - x2 * s4, o2 = x2 * c4 + x1 * s4;
                        u32x2 w; w.x = cvtpk(o1.x, o1.y); w.y = cvtpk(o1.z, o1.w); *(GAS u32x2*)(dst + (size_t)row * DM + cb + d1) = w;
                        w.x = cvtpk(o2.x, o2.y); w.y = cvtpk(o2.z, o2.w); *(GAS u32x2*)(dst + (size_t)row * DM + cb + d1 + 32) = w; } }
        }
    }
};
struct EpiRetQKV {
    static constexpr bool PERM = false, AFTER_DRAIN = false; bf16 *Q, *K, *V; const float *xc, *xs; int smask;
    __device__ __forceinline__ void operator()(const pg8::f32x4 (&acc)[2][2][4][2], const pg8::Unit& u, int wr, int wc, int fr, int fq) const {
        const int row0 = u.pm * 256 + wr * 64 + fr;
        if (u.pn >= 8) {
            const int col0 = (u.pn - 8) * 256 + wc * 32 + 4 * fq;
#pragma unroll
            for (int ai = 0; ai < 2; ++ai)
#pragma unroll
                for (int m = 0; m < 4; ++m) { GAS bf16* rp = (GAS bf16*)(V + (size_t)(row0 + ai * 128 + m * 16) * 2048 + col0);
#pragma unroll
                    for (int bj = 0; bj < 2; ++bj)
#pragma unroll
                        for (int n = 0; n < 2; ++n) { const f32x4 v = acc[ai][bj][m][n]; u32x2 w; w.x = cvtpk(v.x, v.y); w.y = cvtpk(v.z, v.w); *(GAS u32x2*)(rp + bj * 128 + n * 16) = w; } }
        } else {
            bf16* dst = u.pn < 4 ? Q : K; const float sc = u.pn < 4 ? 1.f : 0.0625f; const int col0 = (u.pn & 3) * 256 + wc * 32 + 4 * fq;
#pragma unroll
            for (int ai = 0; ai < 2; ++ai)
#pragma unroll
                for (int m = 0; m < 4; ++m) { const int row = row0 + ai * 128 + m * 16, s = row & smask;
#pragma unroll
                    for (int bj = 0; bj < 2; ++bj)
#pragma unroll
                        for (int n = 0; n < 2; ++n) { const int col = col0 + bj * 128 + n * 16, pi = (col & 255) >> 1;
                            const f32x2 c2 = *(GAS const f32x2*)(xc + s * 128 + pi) * sc, s2 = *(GAS const f32x2*)(xs + s * 128 + pi) * sc; const f32x4 x = acc[ai][bj][m][n];
                            u32x2 w; w.x = cvtpk(x.x * c2.x - x.y * s2.x, x.y * c2.x + x.x * s2.x); w.y = cvtpk(x.z * c2.y - x.w * s2.y, x.w * c2.y + x.z * s2.y);
                            const size_t qoff = u.pn < 4 ? ((((size_t)(row >> 5) * 4 + (col >> 8)) * 16 + ((col & 255) >> 4)) * 512 + (((col & 255) >> 3) & 1) * 256 + (row & 31) * 8 + (col & 7)) : ((size_t)row * DM + col);
                            *(GAS u32x2*)(dst + qoff) = w; } }
        }
    }
};

__device__ __forceinline__ void attn_phase(LAS unsigned char* lds, const bf16* Q, const bf16* K, const bf16* V, bf16* OB, int S, int nbatch, int vcu, int G, float lam, float oscale, const float* subln, float* o1s, const int wave) {
    lam = __uint_as_float(__builtin_amdgcn_readfirstlane(__float_as_uint(lam))); oscale = __uint_as_float(__builtin_amdgcn_readfirstlane(__float_as_uint(oscale)));
    const int nqb = S / 256, nunits = nbatch * 8 * nqb, per = (nunits + G - 1) / G;
    constexpr int KSTR = 128, VSTR = 256, QSTR = 144, KBYTES = 64 * KSTR, VBYTES = 64 * VSTR, VBASE = 3 * KBYTES, QBASE = VBASE + 4 * VBYTES;

    for (int it = 0; it < per; ++it) {
    int tid_l = tid_of(wave); asm volatile("" : "+v"(tid_l));
    const int tid = tid_l, lane = tid & 63, w = __builtin_amdgcn_readfirstlane(tid >> 6), l31 = lane & 31, hh = lane >> 5;
    const int i15 = lane & 15, qq = i15 >> 2, pp = i15 & 3;
    const int vtr_off = (4 * hh + qq) * VSTR + 32 * ((lane >> 4) & 1) + 8 * pp;
    const int kfr_off = l31 * KSTR, xk = l31 & 7;
    const size_t kdoff = (size_t)(8 * w + (lane >> 3)) * DM + (((lane & 7) ^ (lane >> 3)) << 3);
    const size_t vdoff = (size_t)(8 * w + (lane >> 4)) * DM + ((((((lane & 15) >> 2) ^ ((lane >> 4) & 3)) << 2) | (lane & 3)) << 3);
        const int u = vcu * per + it; if (u >= nunits) break;
        const int qb = u % nqb, bh = u / nqb, h = bh & 7, b = bh >> 3;
        const size_t rowbase = (size_t)b * S; const int q0 = qb * 256 + w * 32;
#pragma unroll 1
        for (int c = 0; c < 2; ++c) {
            const bf16* Kg = K + rowbase * DM + h * 128 + c * 64; const bf16* Vg = V + rowbase * DM + h * 128;
            size_t kdo = kdoff, vdo = vdoff; asm volatile("" : "+v"(kdo), "+v"(vdo));
            bf16x8 qf[4];
#pragma unroll
            for (int ds = 0; ds < 4; ++ds) qf[ds] = *(GAS const bf16x8*)(Q + (rowbase + q0 + l31) * DM + h * 128 + c * 64 + ds * 16 + hh * 8);
            LAS unsigned char* qst_ = lds + QBASE + w * (32 * QSTR) + l31 * QSTR + hh * 16;
            const int NT = S / 64;
#define ATT_DMA_K(TILE, SLOT) glds16((const void*)(Kg + kdo + (size_t)(TILE) * 64 * DM), (unsigned)__builtin_amdgcn_readfirstlane((int)(unsigned)(size_t)(lds + (SLOT) * KBYTES + w * 1024)))
#define ATT_DMA_V(TILE, SLOT) do { glds16((const void*)(Vg + vdo + (size_t)(TILE) * 64 * DM), (unsigned)__builtin_amdgcn_readfirstlane((int)(unsigned)(size_t)(lds + VBASE + (SLOT) * VBYTES + w * 2048))); \
                glds16((const void*)(Vg + vdo + ((size_t)(TILE) * 64 + 4) * DM), (unsigned)__builtin_amdgcn_readfirstlane((int)(unsigned)(size_t)(lds + VBASE + (SLOT) * VBYTES + w * 2048 + 1024))); } while (0)
            __syncthreads();
            ATT_DMA_K(0, 0); ATT_DMA_K(1, 1); ATT_DMA_V(0, 0); ATT_DMA_V(1, 1);
            {   unsigned z0_ = 0u; asm volatile("" : "+v"(z0_)); const u32x4 zz = {z0_, z0_, z0_, z0_};
                *(LAS u32x4*)(lds + VBASE + 3 * VBYTES + tid * 16) = zz; *(LAS u32x4*)(lds + VBASE + 3 * VBYTES + 8192 + tid * 16) = zz; }
            asm volatile("s_waitcnt vmcnt(0)" ::: "memory");
            __syncthreads();
            f32x16 o[4]; float zf_ = 0.f; asm volatile("" : "+v"(zf_));
#pragma unroll
            for (int d0 = 0; d0 < 4; ++d0)
#pragma unroll
                for (int r = 0; r < 16; ++r) o[d0][r] = zf_;
            float lrun = 0.f, alpha_prev = 1.f;
            f32x16 s0, s1;
#pragma unroll
            for (int ds = 0; ds < 4; ++ds) *(LAS bf16x8*)(qst_ + ds * 32) = qf[ds];
            bf16x8 pfp[4];
#pragma unroll
            for (int k4 = 0; k4 < 4; ++k4) pfp[k4] = (bf16x8){0, 0, 0, 0, 0, 0, 0, 0};
            float mref = -1e30f; f32x16 negm;
#pragma unroll
            for (int r = 0; r < 16; ++r) negm[r] = zf_;
            bool first = true;
            int ks_cur = 0, ks_stage = 2 * KBYTES;
#define KFA(I_) (kb_ + ((I_) & 1) * 32 * KSTR + ((((I_) & ~1) + hh) ^ xk) * 16)
#define VFA(V_) (vb_ + (16 * ((V_) >> 2)) * VSTR + ((((V_) & 3) ^ qq) << 6))
#define ATT_ITER(T_, KW_, V0W_, V1W_, KL_, V0L_, V1L_) do { \
                if (__any(alpha_prev != 1.f)) { \
                _Pragma("unroll") \
                    for (int d0 = 0; d0 < 4; ++d0) \
                _Pragma("unroll") \
                        for (int r = 0; r < 16; ++r) o[d0][r] *= alpha_prev; } \
                { const int tk = (T_ + 2 < NT) ? T_ + 2 : NT - 1; \
                  glds16((const void*)(Kg + kdo + (size_t)tk * 64 * DM), (unsigned)__builtin_amdgcn_readfirstlane((int)(unsigned)(size_t)(lds + ks_stage + w * 1024))); \
                  LAS unsigned char* vds_ = lds + VBASE + ((T_ + 2) & 3) * VBYTES + w * 2048; \
                  glds16((const void*)(Vg + vdo + (size_t)tk * 64 * DM), (unsigned)__builtin_amdgcn_readfirstlane((int)(unsigned)(size_t)(vds_))); \
                  glds16((const void*)(Vg + vdo + ((size_t)tk * 64 + 4) * DM), (unsigned)__builtin_amdgcn_readfirstlane((int)(unsigned)(size_t)(vds_ + 1024))); } \
                { LAS unsigned char* kb_ = lds + ks_cur + kfr_off; LAS unsigned char* vb_ = lds + VBASE + ((T_ + 3) & 3) * VBYTES + vtr_off; \
                  bf16x8 kfr[8], vfr[16], qfl[4]; \
                  kfr[0] = *(LAS bf16x8*)KFA(0); kfr[1] = *(LAS bf16x8*)KFA(1); \
                _Pragma("unroll") \
                  for (int i_ = 0; i_ < 8; ++i_) { \
                      if (i_ + 2 < 8) { kfr[i_ + 2] = *(LAS bf16x8*)KFA(i_ + 2); } \
                      else { const int v_ = i_ - 6; vfr[v_] = cat8(trr(VFA(v_)), trr(VFA(v_) + 8 * VSTR)); } \
                      __builtin_amdgcn_sched_barrier(0); \
                      if (i_ & 1) s1 = MFMA32(kfr[i_], qf[i_ >> 1], i_ == 1 ? negm : s1); else s0 = MFMA32(kfr[i_], qf[i_ >> 1], i_ == 0 ? negm : s0); \
                      __builtin_amdgcn_sched_barrier(0); } \
                  float mxa, mxb, rm, delta = 0.f, alpha = 1.f; f32x2 ps2 = {0.f, 0.f}; \
                _Pragma("unroll") \
                  for (int i_ = 0; i_ < 16; ++i_) { \
                      if (i_ + 2 < 16) { const int v_ = i_ + 2; vfr[v_] = cat8(trr(VFA(v_)), trr(VFA(v_) + 8 * VSTR)); } \
                      __builtin_amdgcn_sched_barrier(0); \
                      o[i_ & 3] = MFMA32(vfr[i_], pfp[i_ >> 2], o[i_ & 3]); \
                        \
                      if (i_ == 0) { mxa = max3f(s0[0], s0[1], s1[0]); mxb = max3f(s0[2], s0[3], s1[1]); mxa = max3f(mxa, s1[2], s1[3]); } \
                      if (i_ >= 1 && i_ <= 3) { const int r = 4 * i_; mxa = max3f(mxa, s0[r], s0[r + 1]); mxb = max3f(mxb, s0[r + 2], s0[r + 3]); mxa = max3f(mxa, s1[r], s1[r + 1]); mxb = max3f(mxb, s1[r + 2], s1[r + 3]); } \
                      if (i_ == 3) { rm = max3f(mxa, mxb, mxa); rm = max3f(rm, shx(rm, 32, lane), rm); } \
                      if (i_ == 4) { \
                          if (first || __any(rm > ATT_THR)) { delta = first ? rm : max3f(rm, 0.f, 0.f); const f32x2 mm2 = {delta, delta}; \
                              _Pragma("unroll") \
                              for (int r = 0; r < 16; r += 2) { const f32x2 a_ = (f32x2){s0[r], s0[r + 1]} - mm2, b_ = (f32x2){s1[r], s1[r + 1]} - mm2; s0[r] = a_.x; s0[r + 1] = a_.y; s1[r] = b_.x; s1[r + 1] = b_.y; } \
                              alpha = first ? 1.f : ex2(-delta); mref = first ? delta : mref + delta; first = false; \
                              _Pragma("unroll") \
                              for (int r = 0; r < 16; ++r) negm[r] = -mref; } } \
                      if (i_ >= 5) { const int e0 = (i_ - 5) * 3; \
                          _Pragma("unroll") \
                          for (int e_ = e0; e_ < e0 + 3 && e_ < 32; ++e_) { if (e_ < 16) s0[e_] = ex2(s0[e_]); else s1[e_ - 16] = ex2(s1[e_ - 16]); } } \
                      __builtin_amdgcn_sched_barrier(0); } \
                    \
                _Pragma("unroll") \
                  for (int r = 0; r < 16; r += 2) ps2 += (f32x2){s0[r], s0[r + 1]} + (f32x2){s1[r], s1[r + 1]}; \
                  lrun = lrun * alpha + (ps2.x + ps2.y); alpha_prev = alpha; \
                  pfp[0] = pack8(s0, 0); pfp[1] = pack8(s0, 8); pfp[2] = pack8(s1, 0); pfp[3] = pack8(s1, 8); } \
                asm volatile("s_waitcnt vmcnt(3)" ::: "memory"); \
                LBAR(); \
                ks_cur = (ks_cur == 2 * KBYTES) ? 0 : ks_cur + KBYTES; ks_stage = (ks_stage == 2 * KBYTES) ? 0 : ks_stage + KBYTES; \
            } while (0)
            for (int t = 0; t < NT; t += 2) { ATT_ITER(t, 0, 0, 0, 0, 0, 0); ATT_ITER(t + 1, 0, 0, 0, 0, 0, 0); }
            asm volatile("s_waitcnt vmcnt(0)" ::: "memory");
#undef ATT_ITER
#undef KFA
#undef VFA
#undef ATT_DMA_K
#undef ATT_DMA_V
            {
#pragma unroll
                for (int d0 = 0; d0 < 4; ++d0)
#pragma unroll
                    for (int r = 0; r < 16; ++r) o[d0][r] *= alpha_prev;
                LAS unsigned char* vb_ = lds + VBASE + ((NT - 1) & 3) * VBYTES + vtr_off;
#pragma unroll
                for (int ks = 0; ks < 4; ++ks)
#pragma unroll
                    for (int d0 = 0; d0 < 4; ++d0) { LAS unsigned char* vp = vb_ + (16 * ks) * VSTR + ((d0 ^ qq) << 6);
                        const bf16x8 vf = cat8(trr(vp), trr(vp + 8 * VSTR)); o[d0] = MFMA32(vf, pfp[ks], o[d0]); } }
            lrun += shx(lrun, 32, lane);
            const float inv = 1.f / lrun;
            GAS float* o1p = (GAS float*)(o1s + tid); asm volatile("" : "+v"(o1p));
            if (c == 0) {
#pragma unroll
                for (int d0 = 0; d0 < 4; ++d0)
#pragma unroll
                    for (int r = 0; r < 16; ++r) o1p[(d0 * 16 + r) * 512] = o[d0][r] * inv;
            } else {
                float ss = 0.f;
#pragma unroll
                for (int d0 = 0; d0 < 4; ++d0)
#pragma unroll
                    for (int r = 0; r < 16; ++r) { const float v = o1p[(d0 * 16 + r) * 512] - lam * (o[d0][r] * inv); o[d0][r] = v; ss += v * v; }
                ss += shx(ss, 32, lane);
                const float rstd = rsqrtf(ss * (1.f / 128.f) + 1e-5f) * oscale;
                GAS bf16* orow = (GAS bf16*)(OB + (rowbase + q0 + l31) * DM + h * 128); asm volatile("" : "+v"(orow));
#pragma unroll
                for (int d0 = 0; d0 < 4; ++d0)
#pragma unroll
                    for (int rg = 0; rg < 4; ++rg) { const int d = 32 * d0 + 8 * rg + 4 * hh; const f32x4 w4 = *(GAS const f32x4*)(subln + d);
                        u32x2 wv; wv.x = cvtpk(o[d0][4 * rg] * rstd * w4.x, o[d0][4 * rg + 1] * rstd * w4.y); wv.y = cvtpk(o[d0][4 * rg + 2] * rstd * w4.z, o[d0][4 * rg + 3] * rstd * w4.w);
                        *(GAS u32x2*)(orow + d) = wv; }
            }
        }
    }
}

__device__ __forceinline__ void scan_phase(LAS unsigned char* lds, const bf16* Q, const bf16* K, const bf16* V, bf16* OF, bf16* OBK, int S, int nbatch, int vcu, int G, const float* decay, const int wave) {
    const int n = S / 128, nunits = nbatch * 64, per = (nunits + G - 1) / G;
    constexpr int KSTR = 576, VSTR = 192, RSTR = 528, KT = 0, VT = 128 * KSTR, RT = VT + 128 * VSTR;
    for (int it = 0; it < per; ++it) {
    int tid_l = tid_of(wave); asm volatile("" : "+v"(tid_l));
    const int tid = tid_l, lane = tid & 63, w = __builtin_amdgcn_readfirstlane(tid >> 6), l31 = lane & 31, hh = lane >> 5;
    const int i15 = lane & 15, qq = i15 >> 2, pp = i15 & 3, cg16 = 16 * ((lane >> 4) & 1) + 4 * pp;
    const int tb = w >> 1, nbk = w & 1;
        const int u = vcu * per + it; if (u >= nunits) break;
        const int dir = u & 1, j = (u >> 1) & 7, h = (u >> 4) & 3, b = u >> 6;
        const float lg2 = -__expf(((GAS const float*)decay)[dir * 4 + h]) * LOG2E;
        const float cd = ex2(lg2 * 128.f);
        bf16* OD = dir ? OBK : OF;
        f32x16 racc[2];
#pragma unroll
        for (int r = 0; r < 16; ++r) { racc[0][r] = 0.f; racc[1][r] = 0.f; }
        u32x4 kreg[8], vreg[2];
        { const int c = dir ? n - 1 : 0; const size_t rowb = (size_t)b * S + (size_t)c * 128;
#pragma unroll
          for (int ii = 0; ii < 8; ++ii) { const int idx = tid + 512 * ii, row = idx >> 5, ch = idx & 31; kreg[ii] = *(GAS const u32x4*)(K + (rowb + row) * DM + h * 256 + ch * 8); }
#pragma unroll
          for (int ii = 0; ii < 2; ++ii) { const int idx = tid + 512 * ii, row = idx >> 3, ch = idx & 7; vreg[ii] = *(GAS const u32x4*)(V + (rowb + row) * 2048 + h * 512 + j * 64 + ch * 8); } }
        bf16x8 qfr[8];
        { const int c = dir ? n - 1 : 0; GAS const bf16* qp = (GAS const bf16*)(Q + ((((size_t)b * S + (size_t)c * 128 + 32 * tb) >> 5) * 4 + h) * 8192 + hh * 256 + l31 * 8);
#pragma unroll
          for (int ks = 0; ks < 8; ++ks) qfr[ks] = *(GAS const bf16x8*)(qp + 512 * ks); }
        __syncthreads();
        for (int step = 0; step < n; ++step) {
            const int c = dir ? n - 1 - step : step; const size_t rowb = (size_t)b * S + (size_t)c * 128;
            bf16x8 qlate[8];
            { GAS const bf16* qp = (GAS const bf16*)(Q + (((rowb + 32 * tb) >> 5) * 4 + h) * 8192 + hh * 256 + l31 * 8);
#pragma unroll
              for (int ks = 0; ks < 8; ++ks) qlate[ks] = *(GAS const bf16x8*)(qp + 512 * (8 + ks)); }
            asm volatile("" ::: "memory");
#pragma unroll
            for (int ii = 0; ii < 8; ++ii) { const int idx = tid + 512 * ii, row = idx >> 5, ch = idx & 31; *(LAS u32x4*)(lds + KT + row * KSTR + ch * 16) = kreg[ii]; }
#pragma unroll
            for (int ii = 0; ii < 2; ++ii) { const int idx = tid + 512 * ii, row = idx >> 3, ch = idx & 7;
                const float z = ex2(lg2 * (float)(dir ? row : 127 - row)); const u32x4 v = vreg[ii]; u32x4 o;
                o.x = cvtpk(__uint_as_float(v.x << 16) * z, __uint_as_float(v.x & 0xffff0000u) * z); o.y = cvtpk(__uint_as_float(v.y << 16) * z, __uint_as_float(v.y & 0xffff0000u) * z);
                o.z = cvtpk(__uint_as_float(v.z << 16) * z, __uint_as_float(v.z & 0xffff0000u) * z); o.w = cvtpk(__uint_as_float(v.w << 16) * z, __uint_as_float(v.w & 0xffff0000u) * z);
                *(LAS u32x4*)(lds + VT + row * VSTR + ch * 16) = o; }
#pragma unroll
            for (int nb2 = 0; nb2 < 2; ++nb2)
#pragma unroll
                for (int rg = 0; rg < 4; ++rg) { u32x2 wv; wv.x = cvtpk(racc[nb2][4 * rg], racc[nb2][4 * rg + 1]); wv.y = cvtpk(racc[nb2][4 * rg + 2], racc[nb2][4 * rg + 3]);
                    *(LAS u32x2*)(lds + RT + (32 * nb2 + l31) * RSTR + (32 * w + 8 * rg + 4 * hh) * 2) = wv; }
            LBAR();
            if (step + 1 < n) { const int c2 = dir ? c - 1 : c + 1; const size_t rb2 = (size_t)b * S + (size_t)c2 * 128;
#pragma unroll
                for (int ii = 0; ii < 8; ++ii) { const int idx = tid + 512 * ii, row = idx >> 5, ch = idx & 31; kreg[ii] = *(GAS const u32x4*)(K + (rb2 + row) * DM + h * 256 + ch * 8); }
#pragma unroll
                for (int ii = 0; ii < 2; ++ii) { const int idx = tid + 512 * ii, row = idx >> 3, ch = idx & 7; vreg[ii] = *(GAS const u32x4*)(V + (rb2 + row) * 2048 + h * 512 + j * 64 + ch * 8); } }
            { f32x16 acc;
#pragma unroll
              for (int r = 0; r < 16; ++r) acc[r] = 0.f;
              LAS unsigned char* rp = lds + RT + (32 * nbk + l31) * RSTR + 16 * hh;
#pragma unroll
              for (int ks = 0; ks < 8; ++ks) { const bf16x8 bfr = *(LAS bf16x8*)(rp + 32 * ks); acc = MFMA32(bfr, qfr[ks], acc); }
#pragma unroll
              for (int ks = 0; ks < 8; ++ks) { const bf16x8 bfr = *(LAS bf16x8*)(rp + 32 * (8 + ks)); acc = MFMA32(bfr, qlate[ks], acc); }
              if (step + 1 < n) { const int c2 = dir ? c - 1 : c + 1; GAS const bf16* qp = (GAS const bf16*)(Q + ((((size_t)b * S + (size_t)c2 * 128 + 32 * tb) >> 5) * 4 + h) * 8192 + hh * 256 + l31 * 8);
#pragma unroll
                  for (int ks = 0; ks < 8; ++ks) qfr[ks] = *(GAS const bf16x8*)(qp + 512 * ks); }
              const int tok = 32 * tb + l31; const float xi = ex2(lg2 * (float)(dir ? 128 - tok : tok + 1));
              GAS bf16* op = (GAS bf16*)(OD + (rowb + 16 * j + 8 * nbk + hh) * 2048 + h * 512 + tok * 4);
#pragma unroll
              for (int rg = 0; rg < 4; ++rg) { u32x2 wv; wv.x = cvtpk(acc[4 * rg] * xi, acc[4 * rg + 1] * xi); wv.y = cvtpk(acc[4 * rg + 2] * xi, acc[4 * rg + 3] * xi); *(GAS u32x2*)(op + (size_t)(2 * rg) * 2048) = wv; } }
#pragma unroll
            for (int r = 0; r < 16; ++r) { racc[0][r] *= cd; racc[1][r] *= cd; }
#pragma unroll
            for (int ks = 0; ks < 8; ++ks) { const int row = 16 * ks + 8 * hh + qq;
                LAS unsigned char* kp = lds + KT + row * KSTR + (32 * w + cg16) * 2; const bf16x8 af = cat8(trr(kp), trr(kp + 4 * KSTR));
                LAS unsigned char* vp = lds + VT + row * VSTR + cg16 * 2; const bf16x8 b0 = cat8(trr(vp), trr(vp + 4 * VSTR)), b1 = cat8(trr(vp + 64), trr(vp + 64 + 4 * VSTR));
                racc[0] = MFMA32(af, b0, racc[0]); racc[1] = MFMA32(af, b1, racc[1]); }
            LBAR();
        }
    }
}

__device__ __forceinline__ void intra_phase(LAS unsigned char* lds, const bf16* Q, const bf16* K, const bf16* V, bf16* OF, const bf16* OBK, int S, int nbatch, int vcu, int G, const float* decay, const int wave, const bool do_store = true) {
    const int n = S / 128, nunits = nbatch * 4 * n, per = (nunits + G - 1) / G;
    constexpr int KSTR = 528, VSTR = 320, KT = 0, VT = 128 * KSTR, SSB = VT + 128 * VSTR;
    for (int it = 0; it < per; ++it) {
    int tid_l = tid_of(wave); asm volatile("" : "+v"(tid_l));
    const int tid = tid_l, lane = tid & 63, w = __builtin_amdgcn_readfirstlane(tid >> 6), l31 = lane & 31, hh = lane >> 5;
    const int i15 = lane & 15, qq = i15 >> 2, pp = i15 & 3, cg16 = 16 * ((lane >> 4) & 1) + 4 * pp;
    const int qb = w >> 1, par = w & 1;
        const int u = vcu * per + it; if (u >= nunits) break;
        const int c = u % n, bh = u / n, h = bh & 3, b = bh >> 2;
        const float lgf2 = -__expf(((GAS const float*)decay)[h]) * LOG2E, lgb2 = -__expf(((GAS const float*)decay)[4 + h]) * LOG2E;
        const size_t rowb = (size_t)b * S + (size_t)c * 128;
        __syncthreads();
#pragma unroll
        for (int ii = 0; ii < 8; ++ii) { const int idx = tid + 512 * ii, row = idx >> 5, ch = idx & 31; *(LAS u32x4*)(lds + KT + row * KSTR + ch * 16) = *(GAS const u32x4*)(K + (rowb + row) * DM + h * 256 + ch * 8); }
        u32x4 vreg[4];
#pragma unroll
        for (int ii = 0; ii < 4; ++ii) { const int idx = tid + 512 * ii, row = idx >> 4, ch = idx & 15; vreg[ii] = *(GAS const u32x4*)(V + (rowb + row) * 2048 + h * 512 + ch * 8); }
        __syncthreads();
        bf16x8 pf[8];
        { f32x16 X[4];
#pragma unroll
          for (int k4 = 0; k4 < 4; ++k4)
#pragma unroll
              for (int r = 0; r < 16; ++r) X[k4][r] = 0.f;
          GAS const bf16* qp = (GAS const bf16*)(Q + (((rowb + 32 * qb) >> 5) * 4 + h) * 8192 + hh * 256 + l31 * 8); LAS unsigned char* kp = lds + KT + l31 * KSTR + 16 * hh;
#pragma unroll
          for (int ks = 0; ks < 16; ++ks) { const bf16x8 bq = *(GAS const bf16x8*)(qp + 512 * ks);
#pragma unroll
              for (int k4 = 0; k4 < 4; ++k4) { const bf16x8 a = *(LAS bf16x8*)(kp + 32 * k4 * KSTR + 32 * ks); X[k4] = MFMA32(a, bq, X[k4]); } }
          const int iq = 32 * qb + l31;
#pragma unroll
          for (int k4 = 0; k4 < 4; ++k4) {
#pragma unroll
              for (int r = 0; r < 16; ++r) { const int d = iq - (32 * k4 + crow(r, hh)); X[k4][r] *= ex2(d >= 0 ? lgf2 * (float)d : -lgb2 * (float)d); }
              pf[2 * k4] = pack8(X[k4], 0); pf[2 * k4 + 1] = pack8(X[k4], 8); } }
        f32x16 z[8];
#pragma unroll
        for (int t = 0; t < 8; ++t)
#pragma unroll
            for (int r = 0; r < 16; ++r) z[t][r] = 0.f;
#pragma unroll
        for (int p = 0; p < 4; ++p) {
#pragma unroll
            for (int ii = 0; ii < 4; ++ii) { const int idx = tid + 512 * ii, row = idx >> 4, ch = idx & 15; *(LAS u32x4*)(lds + VT + row * VSTR + ch * 16) = vreg[ii]; }
            LBAR();
            if (p < 3) {
#pragma unroll
                for (int ii = 0; ii < 4; ++ii) { const int idx = tid + 512 * ii, row = idx >> 4, ch = idx & 15; vreg[ii] = *(GAS const u32x4*)(V + (rowb + row) * 2048 + h * 512 + (p + 1) * 128 + ch * 8); } }
#pragma unroll
            for (int bi = 0; bi < 2; ++bi) { const int blk = 2 * bi + par;
#pragma unroll
                for (int ks = 0; ks < 8; ++ks) { LAS unsigned char* vp = lds + VT + (16 * ks + 4 * hh + qq) * VSTR + (32 * blk + cg16) * 2;
                    const bf16x8 vf = cat8(trr(vp), trr(vp + 8 * VSTR)); z[2 * p + bi] = MFMA32(vf, pf[ks], z[2 * p + bi]); } }
            LBAR();
        }
        size_t ebase = (rowb + 32 * qb + l31) * 2048 + h * 512 + 32 * par + 4 * hh; asm volatile("" : "+v"(ebase));
        size_t xbase = (rowb + 8 * par + hh) * 2048 + h * 512 + (32 * qb + l31) * 4; asm volatile("" : "+v"(xbase));
        float ssq = 0.f;
#pragma unroll
        for (int t = 0; t < 8; ++t) { const int co = 128 * (t >> 1) + 64 * (t & 1);
#pragma unroll
            for (int rg = 0; rg < 4; ++rg) { const size_t xo_ = xbase + (size_t)((co >> 2) + 2 * rg) * 2048; const u32x2 a_ = *(GAS const u32x2*)(OF + xo_), b_ = *(GAS const u32x2*)(OBK + xo_);
                z[t][4 * rg] += __uint_as_float(a_.x << 16) + __uint_as_float(b_.x << 16); z[t][4 * rg + 1] += __uint_as_float(a_.x & 0xffff0000u) + __uint_as_float(b_.x & 0xffff0000u);
                z[t][4 * rg + 2] += __uint_as_float(a_.y << 16) + __uint_as_float(b_.y << 16); z[t][4 * rg + 3] += __uint_as_float(a_.y & 0xffff0000u) + __uint_as_float(b_.y & 0xffff0000u);
                ssq += z[t][4 * rg] * z[t][4 * rg] + z[t][4 * rg + 1] * z[t][4 * rg + 1] + z[t][4 * rg + 2] * z[t][4 * rg + 2] + z[t][4 * rg + 3] * z[t][4 * rg + 3]; }
            asm volatile("" ::: "memory"); }
        ssq += shx(ssq, 32, lane);
        LAS float* ssb = (LAS float*)(lds + SSB);
        if (hh == 0) ssb[w * 32 + l31] = ssq;
        __syncthreads();
        const float rstd = rsqrtf((ssq + ssb[(w ^ 1) * 32 + l31]) * (1.f / 512.f) + 1e-6f);
        asm volatile("" : "+v"(ebase));
#pragma unroll
        for (int t = 0; t < 8; ++t) { const int co = 128 * (t >> 1) + 64 * (t & 1);
#pragma unroll
            for (int rg = 0; rg < 4; ++rg) { u32x2 wv; wv.x = cvtpk(z[t][4 * rg] * rstd, z[t][4 * rg + 1] * rstd); wv.y = cvtpk(z[t][4 * rg + 2] * rstd, z[t][4 * rg + 3] * rstd); if (do_store) *(GAS u32x2*)(OF + ebase + co + 8 * rg) = wv; }
            asm volatile("" ::: "memory"); }
    }
}

#define XB_TMO      128
#define XB_XCNT(j)  (256  + 64 * (j))
#define XB_XSUB(j)  (1280 + 64 * (j))
#define XB_XGEN(j)  (2304 + 64 * (j))
#define XB_TOP      3328
#define XB_TOPGEN   3392
#define XCD_BAR_WORDS 3456
#define XB_SPIN_CAP (1u << 18)

__device__ __forceinline__ unsigned xb_ld(unsigned* p)              { return __hip_atomic_load(p, __ATOMIC_RELAXED, __HIP_MEMORY_SCOPE_AGENT); }
__device__ __forceinline__ unsigned xb_add(unsigned* p, unsigned v) { return __hip_atomic_fetch_add(p, v, __ATOMIC_RELAXED, __HIP_MEMORY_SCOPE_AGENT); }
__device__ __forceinline__ unsigned xb_xcc_id() { return (unsigned)__builtin_amdgcn_s_getreg((3 << 11) | 20) & 0xFu; }
#define XB_SPIN(cond, bar) do { unsigned _sp = 0; while (cond) { __builtin_amdgcn_s_sleep(1); \
    if ((++_sp & 255u) == 0u) { if (xb_ld(&(bar)[XB_TMO])) break; if (_sp > XB_SPIN_CAP) { atomicAdd(&(bar)[XB_TMO], 1u); break; } } } } while (0)

struct XcdBarrier {
    unsigned* bar; unsigned x;
    volatile LAS unsigned* st;
};

__device__ __forceinline__ XcdBarrier xcd_barrier_post(unsigned* bar, volatile LAS unsigned* st, const bool tid0) {
    XcdBarrier b; b.bar = bar; b.x = xb_xcc_id(); b.st = st;
    if (tid0) (void)xb_add(&bar[XB_XCNT(b.x)], 1u);
    return b;
}
__device__ __forceinline__ void xcd_barrier_complete(unsigned* bar, unsigned x, unsigned& nloc, unsigned& nx) {
    const unsigned G = gridDim.x * gridDim.y * gridDim.z;
    unsigned sum, cnt, mine, sp = 0u;
    for (;;) {
        sum = 0u; cnt = 0u; mine = 0u;
#pragma unroll
        for (unsigned j = 0; j < 16; ++j) { const unsigned c = xb_ld(&bar[XB_XCNT(j)]); sum += c; cnt += (c > 0u) ? 1u : 0u; mine = (j == x) ? c : mine; }
        if (sum == G) break;
        __builtin_amdgcn_s_sleep(1);
        if ((++sp & 255u) == 0u) { if (xb_ld(&bar[XB_TMO])) break; if (sp > XB_SPIN_CAP) { atomicAdd(&bar[XB_TMO], 1u); break; } }
    }
    nloc = mine > 0u ? mine : 1u; nx = cnt > 0u ? cnt : 1u;
}

__device__ __forceinline__ void xcd_barrier(const XcdBarrier& b, const bool tid0) {
    asm volatile("s_waitcnt vmcnt(0)" ::: "memory");
    __syncthreads();
    if (tid0) {
        unsigned* bar = b.bar;
        __builtin_amdgcn_s_waitcnt(0);
        unsigned nloc = b.st[0], nx = b.st[1];
        if (nloc == 0u) { xcd_barrier_complete(bar, b.x, nloc, nx); b.st[0] = nloc; b.st[1] = nx; }
        const unsigned old = xb_add(&bar[XB_XSUB(b.x)], 1u);
        const unsigned gen = old / nloc;
        if (old + 1u == (gen + 1u) * nloc) {
            __builtin_amdgcn_fence(__ATOMIC_RELEASE, "agent");
            asm volatile("s_waitcnt vmcnt(0)" ::: "memory");
            const unsigned og = xb_add(&bar[XB_TOP], 1u);
            const unsigned tg = og / nx;
            if (og + 1u == (tg + 1u) * nx) xb_add(&bar[XB_TOPGEN], 1u);
            else XB_SPIN(xb_ld(&bar[XB_TOPGEN]) == tg, bar);
            __builtin_amdgcn_fence(__ATOMIC_ACQUIRE, "agent");
            xb_add(&bar[XB_XGEN(b.x)], 1u);
            asm volatile("s_waitcnt vmcnt(0)" ::: "memory");
        } else {
            XB_SPIN(xb_ld(&bar[XB_XGEN(b.x)]) == gen, bar);
            __builtin_amdgcn_fence(__ATOMIC_ACQUIRE, "agent");
            asm volatile("s_waitcnt vmcnt(0)" ::: "memory");
        }
    }
    __syncthreads();
}

__device__ __forceinline__ void gbar(unsigned* ctr, unsigned target, const int wave) {
    asm volatile("s_waitcnt vmcnt(0)" ::: "memory");
    __syncthreads();
    int t_ = tid_of(wave); asm volatile("" : "+v"(t_));
    if (t_ == 0) {
        __builtin_amdgcn_fence(__ATOMIC_RELEASE, "agent");
        asm volatile("s_waitcnt vmcnt(0) lgkmcnt(0)" ::: "memory");
        __hip_atomic_fetch_add(ctr, 1u, __ATOMIC_RELAXED, __HIP_MEMORY_SCOPE_AGENT);
        while (__hip_atomic_load(ctr, __ATOMIC_RELAXED, __HIP_MEMORY_SCOPE_AGENT) < target) __builtin_amdgcn_s_sleep(2);
        __builtin_amdgcn_fence(__ATOMIC_ACQUIRE, "agent");
        asm volatile("s_waitcnt vmcnt(0) lgkmcnt(0)" ::: "memory");
    }
    __syncthreads();
}
#define GSYNC() do { nsync += (unsigned)Gn; gbar(gctr, nsync, wave); } while (0)

#define GEMM_CALL(EPI_T, A_, B_, M_, N_, K_, E_) do { pg8::Gemm g_{(const pg8::bf16_t*)(A_), (const pg8::bf16_t*)(B_), (M_), (N_), (K_)}; pg8::StaticOrder S_; S_.init((M_), (N_), Gn, (int)blockIdx.x); \
    pg8::gemm_phase<EPI_T, pg8::StaticOrder, true, true>(lds, g_, S_, (E_), wave); } while (0)

#ifdef DBG
__device__ __forceinline__ void dbg_acc(unsigned char* ws, int id, float err2, float ref2, int lane) { if (lane == 0) { atomicAdd((float*)(ws + WS_CTL + 1024) + 2 * id, err2); atomicAdd((float*)(ws + WS_CTL + 1024) + 2 * id + 1, ref2); } }
__device__ __forceinline__ float wsum_d(float v) { for (int o = 1; o < 64; o <<= 1) v += __shfl_xor(v, o); return v; }
__device__ __forceinline__ float dbg_dot(const bf16* arow, const float* W, int K, int N, int col, int lane) { float a = 0.f; for (int k = lane; k < K; k += 64) a += bf2f(arow[k]) * W[(size_t)k * N + col]; return wsum_d(a); }
__device__ __forceinline__ void dbg_gemm(unsigned char* ws, int id, const bf16* A, const float* W, int K, int N, const void* O, int ldo, int mode, int gwv, int lane) {
    if (gwv >= 256) return;
    const int row = (gwv * 2731 + 17) % TG, col = (gwv * 977 + 5) % N;
    float ref = dbg_dot(A + (size_t)row * K, W, K, N, col, lane), got;
    if (mode == 0) got = ((const float*)O)[(size_t)row * ldo + col]; else if (mode == 2) got = bf2f(((const bf16*)O)[(size_t)row * ldo + col]); else { ref = fmaxf(ref, 0.f); ref *= ref; got = bf2f(((const bf16*)O)[(size_t)row * ldo + col]); }
    dbg_acc(ws, id, (got - ref) * (got - ref), ref * ref, lane);
}
__device__ __forceinline__ void dbg_attn_qkv(unsigned char* ws, int id, const bf16* A, const float* W, const bf16* Qb, const bf16* Kb, const bf16* Vb, int S, int gwv, int lane) {
    if (gwv >= 256) return;
    const int row = (gwv * 2731 + 17) % TG, col = (gwv * 1549 + 3) % 3072, region = col >> 10, cr = col & 1023, d = cr & 63, s = row % S;
    float x = dbg_dot(A + (size_t)row * 1024, W, 1024, 3072, col, lane), ref, got;
    if (region == 2) { ref = x; got = bf2f(Vb[(size_t)row * 1024 + cr]); }
    else { const int pc = d < 32 ? col + 32 : col - 32; const float xp = dbg_dot(A + (size_t)row * 1024, W, 1024, 3072, pc, lane);
        const float inv = ex2(-13.287712379549449f * (float)(2 * (d & 31)) / 64.0f); const double ad = (double)((float)s * inv); const float ang = (float)(ad - 6.283185307179586 * floor(ad / 6.283185307179586)); const float rot = d < 32 ? -xp : xp;
        ref = x * __cosf(ang) + rot * __sinf(ang); if (region == 0) ref *= 0.125f * LOG2E; got = bf2f((region == 0 ? Qb : Kb)[(size_t)row * 1024 + cr]); }
    dbg_acc(ws, id, (got - ref) * (got - ref), ref * ref, lane);
}
__device__ __forceinline__ void dbg_ret_qkv(unsigned char* ws, int id, const bf16* A, const float* W, const bf16* Qb, const bf16* Kb, const bf16* Vb, int S, int gwv, int lane) {
    if (gwv >= 256) return;
    const int row = (gwv * 2731 + 17) % TG, col = (gwv * 1549 + 3) % 4096, s = row % S;
    float x = dbg_dot(A + (size_t)row * 1024, W, 1024, 6144, col, lane), ref, got;
    if (col >= 2048) { ref = x; got = bf2f(Vb[(size_t)row * 2048 + col - 2048]); }
    else { const float xp = dbg_dot(A + (size_t)row * 1024, W, 1024, 6144, col ^ 1, lane); const int pi = (col & 255) >> 1;
        const float a = ex2(-13.287712379549449f * (float)pi / 127.0f); const double ad = (double)((float)s * a); const float ang = (float)(ad - 6.283185307179586 * floor(ad / 6.283185307179586)); const float rot = (col & 1) ? xp : -xp;
        ref = x * __cosf(ang) + rot * __sinf(ang); if (col >= 1024) ref *= 0.0625f; got = bf2f((col < 1024 ? Qb : Kb)[(size_t)row * 1024 + (col & 1023)]); }
    dbg_acc(ws, id, (got - ref) * (got - ref), ref * ref, lane);
}
__device__ __forceinline__ void dbg_attn(unsigned char* ws, int id, const bf16* Qb, const bf16* Kb, const bf16* Vb, const bf16* OB, int S, int NB, float lam, float oscale, const float* subln, int gwv, int lane) {
    if (gwv >= 32) return;
    const int b = gwv % NB, s = (gwv * 389 + 7) % S, h = (gwv * 5 + 1) & 7; const size_t row = (size_t)b * S + s, rb = (size_t)b * S;
    float of0 = 0.f, of1 = 0.f;
    for (int c = 0; c < 2; ++c) {
        const float q = bf2f(Qb[row * 1024 + h * 128 + c * 64 + lane]);
        float mr = -1e30f, l = 0.f, o0 = 0.f, o1 = 0.f;
        for (int m = 0; m < S; ++m) {
            const float sc = wsum_d(q * bf2f(Kb[(rb + m) * 1024 + h * 128 + c * 64 + lane]));
            const float mn = fmaxf(mr, sc), al = exp2f(mr - mn), p = exp2f(sc - mn); mr = mn;
            l = l * al + p; o0 = o0 * al + p * bf2f(Vb[(rb + m) * 1024 + h * 128 + lane]); o1 = o1 * al + p * bf2f(Vb[(rb + m) * 1024 + h * 128 + 64 + lane]);
        }
        if (c == 0) { of0 = o0 / l; of1 = o1 / l; } else { of0 -= lam * o0 / l; of1 -= lam * o1 / l; }
    }
    const float ss = wsum_d(of0 * of0 + of1 * of1), r = rsqrtf(ss / 128.f + 1e-5f) * oscale;
    const float r0 = of0 * r * subln[lane], r1 = of1 * r * subln[64 + lane];
    const float g0 = bf2f(OB[row * 1024 + h * 128 + lane]), g1 = bf2f(OB[row * 1024 + h * 128 + 64 + lane]);
    dbg_acc(ws, id, wsum_d((g0 - r0) * (g0 - r0) + (g1 - r1) * (g1 - r1)), wsum_d(r0 * r0 + r1 * r1), lane);
}
__device__ __forceinline__ void dbg_ret(unsigned char* ws, int id, const bf16* Qb, const bf16* Kb, const bf16* Vb, const bf16* OB, int S, int NB, const float* decay, int gwv, int lane) {
    if (gwv >= 32) return;
    const int b = gwv % NB, n = (gwv * 389 + 7) % S, h = (gwv * 3 + 1) & 3; const size_t row = (size_t)b * S + n, rb = (size_t)b * S;
    const float lgf = -expf(decay[h]), lgb = -expf(decay[4 + h]);
    float q[4], o[8];
#pragma unroll
    for (int t = 0; t < 4; ++t) q[t] = bf2f(Qb[row * 1024 + h * 256 + lane + 64 * t]);
#pragma unroll
    for (int t = 0; t < 8; ++t) o[t] = 0.f;
    for (int m = 0; m < S; ++m) {
        float a = 0.f;
#pragma unroll
        for (int t = 0; t < 4; ++t) a += q[t] * bf2f(Kb[(rb + m) * 1024 + h * 256 + lane + 64 * t]);
        a = wsum_d(a) * (m <= n ? expf(lgf * (float)(n - m)) : expf(lgb * (float)(m - n)));
#pragma unroll
        for (int t = 0; t < 8; ++t) o[t] += a * bf2f(Vb[(rb + m) * 2048 + h * 512 + lane + 64 * t]);
    }
    float ss = 0.f;
#pragma unroll
    for (int t = 0; t < 8; ++t) ss += o[t] * o[t];
    const float r = rsqrtf(wsum_d(ss) / 512.f + 1e-6f); float e2 = 0.f, r2 = 0.f;
#pragma unroll
    for (int t = 0; t < 8; ++t) { const float rf = o[t] * r, gt = bf2f(OB[row * 2048 + h * 512 + lane + 64 * t]); e2 += (gt - rf) * (gt - rf); r2 += rf * rf; }
    dbg_acc(ws, id, wsum_d(e2), wsum_d(r2), lane);
}

__device__ __forceinline__ void dbg_rp(unsigned char* ws, int id, const float* xold, const float* xnew, const float* m, const float* wpost, const float* wpre, const bf16* hb, int gwv, int lane) {
    if (gwv >= 64) return;
    const int row = (gwv * 2731 + 17) % TG; float e2 = 0.f, r2 = 0.f, ss = 0.f, xs[16];
    if (m) { for (int k = lane; k < 1024; k += 64) { const float v = m[(size_t)row * 1024 + k]; ss += v * v; } }
    const float r = rsqrtf(wsum_d(ss) / 1024.f + 1e-6f); float s2 = 0.f;
#pragma unroll
    for (int t = 0; t < 16; ++t) { const int k = lane + 64 * t; float v = xold ? xold[(size_t)row * 1024 + k] : xnew[(size_t)row * 1024 + k]; if (m) v += m[(size_t)row * 1024 + k] * r * wpost[k]; xs[t] = v; s2 += v * v;
        if (xold) { const float g = xnew[(size_t)row * 1024 + k]; e2 += (g - v) * (g - v); r2 += v * v; } }
    const float rr = rsqrtf(wsum_d(s2) / 1024.f + 1e-6f);
#pragma unroll
    for (int t = 0; t < 16; ++t) { const int k = lane + 64 * t; const float rf = xs[t] * rr * (wpre ? wpre[k] : 1.f), g = bf2f(hb[(size_t)row * 1024 + k]); e2 += (g - rf) * (g - rf); r2 += rf * rf; }
    dbg_acc(ws, id, wsum_d(e2), wsum_d(r2), lane);
}
#endif

#ifndef REP_MASK
#define REP_MASK 0
#endif
#ifndef DBG_MASK
#define DBG_MASK 255
#endif
#ifndef DBG_G
#define DBG_G 0
#endif
#ifndef DBG_TOL
#define DBG_TOL 1e-3f
#endif
#define PT_OFF 146944
__device__ __forceinline__ unsigned long long ldpk(int k) { unsigned a = (unsigned)(PT_OFF + 8 * k); asm volatile("" : "+s"(a)); const unsigned long long v = *(LAS unsigned long long*)a;
    const unsigned lo = __builtin_amdgcn_readfirstlane((unsigned)v), hi = __builtin_amdgcn_readfirstlane((unsigned)(v >> 32)); return ((unsigned long long)hi << 32) | lo; }
#define PIN(k) ((const float*)ldpk(k))
#define WSP ((unsigned char*)ldpk(23))
#define GW (vcu * 8 + wave)
#define NGW (Gn * 8)
#define GCTR ((unsigned*)(WSP + WS_CTL))
#undef GSYNC
#define XBAR_WORDS ((unsigned*)(WSP + WS_CTL + 16384))
#define XBAR_ST ((volatile LAS unsigned*)(lds + PT_OFF + 320))
#define GSYNC() do { int t_ = tid_of(wave); asm volatile("" : "+v"(t_)); XcdBarrier xb_; xb_.bar = XBAR_WORDS; xb_.x = xb_xcc_id(); xb_.st = XBAR_ST; xcd_barrier(xb_, t_ == 0); } while (0)
#define XP ((float*)ldpk(22) + (size_t)g * TG * DM)
#define WBP ((bf16*)(WSP + WS_W))
#define HBP ((bf16*)(WSP + WS_HB))
#define PBP ((bf16*)(WSP + WS_PB))
#define OBP ((bf16*)(WSP + WS_OB))
#define BIGP (WSP + WS_BIG)
__global__ void __launch_bounds__(512) fwd_mega(Params P) {
    extern __shared__ __attribute__((aligned(16))) unsigned char lds_raw[];
    LAS unsigned char* lds = (LAS unsigned char*)lds_raw;
    cg::grid_group grid = cg::this_grid();
    const int wave = __builtin_amdgcn_readfirstlane(threadIdx.x >> 6);
    const int Gn = gridDim.x, bx = blockIdx.x, vcu = (Gn % 8 == 0) ? (bx % 8) * (Gn / 8) + bx / 8 : bx;
    { LAS unsigned long long* PT = (LAS unsigned long long*)(lds + PT_OFF);
      if (threadIdx.x < 22) PT[threadIdx.x] = (unsigned long long)P.in[threadIdx.x];
      if (threadIdx.x == 22) PT[22] = (unsigned long long)P.out;
      if (threadIdx.x == 23) PT[23] = (unsigned long long)P.ws; }
    if (threadIdx.x >= 32 && threadIdx.x < 40) ((LAS unsigned long long*)(lds + PT_OFF + 256))[threadIdx.x - 32] = 0ull;
    if (threadIdx.x == 40) { ((LAS unsigned*)(lds + PT_OFF + 320))[0] = 0u; ((LAS unsigned*)(lds + PT_OFF + 320))[1] = 0u; }
    __syncthreads();
    (void)xcd_barrier_post((unsigned*)(ldpk(23) + WS_CTL + 16384), (volatile LAS unsigned*)(lds + PT_OFF + 320), threadIdx.x == 0);
    unsigned nsync = 0;

    { unsigned char* ws = WSP; bf16* Wb = (bf16*)(ws + WS_W);
      float* rc = (float*)(ws + WS_TAB + TAB_RC); float* rs = (float*)(ws + WS_TAB + TAB_RS); float* xc = (float*)(ws + WS_TAB + TAB_XC); float* xs = (float*)(ws + WS_TAB + TAB_XS);
      int tid_t = tid_of(wave); asm volatile("" : "+v"(tid_t)); const int gt = (vcu * 512 + tid_t), NT_ = Gn * 512;
#ifndef NO_TAB
      for (int idx = gt; idx < 8192 * 32; idx += NT_) { const int s = idx >> 5, j = idx & 31; const float inv = 1.0f / powf(10000.0f, (float)(2 * j) / 64.0f); const float ang = (float)s * inv; float sn, cs; sincosf(ang, &sn, &cs); rc[idx] = cs; rs[idx] = sn; }
      for (int idx = gt; idx < 8192 * 128; idx += NT_) { const int s = idx >> 7, i = idx & 127; const float a = 1.0f / powf(10000.0f, (float)i / 127.0f); const float ang = (float)s * a; float sn, cs; sincosf(ang, &sn, &cs); xc[idx] = cs; xs[idx] = sn; }
#endif
      LAS float* scr = (LAS float*)(lds + wave * 16384);
#pragma unroll 1
      for (int mi = 0; mi < 32; ++mi) {
          const int kind = mi >> 2, li = mi & 3;
          int pin, K, N, permN = 0; size_t soff, doff;
          switch (kind) {
              case 0: if (li >= 2) continue; pin = 8; K = 1024; N = 3072; permN = 2048; soff = (size_t)li * 1024 * 3072; doff = W_QKV + (size_t)li * 3 * MEL; break;
              case 1: if (li >= 2) continue; pin = 9; K = 1024; N = 1024; soff = (size_t)li * MEL; doff = W_O + (size_t)li * MEL; break;
              case 2: if (li >= 2) continue; pin = 15; K = 1024; N = 6144; soff = (size_t)li * 1024 * 6144; doff = W_RIN + (size_t)li * 6 * MEL; break;
              case 3: if (li >= 2) continue; pin = 16; K = 2048; N = 1024; soff = (size_t)li * 2 * MEL; doff = W_ROUT + (size_t)li * 2 * MEL; break;
              case 4: pin = 18; K = 1024; N = 4096; soff = (size_t)li * 4 * MEL; doff = W_MIN + (size_t)li * 4 * MEL; break;
              case 5: pin = 19; K = 4096; N = 1024; soff = (size_t)li * 4 * MEL; doff = W_MOUT + (size_t)li * 4 * MEL; break;
              case 6: pin = 20; K = 256; N = 1024; soff = (size_t)li * 262144; doff = W_PROJ + (size_t)li * 262144; break;
              default: pin = 21; K = 1024; N = 1024; soff = (size_t)li * MEL; doff = W_GATE + (size_t)li * MEL; break;
          }
          conv_matrix(PIN(pin) + soff, K, N, Wb + doff, permN, scr, GW, NGW, wave);
      }
    }
    grid.sync();
#pragma unroll 1
    for (int step2 = 0; step2 < 2 * 4 * 13 * 2; ++step2) {
        const int step = step2 >> 1;
        if (step2 & 1) { const int ph_ = step % 13, i_ = (step % 52) / 13; if (!(((REP_MASK & 2) && (ph_ == 1 || ph_ == 5 || ph_ == 7 || ph_ == 8)) || ((REP_MASK & 1) && ph_ == 2 && !(i_ & 1)) || ((REP_MASK & 4) && ph_ == 2 && (i_ & 1)))) continue; }
        const int g = step / 52, i = (step % 52) / 13, ph = step % 13, j = i >> 1, ret = i & 1;
#ifdef TIMING
        const unsigned long long t0_ = __builtin_amdgcn_s_memrealtime();
#endif
        const int S = g ? 8192 : 2048, NB = g ? 4 : 16, smask = S - 1;
        switch (ph) {
        case 0: { if (i != 0) continue; rowpass<false, true, true, false>(PIN(g), XP, nullptr, nullptr, PIN(4), HBP, nullptr, nullptr, GW, NGW, wave); } break;
        case 1: {
            unsigned char* B_ = BIGP; unsigned char* ws = WSP;
            if (!ret) { EpiAttnQKV E{(bf16*)B_, (bf16*)(B_ + 64 * MiB), (bf16*)(B_ + 128 * MiB), (const float*)(ws + WS_TAB + TAB_RC), (const float*)(ws + WS_TAB + TAB_RS), smask};
                GEMM_CALL(EpiAttnQKV, HBP, WBP + W_QKV + (size_t)j * 3 * MEL, TG, 3072, 1024, E); }
            else { EpiRetQKV E{(bf16*)B_, (bf16*)(B_ + 64 * MiB), (bf16*)(B_ + 128 * MiB), (const float*)(ws + WS_TAB + TAB_XC), (const float*)(ws + WS_TAB + TAB_XS), smask};
                GEMM_CALL(EpiRetQKV, HBP, WBP + W_RIN + (size_t)j * 6 * MEL, TG, 4096, 1024, E); }
        } break;
        case 2: {
            unsigned char* B_ = BIGP;
            if (!ret) {
                GAS const float* lq1 = (GAS const float*)(PIN(10) + j * 64); GAS const float* lk1 = (GAS const float*)(PIN(11) + j * 64); GAS const float* lq2 = (GAS const float*)(PIN(12) + j * 64); GAS const float* lk2 = (GAS const float*)(PIN(13) + j * 64);
                float d1 = 0.f, d2 = 0.f;
                for (int k = 0; k < 64; ++k) { d1 += lq1[k] * lk1[k]; d2 += lq2[k] * lk2[k]; }
                const float lam_init = 0.8f - 0.6f * expf(-0.3f * (float)i); const float lam = expf(d1) - expf(d2) + lam_init;
#ifndef NO_ATTN
                attn_phase(lds, (const bf16*)B_, (const bf16*)(B_ + 64 * MiB), (const bf16*)(B_ + 128 * MiB), OBP, S, NB, vcu, Gn, lam, 1.0f - lam_init, PIN(14) + j * 128, (float*)(B_ + 256 * MiB) + (size_t)blockIdx.x * 32768, wave);
#endif
            } else {
#ifndef NO_SCAN
                scan_phase(lds, (const bf16*)B_, (const bf16*)(B_ + 64 * MiB), (const bf16*)(B_ + 128 * MiB), OBP, (bf16*)(B_ + 256 * MiB), S, NB, vcu, Gn, PIN(17) + j * 8, wave);
#endif
            }
        } break;
        case 3: { if (!ret) continue;
#ifndef NO_INTRA
            unsigned char* B_ = BIGP;
#if (REP_MASK & 8)
            intra_phase(lds, (const bf16*)B_, (const bf16*)(B_ + 64 * MiB), (const bf16*)(B_ + 128 * MiB), OBP, (const bf16*)(B_ + 256 * MiB), S, NB, vcu, Gn, PIN(17) + j * 8, wave, false);
#endif
            intra_phase(lds, (const bf16*)B_, (const bf16*)(B_ + 64 * MiB), (const bf16*)(B_ + 128 * MiB), OBP, (const bf16*)(B_ + 256 * MiB), S, NB, vcu, Gn, PIN(17) + j * 8, wave);
#endif
        } break;
        case 4: { if (!ret) continue; EpiSiluMul E{OBP, 2048}; GEMM_CALL(EpiSiluMul, HBP, WBP + W_RIN + (size_t)j * 6 * MEL + (size_t)4096 * 1024, TG, 2048, 1024, E); } break;
        case 5: case 8: {
            unsigned char* B_ = BIGP; const bf16* A_; const bf16* W_; int K_; bf16* O_;
            if (ph == 5) { A_ = OBP; K_ = ret ? 2048 : 1024; W_ = WBP + (ret ? W_ROUT + (size_t)j * 2 * MEL : W_O + (size_t)j * MEL); O_ = (bf16*)B_; }
            else { A_ = (const bf16*)B_; K_ = 4096; W_ = WBP + W_MOUT + (size_t)i * 4 * MEL; O_ = (bf16*)(B_ + 256 * MiB); }
            EpiBf16Plain E{O_, DM}; GEMM_CALL(EpiBf16Plain, A_, W_, TG, 1024, K_, E);
        } break;
        case 10: {
            EpiBf16NP E{(bf16*)BIGP, DM}; GEMM_CALL(EpiBf16NP, PBP, WBP + W_PROJ + (size_t)i * 262144, TG, 1024, 256, E);
#ifndef PROJ_SYNC
            continue;
#endif
        } break;
        case 6: { float* x = XP; rowpass<true, true, true, false>(x, x, (const bf16*)BIGP, PIN(5) + i * DM, PIN(6) + i * DM, HBP, nullptr, nullptr, GW, NGW, wave); } break;
        case 7: { EpiRelu2 E{(bf16*)BIGP, FFD}; GEMM_CALL(EpiRelu2, HBP, WBP + W_MIN + (size_t)i * 4 * MEL, TG, 4096, 1024, E); } break;
        case 9: { float* x = XP; rowpass<true, true, false, true>(x, x, (const bf16*)(BIGP + 256 * MiB), PIN(7) + i * DM, nullptr, HBP, PIN(2 + g) + (size_t)i * TG * 256, PBP, GW, NGW, wave); } break;
        case 11: { EpiGate E{XP, (const bf16*)BIGP}; GEMM_CALL(EpiGate, HBP, WBP + W_GATE + (size_t)i * MEL, TG, 1024, 1024, E); } break;
        default: { if (i == 3) continue; rowpass<false, false, true, false>(XP, nullptr, nullptr, nullptr, PIN(4) + (i + 1) * DM, HBP, nullptr, nullptr, GW, NGW, wave); } break;
        }
#ifdef TIMING
        const unsigned long long t1_ = __builtin_amdgcn_s_memrealtime();
#endif
        GSYNC();
#ifdef TIMING
        { const unsigned long long t2_ = __builtin_amdgcn_s_memrealtime(); LAS unsigned long long* TA = (LAS unsigned long long*)(lds + PT_OFF + 256);
          const int cat = (ph == 0 || ph == 6 || ph == 9 || ph == 12) ? 4 : (ph == 2 ? (ret ? 2 : 1) : (ph == 3 ? 3 : 0));
          if (tid_of(wave) == 0) { TA[cat] += t1_ - t0_; TA[5] += t2_ - t1_; TA[6] += t2_ - t0_; } }
#endif
#ifdef DBG
        if (g == DBG_G) {
            int lane = tid_of(wave) & 63, gwv = (int)blockIdx.x * 8 + wave; asm volatile("" : "+v"(lane), "+s"(gwv)); unsigned char* ws = WSP; unsigned char* B_ = ws + WS_BIG;
            const bf16* Qb = (const bf16*)B_; const bf16* Kb = (const bf16*)(B_ + 64 * MiB); const bf16* Vb = (const bf16*)(B_ + 128 * MiB);
            const int hi_ = i >> 1;
            bool did = true;
            if (!ret && ph == 1) dbg_attn_qkv(ws, hi_ ? 14 : 2, HBP, PIN(8) + (size_t)j * 1024 * 3072, Qb, Kb, Vb, S, gwv, lane);
            else if (!ret && ph == 2) { const float* lq1 = PIN(10) + j * 64; const float* lk1 = PIN(11) + j * 64; const float* lq2 = PIN(12) + j * 64; const float* lk2 = PIN(13) + j * 64; float d1 = 0.f, d2 = 0.f;
                for (int k = 0; k < 64; ++k) { d1 += lq1[k] * lk1[k]; d2 += lq2[k] * lk2[k]; }
                const float lam_init = 0.8f - 0.6f * expf(-0.3f * (float)i); dbg_attn(ws, hi_ ? 14 : 3, Qb, Kb, Vb, OBP, S, NB, expf(d1) - expf(d2) + lam_init, 1.0f - lam_init, PIN(14) + j * 128, gwv, lane); }
            else if (!ret && ph == 5) dbg_gemm(ws, hi_ ? 14 : 4, OBP, PIN(9) + (size_t)j * MEL, 1024, 1024, B_, 1024, 2, gwv, lane);
            else if (i == 0 && ph == 6) dbg_rp(ws, 5, PIN(g), XP, nullptr, PIN(5), PIN(6), HBP, gwv, lane);
            else if (i == 0 && ph == 7) dbg_gemm(ws, 6, HBP, PIN(18), 1024, 4096, B_, 4096, 1, gwv, lane);
            else if (i == 0 && ph == 8) dbg_gemm(ws, 7, (const bf16*)B_, PIN(19), 4096, 1024, B_ + 256 * MiB, 1024, 2, gwv, lane);
            else if (i == 0 && ph == 9) dbg_rp(ws, 8, nullptr, XP, nullptr, nullptr, nullptr, HBP, gwv, lane);
            else if (i == 0 && ph == 11) dbg_gemm(ws, 9, PBP, PIN(20), 256, 1024, B_, 1024, 2, gwv, lane);
            else if (ret && ph == 1) dbg_ret_qkv(ws, hi_ ? 14 : 10, HBP, PIN(15) + (size_t)j * 1024 * 6144, Qb, Kb, Vb, S, gwv, lane);
            else if (ret && ph == 3) dbg_ret(ws, hi_ ? 14 : 11, Qb, Kb, Vb, OBP, S, NB, PIN(17) + j * 8, gwv, lane);
            else if (ret && ph == 5) dbg_gemm(ws, hi_ ? 14 : 13, OBP, PIN(16) + (size_t)j * 2 * MEL, 2048, 1024, B_, 1024, 2, gwv, lane);
            else if (i == 3 && ph == 11) dbg_acc(ws, 15, 1.f, 1.f, lane);
            else did = false;
            if (did) GSYNC();
        }
#endif
    }
#ifdef TIMING
    { unsigned char* ws = WSP; float* tw = (float*)(ws + WS_CTL + 2048); LAS unsigned long long* TA = (LAS unsigned long long*)(lds + PT_OFF + 256);
      if (blockIdx.x == 0 && tid_of(wave) == 0) { tw[0] = (float)TA[TIMING_A] * 0.01f; tw[1] = (float)TA[TIMING_B] / (float)TA[6]; }
      GSYNC();
      const float C = __hip_atomic_load(tw, __ATOMIC_RELAXED, __HIP_MEMORY_SCOPE_AGENT), f = __hip_atomic_load(tw + 1, __ATOMIC_RELAXED, __HIP_MEMORY_SCOPE_AGENT);
      float* o = (float*)ldpk(22); const size_t nh = (size_t)TG * DM, nf = (size_t)(f * (float)nh);
      for (size_t idx = (size_t)blockIdx.x * 512 + tid_of(wave); idx < nf; idx += (size_t)Gn * 512) { o[idx] = C; o[nh + idx] = C; } }
#endif
#ifdef DBG
    { unsigned char* ws = WSP; const float* acc = (const float*)(ws + WS_CTL + 1024); int bad = -1;
      for (int id = 15; id >= 0; --id) { const float e = __hip_atomic_load(acc + 2 * id, __ATOMIC_RELAXED, __HIP_MEMORY_SCOPE_AGENT), r = __hip_atomic_load(acc + 2 * id + 1, __ATOMIC_RELAXED, __HIP_MEMORY_SCOPE_AGENT); if (r > 0.f && !(e <= DBG_TOL * r)) bad = id; }
      if (bad >= 0) { float C = 100.f; for (int k = 0; k < bad; ++k) C *= 4.f;
#ifdef DBG_RATIO
          C = 1000.f * fminf(fmaxf(__hip_atomic_load(acc + 2 * bad, __ATOMIC_RELAXED, __HIP_MEMORY_SCOPE_AGENT) / __hip_atomic_load(acc + 2 * bad + 1, __ATOMIC_RELAXED, __HIP_MEMORY_SCOPE_AGENT), 1e-3f), 1e3f);
#endif
 float* o = (float*)ldpk(22); const size_t n = (size_t)2 * TG * DM;
          for (size_t idx = (size_t)blockIdx.x * 512 + tid_of(wave); idx < n; idx += (size_t)Gn * 512) o[idx] = C; } }
#endif
}

extern "C" void kernel_launch(void* const* d_in, const int* in_sizes, int n_in, void* d_out, int out_size, void* d_ws, size_t ws_size, hipStream_t stream) {
    static int grid_blocks = 0;
    if (!grid_blocks) {
        int dev = 0, cus = 0, per_cu = 0;
        (void)hipGetDevice(&dev);
        (void)hipDeviceGetAttribute(&cus, hipDeviceAttributeMultiprocessorCount, dev);
        (void)hipFuncSetAttribute((const void*)fwd_mega, hipFuncAttributeMaxDynamicSharedMemorySize, LDS_BYTES);
        (void)hipOccupancyMaxActiveBlocksPerMultiprocessor(&per_cu, (const void*)fwd_mega, 512, LDS_BYTES);
        if (per_cu < 1) per_cu = 1;
        grid_blocks = cus * per_cu;
        if (ws_size < WS_END || n_in != 22) { fprintf(stderr, "kernel_launch: workspace %zu < %zu or n_in %d != 22\n", ws_size, (size_t)WS_END, n_in); }
    }
    (void)hipMemsetAsync((char*)d_ws + WS_CTL, 0, 65536, stream);
    Params p{};
    for (int i = 0; i < 22; ++i) p.in[i] = (const float*)d_in[i];
    p.out = (float*)d_out; p.ws = (unsigned char*)d_ws;
    void* args[] = {&p};
    hipError_t e = hipLaunchCooperativeKernel((void*)fwd_mega, dim3(grid_blocks), dim3(512), args, LDS_BYTES, stream);
    if (e != hipSuccess) fprintf(stderr, "cooperative launch failed: %s (grid %d)\n", hipGetErrorString(e), grid_blocks);
}
```

```cpp
#include <hip/hip_runtime.h>
#include <hip/hip_cooperative_groups.h>
#include <cstdio>
#include <cstdint>
namespace pg8 {
#define PG8_LAS __attribute__((address_space(3)))
typedef unsigned short bf16_t;
typedef short bf16x8 __attribute__((ext_vector_type(8)));
typedef float f32x4 __attribute__((ext_vector_type(4)));
typedef unsigned u32x4 __attribute__((ext_vector_type(4)));
constexpr int BM = 256, BK = 64, HALF = 128, HTB = HALF * BK * 2  , STAGE_BYTES = 8 * HTB, NXCD = 8, WGM = 8;

__host__ __device__ __forceinline__ int lds_byte(int r, int c) { const int st = (r >> 4) * 2 + (c >> 5), rr = r & 15, cc = c & 31, ob = rr * 64 + cc * 2; return st * 1024 + (ob ^ (((ob >> 9) & 1) << 5)); }
__host__ __device__ __forceinline__ void stage_rc(int b, int& R, int& C) { const int st = b / 1024, sb = b % 1024, swz = sb ^ (((sb >> 9) & 1) << 5); R = (st >> 1) * 16 + swz / 64; C = (st & 1) * 32 + (swz % 64) / 2; }
__host__ __device__ __forceinline__ int perm32(int rho) { const int n = rho >> 4, i = rho & 15; return 8 * (i >> 2) + 4 * n + (i & 3); }

struct Unit { int pm, pn; };
struct Gemm { const bf16_t* A; const bf16_t* Bt; int M, N, K; };

struct StaticOrder {
    int nM, nN, nwg, G, c;
    __host__ __device__ void init(int M, int N, int G_, int c_) { nM = M / BM; nN = N / BM; nwg = nM * nN; G = G_; c = c_; }
    __host__ __device__ bool next(int i, Unit& u) const {
        const long L = (long)i * G + c; if (L >= nwg) return false;
        int wgid = (int)L; { const int q = nwg / NXCD, r = nwg % NXCD, xcd = wgid % NXCD, off = wgid / NXCD; wgid = (xcd < r ? xcd * (q + 1) : r * (q + 1) + (xcd - r) * q) + off; }
        const int nig = WGM * nN, gid = wgid / nig, fm = gid * WGM, gsz = (nM - fm) < WGM ? (nM - fm) : WGM;
        u.pm = fm + ((wgid % nig) % gsz); u.pn = (wgid % nig) / gsz; return true;
    }
    __device__ __forceinline__ void a_ready(const Unit&) const {}
    __device__ __forceinline__ void done(const Unit&) const {}
};

__device__ __forceinline__ unsigned cvt_pk_bf16(float lo, float hi) { unsigned r; asm volatile("v_cvt_pk_bf16_f32 %0, %1, %2" : "=v"(r) : "v"(lo), "v"(hi)); return r; }
typedef float f32x2 __attribute__((ext_vector_type(2)));
template <class Epi, class Sched, bool ALIGN_EPI = false, bool SP2 = false>
__device__ __forceinline__ void gemm_phase(PG8_LAS unsigned char* lds, const Gemm g, const Sched& S, const Epi& E, const int wave_id) {
    int tid_l; asm volatile("v_mbcnt_lo_u32_b32 %0, -1, 0\n\tv_mbcnt_hi_u32_b32 %0, -1, %0" : "=v"(tid_l)); tid_l += wave_id * 64; asm volatile("" : "+v"(tid_l));
    const int tid = tid_l, wid = __builtin_amdgcn_readfirstlane(tid >> 6), lane = tid & 63, wr = wid >> 2, wc = wid & 3, fr = lane & 15, fq = lane >> 4;
    const int K = g.K, nt = K / BK;
    unsigned voffA[2], voffB[2];
#pragma unroll
    for (int i = 0; i < 2; ++i) { int R, C; stage_rc(tid * 16 + i * 8192, R, C); const int Rb = Epi::PERM ? ((R & ~31) + perm32(R & 31)) : R;
        voffA[i] = (unsigned)(R * K + C) * 2u; voffB[i] = (unsigned)(Rb * K + C) * 2u; }
    const size_t kstep = (size_t)(BK * 2);
    const size_t hstep = (size_t)HALF * K * 2;
    const size_t tstep = 2 * hstep;
    const unsigned ldsw = (unsigned)wid * 1024u;
    const int aoff = lds_byte(wr * 64 + fr, fq * 8), boff = lds_byte(wc * 32 + fr, fq * 8);
#define PG8_SA(b, h) (((b) * 2 + (h)) * HTB)
#define PG8_SB(b, h) ((4 + (b) * 2 + (h)) * HTB)
#define PG8_STAGE(bufoff, gbase, voff) do { _Pragma("unroll") for (int _i = 0; _i < 2; ++_i) \
        __builtin_amdgcn_global_load_lds((const unsigned*)((const char*)(gbase) + (voff)[_i]), (PG8_LAS unsigned*)(lds + (bufoff) + ldsw + _i * 8192), 16, 0, 0); } while (0)
#define PG8_LDA(dst, b, h) do { _Pragma("unroll") for (int m = 0; m < 4; ++m) _Pragma("unroll") for (int k = 0; k < 2; ++k) dst[m][k] = *(const PG8_LAS bf16x8*)(lds + PG8_SA(b, h) + aoff + m * 2048 + k * 1024); } while (0)
#define PG8_LDB(dst, b, h) do { _Pragma("unroll") for (int n = 0; n < 2; ++n) _Pragma("unroll") for (int k = 0; k < 2; ++k) dst[n][k] = *(const PG8_LAS bf16x8*)(lds + PG8_SB(b, h) + boff + n * 2048 + k * 1024); } while (0)
#define PG8_MMA(ai, bj, At, Bt) do { __builtin_amdgcn_s_setprio(1); _Pragma("unroll") for (int m = 0; m < 4; ++m) _Pragma("unroll") for (int n = 0; n < 2; ++n) _Pragma("unroll") for (int k = 0; k < 2; ++k) \
        acc[ai][bj][m][n] = __builtin_amdgcn_mfma_f32_16x16x32_bf16(Bt[n][k], At[m][k], acc[ai][bj][m][n], 0, 0, 0); __builtin_amdgcn_s_setprio(0); } while (0)
#define PG8_WAIT_V(n) asm volatile("s_waitcnt vmcnt(" #n ")" ::: "memory")
#define PG8_WAIT_L(n) asm volatile("s_waitcnt lgkmcnt(" #n ")" ::: "memory")
#define PG8_BAR __builtin_amdgcn_s_barrier()
#define PG8_SCHED __builtin_amdgcn_sched_barrier(0)
    Unit cur, nxt; int ui = 0;
    if (!S.next(0, cur)) return;
    f32x4 acc[2][2][4][2];
#pragma unroll
    for (int a = 0; a < 2; ++a)
#pragma unroll
        for (int b = 0; b < 2; ++b)
#pragma unroll
            for (int m = 0; m < 4; ++m)
#pragma unroll
                for (int n = 0; n < 2; ++n) acc[a][b][m][n] = (f32x4){0.f, 0.f, 0.f, 0.f};
    bf16x8 At[4][2], B0[2][2], B1[2][2];
    const char* cA = (const char*)g.A + (size_t)cur.pm * tstep; const char* cB = (const char*)g.Bt + (size_t)cur.pn * tstep;
    S.a_ready(cur);
    if constexpr (SP2) {
        PG8_STAGE(PG8_SB(0, 0), cB, voffB); PG8_STAGE(PG8_SB(0, 1), cB + hstep, voffB); PG8_STAGE(PG8_SA(0, 0), cA, voffA); PG8_STAGE(PG8_SA(0, 1), cA + hstep, voffA);
        if (wr == 1) PG8_BAR;
        PG8_WAIT_V(2); PG8_BAR;
        PG8_STAGE(PG8_SB(1, 0), cB + kstep, voffB); PG8_STAGE(PG8_SA(1, 0), cA + kstep, voffA); PG8_STAGE(PG8_SB(1, 1), cB + hstep + kstep, voffB);
        PG8_WAIT_V(6); PG8_BAR;
    } else {
        PG8_STAGE(PG8_SB(0, 0), cB, voffB); PG8_STAGE(PG8_SA(0, 0), cA, voffA); PG8_STAGE(PG8_SB(0, 1), cB + hstep, voffB); PG8_STAGE(PG8_SA(0, 1), cA + hstep, voffA);
        if (wr == 1) PG8_BAR;
        PG8_WAIT_V(4); PG8_BAR;
        PG8_STAGE(PG8_SB(1, 0), cB + kstep, voffB); PG8_STAGE(PG8_SA(1, 0), cA + kstep, voffA); PG8_STAGE(PG8_SB(1, 1), cB + hstep + kstep, voffB);
        PG8_WAIT_V(6); PG8_BAR;
    }
    for (;;) {
        const bool has_next = S.next(ui + 1, nxt);
        const char* nA = has_next ? (const char*)g.A + (size_t)nxt.pm * tstep : cA; const char* nB = has_next ? (const char*)g.Bt + (size_t)nxt.pn * tstep : cB;
        for (int t = 0; t < nt; t += 2) {
            const bool last = (t == nt - 2);
            const char* a1 = cA + (size_t)(t + 1) * kstep;
            const char* a2 = last ? nA : cA + (size_t)(t + 2) * kstep; const char* b2 = last ? nB : cB + (size_t)(t + 2) * kstep;
            const char* a3 = a2 + kstep; const char* b3 = b2 + kstep;
            if (last && has_next) S.a_ready(nxt);
            if constexpr (SP2) {
            PG8_LDB(B0, 0, 0); PG8_LDB(B1, 0, 1); PG8_SCHED; PG8_LDA(At, 0, 0); PG8_STAGE(PG8_SA(1, 1), a1 + hstep, voffA);
            PG8_WAIT_V(8); PG8_WAIT_L(0); PG8_BAR; PG8_MMA(0, 0, At, B0); PG8_MMA(0, 1, At, B1); PG8_BAR; PG8_SCHED;
            PG8_LDA(At, 0, 1); PG8_STAGE(PG8_SB(0, 0), b2, voffB); PG8_STAGE(PG8_SB(0, 1), b2 + hstep, voffB); PG8_STAGE(PG8_SA(0, 0), a2, voffA);
            PG8_WAIT_V(8); PG8_WAIT_L(0); PG8_BAR; PG8_MMA(1, 0, At, B0); PG8_MMA(1, 1, At, B1); PG8_BAR; PG8_SCHED;
            PG8_LDB(B0, 1, 0); PG8_LDB(B1, 1, 1); PG8_SCHED; PG8_LDA(At, 1, 0); PG8_STAGE(PG8_SA(0, 1), a2 + hstep, voffA);
            PG8_WAIT_V(8); PG8_WAIT_L(0); PG8_BAR; PG8_MMA(0, 0, At, B0); PG8_MMA(0, 1, At, B1); PG8_BAR; PG8_SCHED;
            PG8_LDA(At, 1, 1); PG8_STAGE(PG8_SB(1, 0), b3, voffB); PG8_STAGE(PG8_SB(1, 1), b3 + hstep, voffB); PG8_STAGE(PG8_SA(1, 0), a3, voffA);
            PG8_WAIT_V(8); PG8_WAIT_L(0); PG8_BAR; PG8_MMA(1, 0, At, B0); PG8_MMA(1, 1, At, B1); PG8_BAR; PG8_SCHED;
            } else {
            PG8_LDB(B0, 0, 0); PG8_SCHED; PG8_LDA(At, 0, 0); PG8_STAGE(PG8_SA(1, 1), a1 + hstep, voffA);
            PG8_WAIT_L(8); PG8_BAR; PG8_WAIT_L(0); PG8_MMA(0, 0, At, B0); PG8_BAR; PG8_SCHED;
            PG8_LDB(B1, 0, 1); PG8_STAGE(PG8_SB(0, 0), b2, voffB);
            PG8_BAR; PG8_WAIT_L(0); PG8_MMA(0, 1, At, B1); PG8_BAR;
            PG8_LDA(At, 0, 1); PG8_STAGE(PG8_SA(0, 0), a2, voffA);
            PG8_BAR; PG8_WAIT_L(0); PG8_MMA(1, 0, At, B0); PG8_BAR; PG8_SCHED;
            PG8_STAGE(PG8_SB(0, 1), b2 + hstep, voffB);
            PG8_WAIT_V(6); PG8_BAR; PG8_MMA(1, 1, At, B1); PG8_BAR;
            PG8_LDB(B0, 1, 0); PG8_SCHED; PG8_LDA(At, 1, 0); PG8_STAGE(PG8_SA(0, 1), a2 + hstep, voffA);
            PG8_WAIT_L(8); PG8_BAR; PG8_WAIT_L(0); PG8_MMA(0, 0, At, B0); PG8_BAR; PG8_SCHED;
            PG8_LDB(B1, 1, 1); PG8_STAGE(PG8_SB(1, 0), b3, voffB);
            PG8_BAR; PG8_WAIT_L(0); PG8_MMA(0, 1, At, B1); PG8_BAR;
            PG8_LDA(At, 1, 1); PG8_STAGE(PG8_SA(1, 0), a3, voffA);
            PG8_BAR; PG8_WAIT_L(0); PG8_MMA(1, 0, At, B0); PG8_BAR; PG8_SCHED;
            PG8_STAGE(PG8_SB(1, 1), b3 + hstep, voffB);
            PG8_WAIT_V(6); PG8_BAR; PG8_MMA(1, 1, At, B1); PG8_BAR;
            }
        }
        if constexpr (ALIGN_EPI) { if (wr == 0) PG8_BAR; }
        if constexpr (!Epi::AFTER_DRAIN) { E(acc, cur, wr, wc, fr, fq); S.done(cur); }
        if (!has_next) break;
#pragma unroll
        for (int a = 0; a < 2; ++a)
#pragma unroll
            for (int b = 0; b < 2; ++b)
#pragma unroll
                for (int m = 0; m < 4; ++m)
#pragma unroll
                    for (int n = 0; n < 2; ++n) acc[a][b][m][n] = (f32x4){0.f, 0.f, 0.f, 0.f};
        cur = nxt; cA = nA; cB = nB; ++ui;
        if constexpr (ALIGN_EPI) { if (wr == 1) PG8_BAR; }
    }
    PG8_WAIT_V(0);
    if constexpr (!ALIGN_EPI) { if (wr == 0) PG8_BAR; }
    PG8_BAR;
    if constexpr (Epi::AFTER_DRAIN) { E.fused(acc, cur, wr, wc, fr, fq, lds, wid, lane); S.done(cur); }
#undef PG8_SA
#undef PG8_SB
#undef PG8_STAGE
#undef PG8_LDA
#undef PG8_LDB
#undef PG8_MMA
#undef PG8_WAIT_V
#undef PG8_WAIT_L
#undef PG8_BAR
#undef PG8_SCHED
}
}

namespace cg = cooperative_groups;
#define LAS __attribute__((address_space(3)))
#define GAS __attribute__((address_space(1)))
typedef unsigned short bf16;
typedef short bf16x8 __attribute__((ext_vector_type(8)));
typedef short s16x4 __attribute__((ext_vector_type(4)));
typedef float f32x2 __attribute__((ext_vector_type(2)));
typedef float f32x4 __attribute__((ext_vector_type(4)));
typedef float f32x16 __attribute__((ext_vector_type(16)));
typedef unsigned u32x2 __attribute__((ext_vector_type(2)));
typedef unsigned u32x4 __attribute__((ext_vector_type(4)));

constexpr int DM = 1024, TG = 32768, FFD = 4096;
constexpr size_t MiB = (size_t)1 << 20;
constexpr size_t WS_CTL = 0, WS_TAB = 1 * MiB, WS_W = 12 * MiB, WS_HB = 136 * MiB, WS_PB = 200 * MiB, WS_OB = 216 * MiB, WS_BIG = 344 * MiB, WS_END = 728 * MiB;
constexpr size_t TAB_RC = 0, TAB_RS = 1 * MiB, TAB_XC = 2 * MiB, TAB_XS = 6 * MiB;
constexpr size_t MEL = 1048576;
constexpr size_t W_QKV = 0, W_O = 6 * MEL, W_RIN = 8 * MEL, W_ROUT = 20 * MEL, W_MIN = 24 * MEL, W_MOUT = 40 * MEL, W_PROJ = 56 * MEL, W_GATE = 57 * MEL;
constexpr float LOG2E = 1.4426950408889634f;
constexpr int LDS_BYTES = 147456;

struct Params { const float* in[22]; float* out; unsigned char* ws; };

__device__ __forceinline__ unsigned cvtpk(float lo, float hi) { typedef __bf16 b2 __attribute__((ext_vector_type(2))); f32x2 v = {lo, hi}; b2 b = __builtin_convertvector(v, b2); return __builtin_bit_cast(unsigned, b); }
__device__ __forceinline__ float bf2f(unsigned short b) { return __uint_as_float(((unsigned)b) << 16); }
__device__ __forceinline__ unsigned short f2bf(float f) { return (unsigned short)(cvtpk(f, 0.f) & 0xffffu); }
__device__ __forceinline__ float shx(float v, int o, int lane) { return __int_as_float(__builtin_amdgcn_ds_bpermute((lane ^ o) << 2, __float_as_int(v))); }
__device__ __forceinline__ float wave_sum(float v, int lane) {
#pragma unroll
    for (int o = 1; o < 64; o <<= 1) v += shx(v, o, lane);
    return v;
}
__device__ __forceinline__ int crow(int r, int hh) { return (r & 3) + 8 * (r >> 2) + 4 * hh; }
__device__ __forceinline__ s16x4 trr(LAS unsigned char* p) { return __builtin_bit_cast(s16x4, __builtin_amdgcn_ds_read_tr16_b64_v4i16((LAS s16x4*)p)); }
__device__ __forceinline__ bf16x8 cat8(s16x4 lo, s16x4 hi) { return (bf16x8){lo[0], lo[1], lo[2], lo[3], hi[0], hi[1], hi[2], hi[3]}; }
__device__ __forceinline__ bf16x8 pack8(const f32x16& v, int b) { u32x4 w; w.x = cvtpk(v[b], v[b + 1]); w.y = cvtpk(v[b + 2], v[b + 3]); w.z = cvtpk(v[b + 4], v[b + 5]); w.w = cvtpk(v[b + 6], v[b + 7]); return __builtin_bit_cast(bf16x8, w); }
#define LBAR() do { asm volatile("s_waitcnt lgkmcnt(0)" ::: "memory"); __builtin_amdgcn_s_barrier(); asm volatile("" ::: "memory"); } while (0)
#ifndef ATT_THR
#define ATT_THR 6.0f
#endif
#ifndef PPSEL
#define PPSEL(w) ((w) >= 4)
#endif
__device__ __forceinline__ void glds16(const void* gsrc, unsigned lds_dst) { unsigned keep;
    asm volatile("s_mov_b32 %0, m0\n\ts_mov_b32 m0, %2\n\ts_nop 0\n\tglobal_load_lds_dwordx4 %1, off\n\ts_mov_b32 m0, %0" : "=&s"(keep) : "v"(gsrc), "s"(lds_dst) : "memory"); }
#define MFMA32(a, b, c) __builtin_amdgcn_mfma_f32_32x32x16_bf16((a), (b), (c), 0, 0, 0)
__device__ __forceinline__ int tid_of(int wave) { int l; asm volatile("v_mbcnt_lo_u32_b32 %0, -1, 0\n\tv_mbcnt_hi_u32_b32 %0, -1, %0" : "=v"(l)); return wave * 64 + l; }
__device__ __forceinline__ float max3f(float a, float b, float c) { float r; asm("v_max3_f32 %0, %1, %2, %3" : "=v"(r) : "v"(a), "v"(b), "v"(c)); return r; }
__device__ __forceinline__ float ex2(float x) { return __builtin_amdgcn_exp2f(x); }

__device__ __forceinline__ int qk_perm(int n) { const int d = n & 63; return (n & ~63) | (((d >> 4) & 1) << 5) | ((d >> 5) << 4) | (d & 15); }
__device__ __forceinline__ void conv_item(const float* W, int K, int N, bf16* WT, int permN, LAS float* scr, int item, int lane) {
    const int nblk = N / 32, kb = item / nblk, nb = item % nblk, k0 = 64 * kb, n0 = 32 * nb;
#pragma unroll 8
    for (int i = 0; i < 32; ++i) { const int kk = 2 * i + (lane >> 5); scr[kk * 33 + (lane & 31)] = ((GAS const float*)W)[(size_t)(k0 + kk) * N + n0 + (lane & 31)]; }
    asm volatile("s_waitcnt lgkmcnt(0)" ::: "memory");
    const int c = lane & 7;
#pragma unroll
    for (int j = 0; j < 4; ++j) { const int n = (lane >> 3) + 8 * j; const LAS float* s = scr + (8 * c) * 33 + n;
        u32x4 o; o.x = cvtpk(s[0 * 33], s[1 * 33]); o.y = cvtpk(s[2 * 33], s[3 * 33]); o.z = cvtpk(s[4 * 33], s[5 * 33]); o.w = cvtpk(s[6 * 33], s[7 * 33]);
        const int nn = n0 + n, dst = nn < permN ? qk_perm(nn) : nn;
        *(GAS u32x4*)(WT + (size_t)dst * K + k0 + 8 * c) = o; }
    asm volatile("s_waitcnt lgkmcnt(0)" ::: "memory");
}
__device__ __forceinline__ void conv_matrix(const float* W, int K, int N, bf16* WT, int permN, LAS float* scr, int gw, int NGW, const int wave) {
    int lane = tid_of(wave) & 63; asm volatile("" : "+v"(lane));
    const int items = (K / 64) * (N / 32);
    for (int it = gw; it < items; it += NGW) conv_item(W, K, N, WT, permN, scr, it, lane);
}

template <bool HAS_M, bool STORE_X, bool HAS_WPRE, bool HAS_P>
__device__ __forceinline__ void rowpass(const float* xsrc, float* xdst, const bf16* m, const float* wpost, const float* wpre, bf16* hb, const float* psrc, bf16* pb, int gw, int NGW, const int wave) {
    int lane = tid_of(wave) & 63; asm volatile("" : "+v"(lane));
    constexpr int RB = 4;
    for (int row0 = gw; row0 < TG; row0 += RB * NGW) {
        f32x4 v[RB][4]; u32x2 mw[RB][4]; f32x4 pv[RB];
#pragma unroll
        for (int q = 0; q < RB; ++q) { const int row = min(row0 + q * NGW, TG - 1);
            GAS const f32x4* xr = (GAS const f32x4*)(xsrc + (size_t)row * DM) + lane;
#pragma unroll
            for (int j = 0; j < 4; ++j) v[q][j] = xr[64 * j];
            if constexpr (HAS_M) { GAS const u32x2* mr = (GAS const u32x2*)(m + (size_t)row * DM) + lane;
#pragma unroll
                for (int j = 0; j < 4; ++j) mw[q][j] = mr[64 * j]; }
            if constexpr (HAS_P) pv[q] = ((GAS const f32x4*)(psrc + (size_t)row * 256))[lane]; }
        f32x4 wp[4], wq[4];
#pragma unroll
        for (int j = 0; j < 4; ++j) { if constexpr (HAS_M) wp[j] = ((GAS const f32x4*)wpost)[lane + 64 * j]; if constexpr (HAS_WPRE) wq[j] = ((GAS const f32x4*)wpre)[lane + 64 * j]; }
#pragma unroll
        for (int q = 0; q < RB; ++q) { const int row = row0 + q * NGW; if (row >= TG) break;
            if constexpr (HAS_M) {
                f32x4 mm[4]; float ss = 0.f;
#pragma unroll
                for (int j = 0; j < 4; ++j) { const u32x2 w_ = mw[q][j]; mm[j].x = __uint_as_float(w_.x << 16); mm[j].y = __uint_as_float(w_.x & 0xffff0000u); mm[j].z = __uint_as_float(w_.y << 16); mm[j].w = __uint_as_float(w_.y & 0xffff0000u);
                    ss += mm[j].x * mm[j].x + mm[j].y * mm[j].y + mm[j].z * mm[j].z + mm[j].w * mm[j].w; }
                const float r = rsqrtf(wave_sum(ss, lane) * (1.f / DM) + 1e-6f);
#pragma unroll
                for (int j = 0; j < 4; ++j) v[q][j] += mm[j] * r * wp[j];
            }
            if constexpr (STORE_X) { GAS f32x4* xo = (GAS f32x4*)(xdst + (size_t)row * DM) + lane;
#pragma unroll
                for (int j = 0; j < 4; ++j) xo[64 * j] = v[q][j]; }
            {
                float ss = 0.f;
#pragma unroll
                for (int j = 0; j < 4; ++j) ss += v[q][j].x * v[q][j].x + v[q][j].y * v[q][j].y + v[q][j].z * v[q][j].z + v[q][j].w * v[q][j].w;
                const float r = rsqrtf(wave_sum(ss, lane) * (1.f / DM) + 1e-6f);
                GAS u32x2* ho = (GAS u32x2*)(hb + (size_t)row * DM) + lane;
#pragma unroll
                for (int j = 0; j < 4; ++j) { f32x4 o = v[q][j] * r; if constexpr (HAS_WPRE) o *= wq[j]; u32x2 w; w.x = cvtpk(o.x, o.y); w.y = cvtpk(o.z, o.w); ho[64 * j] = w; }
            }
            if constexpr (HAS_P) { u32x2 w; w.x = cvtpk(pv[q].x, pv[q].y); w.y = cvtpk(pv[q].z, pv[q].w); ((GAS u32x2*)(pb + (size_t)row * 256))[lane] = w; }
        }
    }
}

#define EPI_LOOP_AIM for (int ai = 0; ai < 2; ++ai) for (int m = 0; m < 4; ++m)
struct EpiF32 {
    static constexpr bool PERM = false, AFTER_DRAIN = false; float* O; int ldc;
    __device__ __forceinline__ void operator()(const pg8::f32x4 (&acc)[2][2][4][2], const pg8::Unit& u, int wr, int wc, int fr, int fq) const {
        const int row0 = u.pm * 256 + wr * 64 + fr, col0 = u.pn * 256 + wc * 32 + 4 * fq;
#pragma unroll
        for (int ai = 0; ai < 2; ++ai)
#pragma unroll
            for (int m = 0; m < 4; ++m) { GAS float* rp = (GAS float*)(O + (size_t)(row0 + ai * 128 + m * 16) * ldc + col0);
#pragma unroll
                for (int bj = 0; bj < 2; ++bj)
#pragma unroll
                    for (int n = 0; n < 2; ++n) *(GAS f32x4*)(rp + bj * 128 + n * 16) = acc[ai][bj][m][n]; }
    }
};
struct EpiBf16Plain {
    static constexpr bool PERM = true, AFTER_DRAIN = false; bf16* O; int ldc;
    __device__ __forceinline__ void operator()(const pg8::f32x4 (&acc)[2][2][4][2], const pg8::Unit& u, int wr, int wc, int fr, int fq) const {
        const int row0 = u.pm * 256 + wr * 64 + fr, col0 = u.pn * 256 + wc * 32 + 8 * fq;
#pragma unroll
        for (int ai = 0; ai < 2; ++ai)
#pragma unroll
            for (int m = 0; m < 4; ++m) { GAS bf16* rp = (GAS bf16*)(O + (size_t)(row0 + ai * 128 + m * 16) * ldc + col0);
#pragma unroll
                for (int bj = 0; bj < 2; ++bj) { f32x4 v0 = acc[ai][bj][m][0], v1 = acc[ai][bj][m][1];
                    u32x4 w; w.x = cvtpk(v0.x, v0.y); w.y = cvtpk(v0.z, v0.w); w.z = cvtpk(v1.x, v1.y); w.w = cvtpk(v1.z, v1.w); *(GAS u32x4*)(rp + bj * 128) = w; } }
    }
};
struct EpiRelu2 {
    static constexpr bool PERM = true, AFTER_DRAIN = false; bf16* O; int ldc;
    __device__ __forceinline__ void operator()(const pg8::f32x4 (&acc)[2][2][4][2], const pg8::Unit& u, int wr, int wc, int fr, int fq) const {
        const int row0 = u.pm * 256 + wr * 64 + fr, col0 = u.pn * 256 + wc * 32 + 8 * fq;
#pragma unroll
        for (int ai = 0; ai < 2; ++ai)
#pragma unroll
            for (int m = 0; m < 4; ++m) { GAS bf16* rp = (GAS bf16*)(O + (size_t)(row0 + ai * 128 + m * 16) * ldc + col0);
#pragma unroll
                for (int bj = 0; bj < 2; ++bj) { f32x4 v0 = acc[ai][bj][m][0], v1 = acc[ai][bj][m][1];
                    v0.x = fmaxf(v0.x, 0.f); v0.y = fmaxf(v0.y, 0.f); v0.z = fmaxf(v0.z, 0.f); v0.w = fmaxf(v0.w, 0.f); v1.x = fmaxf(v1.x, 0.f); v1.y = fmaxf(v1.y, 0.f); v1.z = fmaxf(v1.z, 0.f); v1.w = fmaxf(v1.w, 0.f); v0 = v0 * v0; v1 = v1 * v1;
                    u32x4 w; w.x = cvtpk(v0.x, v0.y); w.y = cvtpk(v0.z, v0.w); w.z = cvtpk(v1.x, v1.y); w.w = cvtpk(v1.z, v1.w); *(GAS u32x4*)(rp + bj * 128) = w; } }
    }
};
struct EpiBf16NP {
    static constexpr bool PERM = false, AFTER_DRAIN = false; bf16* O; int ldc;
    __device__ __forceinline__ void operator()(const pg8::f32x4 (&acc)[2][2][4][2], const pg8::Unit& u, int wr, int wc, int fr, int fq) const {
        const int row0 = u.pm * 256 + wr * 64 + fr, col0 = u.pn * 256 + wc * 32 + 4 * fq;
#pragma unroll
        for (int ai = 0; ai < 2; ++ai)
#pragma unroll
            for (int m = 0; m < 4; ++m) { GAS bf16* rp = (GAS bf16*)(O + (size_t)(row0 + ai * 128 + m * 16) * ldc + col0);
#pragma unroll
                for (int bj = 0; bj < 2; ++bj)
#pragma unroll
                    for (int n = 0; n < 2; ++n) { const f32x4 v = acc[ai][bj][m][n]; u32x2 w; w.x = cvtpk(v.x, v.y); w.y = cvtpk(v.z, v.w); *(GAS u32x2*)(rp + bj * 128 + n * 16) = w; } }
    }
};
struct EpiGate {
    static constexpr bool PERM = false, AFTER_DRAIN = false; float* X; const bf16* PR;
    __device__ __forceinline__ void operator()(const pg8::f32x4 (&acc)[2][2][4][2], const pg8::Unit& u, int wr, int wc, int fr, int fq) const {
        const int row0 = u.pm * 256 + wr * 64 + fr, col0 = u.pn * 256 + wc * 32 + 4 * fq;
#pragma unroll
        for (int ai = 0; ai < 2; ++ai)
#pragma unroll
            for (int m = 0; m < 4; ++m) { const size_t off = (size_t)(row0 + ai * 128 + m * 16) * DM + col0;
#pragma unroll
                for (int bj = 0; bj < 2; ++bj)
#pragma unroll
                    for (int n = 0; n < 2; ++n) { const f32x4 a = acc[ai][bj][m][n]; const u32x2 prw = *(GAS const u32x2*)(PR + off + bj * 128 + n * 16); f32x4 pr; pr.x = __uint_as_float(prw.x << 16); pr.y = __uint_as_float(prw.x & 0xffff0000u); pr.z = __uint_as_float(prw.y << 16); pr.w = __uint_as_float(prw.y & 0xffff0000u); f32x4 xv = *(GAS const f32x4*)(X + off + bj * 128 + n * 16);
                        xv.x += pr.x / (1.f + __expf(-a.x)); xv.y += pr.y / (1.f + __expf(-a.y)); xv.z += pr.z / (1.f + __expf(-a.z)); xv.w += pr.w / (1.f + __expf(-a.w));
                        *(GAS f32x4*)(X + off + bj * 128 + n * 16) = xv; } }
    }
};
struct EpiSiluMul {
    static constexpr bool PERM = false, AFTER_DRAIN = false; bf16* O; int ldc;
    __device__ __forceinline__ void operator()(const pg8::f32x4 (&acc)[2][2][4][2], const pg8::Unit& u, int wr, int wc, int fr, int fq) const {
        const int row0 = u.pm * 256 + wr * 64 + fr, col0 = u.pn * 256 + wc * 32 + 4 * fq;
#pragma unroll
        for (int ai = 0; ai < 2; ++ai)
#pragma unroll
            for (int m = 0; m < 4; ++m) { GAS bf16* rp = (GAS bf16*)(O + (size_t)(row0 + ai * 128 + m * 16) * ldc + col0);
#pragma unroll
                for (int bj = 0; bj < 2; ++bj)
#pragma unroll
                    for (int n = 0; n < 2; ++n) { const f32x4 a = acc[ai][bj][m][n]; u32x2 w = *(GAS const u32x2*)(rp + bj * 128 + n * 16);
                        const float o0 = __uint_as_float(w.x << 16) * a.x / (1.f + __expf(-a.x)), o1 = __uint_as_float(w.x & 0xffff0000u) * a.y / (1.f + __expf(-a.y));
                        const float o2 = __uint_as_float(w.y << 16) * a.z / (1.f + __expf(-a.z)), o3 = __uint_as_float(w.y & 0xffff0000u) * a.w / (1.f + __expf(-a.w));
                        w.x = cvtpk(o0, o1); w.y = cvtpk(o2, o3); *(GAS u32x2*)(rp + bj * 128 + n * 16) = w; } }
    }
};
struct EpiAttnQKV {
    static constexpr bool PERM = false, AFTER_DRAIN = false; bf16 *Q, *K, *V; const float *rc, *rs; int smask;
    __device__ __forceinline__ void operator()(const pg8::f32x4 (&acc)[2][2][4][2], const pg8::Unit& u, int wr, int wc, int fr, int fq) const {
        const int row0 = u.pm * 256 + wr * 64 + fr, region = u.pn >> 2, colt = (u.pn & 3) * 256;
        if (region == 2) {
            const int col0 = colt + wc * 32 + 4 * fq;
#pragma unroll
            for (int ai = 0; ai < 2; ++ai)
#pragma unroll
                for (int m = 0; m < 4; ++m) { GAS bf16* rp = (GAS bf16*)(V + (size_t)(row0 + ai * 128 + m * 16) * DM + col0);
#pragma unroll
                    for (int bj = 0; bj < 2; ++bj)
#pragma unroll
                        for (int n = 0; n < 2; ++n) { const f32x4 v = acc[ai][bj][m][n]; u32x2 w; w.x = cvtpk(v.x, v.y); w.y = cvtpk(v.z, v.w); *(GAS u32x2*)(rp + bj * 128 + n * 16) = w; } }
        } else {
            bf16* dst = region == 0 ? Q : K; const float sc = region == 0 ? 0.125f * LOG2E : 1.f; const int g = wc & 1, d1 = 16 * g + 4 * fq;
#pragma unroll
            for (int ai = 0; ai < 2; ++ai)
#pragma unroll
                for (int m = 0; m < 4; ++m) { const int row = row0 + ai * 128 + m * 16, s = row & smask;
                    const f32x4 c4 = *(GAS const f32x4*)(rc + s * 32 + d1) * sc, s4 = *(GAS const f32x4*)(rs + s * 32 + d1) * sc;
#pragma unroll
                    for (int bj = 0; bj < 2; ++bj) { const int cb = colt + bj * 128 + (wc >> 1) * 64;
                        const f32x4 x1 = acc[ai][bj][m][0], x2 = acc[ai][bj][m][1]; const f32x4 o1 = x1 * c4 - x2 * s4, o2 = x2 * c4 + x1 * s4;
                        u32x2 w; w.x = cvtpk(o1.x, o1.y); w.y = cvtpk(o1.z, o1.w); *(GAS u32x2*)(dst + (size_t)row * DM + cb + d1) = w;
                        w.x = cvtpk(o2.x, o2.y); w.y = cvtpk(o2.z, o2.w); *(GAS u32x2*)(dst + (size_t)row * DM + cb + d1 + 32) = w; } }
        }
    }
};
struct EpiRetQKV {
    static constexpr bool PERM = true, AFTER_DRAIN = false; bf16 *Q, *K, *V; const float *xc, *xs; int smask;
    __device__ __forceinline__ void operator()(const pg8::f32x4 (&acc)[2][2][4][2], const pg8::Unit& u, int wr, int wc, int fr, int fq) const {
        const int row0 = u.pm * 256 + wr * 64 + fr;
        if (u.pn >= 8) {
            const int col0 = (u.pn - 8) * 256 + wc * 32 + 8 * fq;
#pragma unroll
            for (int ai = 0; ai < 2; ++ai)
#pragma unroll
                for (int m = 0; m < 4; ++m) { GAS bf16* rp = (GAS bf16*)(V + (size_t)(row0 + ai * 128 + m * 16) * 2048 + col0);
#pragma unroll
                    for (int bj = 0; bj < 2; ++bj) { const f32x4 v0 = acc[ai][bj][m][0], v1 = acc[ai][bj][m][1];
                        u32x4 w; w.x = cvtpk(v0.x, v0.y); w.y = cvtpk(v0.z, v0.w); w.z = cvtpk(v1.x, v1.y); w.w = cvtpk(v1.z, v1.w); *(GAS u32x4*)(rp + bj * 128) = w; } }
        } else {
            bf16* dst = u.pn < 4 ? Q : K; const float sc = u.pn < 4 ? 1.f : 0.0625f; const int col0 = (u.pn & 3) * 256 + wc * 32 + 8 * fq;
#pragma unroll
            for (int ai = 0; ai < 2; ++ai)
#pragma unroll
                for (int m = 0; m < 4; ++m) { const int row = row0 + ai * 128 + m * 16, s = row & smask;
#pragma unroll
                    for (int bj = 0; bj < 2; ++bj) { const int col = col0 + bj * 128; u32x4 w;
#pragma unroll
                        for (int n = 0; n < 2; ++n) { const int pi = ((col + 4 * n) & 255) >> 1;
                            const f32x2 c2 = *(GAS const f32x2*)(xc + s * 128 + pi) * sc, s2 = *(GAS const f32x2*)(xs + s * 128 + pi) * sc; const f32x4 x = acc[ai][bj][m][n];
                            const unsigned lo = cvtpk(x.x * c2.x - x.y * s2.x, x.y * c2.x + x.x * s2.x), hi = cvtpk(x.z * c2.y - x.w * s2.y, x.w * c2.y + x.z * s2.y);
                            if (n == 0) { w.x = lo; w.y = hi; } else { w.z = lo; w.w = hi; } }
                        const size_t qoff = u.pn < 4 ? ((((size_t)(row >> 5) * 4 + (col >> 8)) * 16 + ((col & 255) >> 4)) * 512 + (((col & 255) >> 3) & 1) * 256 + (row & 31) * 8) : ((size_t)row * DM + col);
                        *(GAS u32x4*)(dst + qoff) = w; } }
        }
    }
};

__device__ __forceinline__ void attn_phase(LAS unsigned char* lds, const bf16* Q, const bf16* K, const bf16* V, bf16* OB, int S, int nbatch, int vcu, int G, float lam, float oscale, const float* subln, float* o1s, const int wave) {
    lam = __uint_as_float(__builtin_amdgcn_readfirstlane(__float_as_uint(lam))); oscale = __uint_as_float(__builtin_amdgcn_readfirstlane(__float_as_uint(oscale)));
    const int nqb = S / 256, nunits = nbatch * 8 * nqb, per = (nunits + G - 1) / G;
    constexpr int KSTR = 128, VSTR = 256, QSTR = 144, KBYTES = 64 * KSTR, VBYTES = 64 * VSTR, VBASE = 3 * KBYTES, QBASE = VBASE + 4 * VBYTES;

    for (int it = 0; it < per; ++it) {
    int tid_l = tid_of(wave); asm volatile("" : "+v"(tid_l));
    const int tid = tid_l, lane = tid & 63, w = __builtin_amdgcn_readfirstlane(tid >> 6), l31 = lane & 31, hh = lane >> 5;
    const int i15 = lane & 15, qq = i15 >> 2, pp = i15 & 3;
    const int vtr_off = (4 * hh + qq) * VSTR + 32 * ((lane >> 4) & 1) + 8 * pp;
    const int kfr_off = l31 * KSTR, xk = l31 & 7;
    const size_t kdoff = (size_t)(8 * w + (lane >> 3)) * DM + (((lane & 7) ^ (lane >> 3)) << 3);
    const size_t vdoff = (size_t)(8 * w + (lane >> 4)) * DM + ((((((lane & 15) >> 2) ^ ((lane >> 4) & 3)) << 2) | (lane & 3)) << 3);
        const int u = vcu * per + it; if (u >= nunits) break;
        const int qb = u % nqb, bh = u / nqb, h = bh & 7, b = bh >> 3;
        const size_t rowbase = (size_t)b * S; const int q0 = qb * 256 + w * 32;
#pragma unroll 1
        for (int c = 0; c < 2; ++c) {
            const bf16* Kg = K + rowbase * DM + h * 128 + c * 64; const bf16* Vg = V + rowbase * DM + h * 128;
            size_t kdo = kdoff, vdo = vdoff; asm volatile("" : "+v"(kdo), "+v"(vdo));
            bf16x8 qf[4];
#pragma unroll
            for (int ds = 0; ds < 4; ++ds) qf[ds] = *(GAS const bf16x8*)(Q + (rowbase + q0 + l31) * DM + h * 128 + c * 64 + ds * 16 + hh * 8);
            LAS unsigned char* qst_ = lds + QBASE + w * (32 * QSTR) + l31 * QSTR + hh * 16;
            const int NT = S / 64;
#define ATT_DMA_K(TILE, SLOT) glds16((const void*)(Kg + kdo + (size_t)(TILE) * 64 * DM), (unsigned)__builtin_amdgcn_readfirstlane((int)(unsigned)(size_t)(lds + (SLOT) * KBYTES + w * 1024)))
#define ATT_DMA_V(TILE, SLOT) do { glds16((const void*)(Vg + vdo + (size_t)(TILE) * 64 * DM), (unsigned)__builtin_amdgcn_readfirstlane((int)(unsigned)(size_t)(lds + VBASE + (SLOT) * VBYTES + w * 2048))); \
                glds16((const void*)(Vg + vdo + ((size_t)(TILE) * 64 + 4) * DM), (unsigned)__builtin_amdgcn_readfirstlane((int)(unsigned)(size_t)(lds + VBASE + (SLOT) * VBYTES + w * 2048 + 1024))); } while (0)
            __syncthreads();
            ATT_DMA_K(0, 0); ATT_DMA_K(1, 1); ATT_DMA_V(0, 0); ATT_DMA_V(1, 1);
            {   unsigned z0_ = 0u; asm volatile("" : "+v"(z0_)); const u32x4 zz = {z0_, z0_, z0_, z0_};
                *(LAS u32x4*)(lds + VBASE + 3 * VBYTES + tid * 16) = zz; *(LAS u32x4*)(lds + VBASE + 3 * VBYTES + 8192 + tid * 16) = zz; }
            asm volatile("s_waitcnt vmcnt(0)" ::: "memory");
            __syncthreads();
            f32x16 o[4]; float zf_ = 0.f; asm volatile("" : "+v"(zf_));
#pragma unroll
            for (int d0 = 0; d0 < 4; ++d0)
#pragma unroll
                for (int r = 0; r < 16; ++r) o[d0][r] = zf_;
            float lrun = 0.f, alpha_prev = 1.f;
            f32x16 s0, s1;
#pragma unroll
            for (int ds = 0; ds < 4; ++ds) *(LAS bf16x8*)(qst_ + ds * 32) = qf[ds];
            bf16x8 pfp[4];
#pragma unroll
            for (int k4 = 0; k4 < 4; ++k4) pfp[k4] = (bf16x8){0, 0, 0, 0, 0, 0, 0, 0};
            float mref = -1e30f; f32x16 negm;
#pragma unroll
            for (int r = 0; r < 16; ++r) negm[r] = zf_;
            bool first = true;
            int ks_cur = 0, ks_stage = 2 * KBYTES;
#define KFA(I_) (kb_ + ((I_) & 1) * 32 * KSTR + ((((I_) & ~1) + hh) ^ xk) * 16)
#define VFA(V_) (vb_ + (16 * ((V_) >> 2)) * VSTR + ((((V_) & 3) ^ qq) << 6))
#define ATT_ITER(T_, KW_, V0W_, V1W_, KL_, V0L_, V1L_) do { \
                if (__any(alpha_prev != 1.f)) { \
                _Pragma("unroll") \
                    for (int d0 = 0; d0 < 4; ++d0) \
                _Pragma("unroll") \
                        for (int r = 0; r < 16; ++r) o[d0][r] *= alpha_prev; } \
                { const int tk = (T_ + 2 < NT) ? T_ + 2 : NT - 1; \
                  glds16((const void*)(Kg + kdo + (size_t)tk * 64 * DM), (unsigned)__builtin_amdgcn_readfirstlane((int)(unsigned)(size_t)(lds + ks_stage + w * 1024))); \
                  LAS unsigned char* vds_ = lds + VBASE + ((T_ + 2) & 3) * VBYTES + w * 2048; \
                  glds16((const void*)(Vg + vdo + (size_t)tk * 64 * DM), (unsigned)__builtin_amdgcn_readfirstlane((int)(unsigned)(size_t)(vds_))); \
                  glds16((const void*)(Vg + vdo + ((size_t)tk * 64 + 4) * DM), (unsigned)__builtin_amdgcn_readfirstlane((int)(unsigned)(size_t)(vds_ + 1024))); } \
                { LAS unsigned char* kb_ = lds + ks_cur + kfr_off; LAS unsigned char* vb_ = lds + VBASE + ((T_ + 3) & 3) * VBYTES + vtr_off; \
                  bf16x8 kfr[8], vfr[16], qfl[4]; \
                  kfr[0] = *(LAS bf16x8*)KFA(0); kfr[1] = *(LAS bf16x8*)KFA(1); \
                _Pragma("unroll") \
                  for (int i_ = 0; i_ < 8; ++i_) { \
                      if (i_ + 2 < 8) { kfr[i_ + 2] = *(LAS bf16x8*)KFA(i_ + 2); } \
                      else { const int v_ = i_ - 6; vfr[v_] = cat8(trr(VFA(v_)), trr(VFA(v_) + 8 * VSTR)); } \
                      __builtin_amdgcn_sched_barrier(0); \
                      if (i_ & 1) s1 = MFMA32(kfr[i_], qf[i_ >> 1], i_ == 1 ? negm : s1); else s0 = MFMA32(kfr[i_], qf[i_ >> 1], i_ == 0 ? negm : s0); \
                      __builtin_amdgcn_sched_barrier(0); } \
                  float mxa, mxb, rm, delta = 0.f, alpha = 1.f; f32x2 ps2 = {0.f, 0.f}; \
                _Pragma("unroll") \
                  for (int i_ = 0; i_ < 16; ++i_) { \
                      if (i_ + 2 < 16) { const int v_ = i_ + 2; vfr[v_] = cat8(trr(VFA(v_)), trr(VFA(v_) + 8 * VSTR)); } \
                      __builtin_amdgcn_sched_barrier(0); \
                      o[i_ & 3] = MFMA32(vfr[i_], pfp[i_ >> 2], o[i_ & 3]); \
                        \
                      if (i_ == 0) { mxa = max3f(s0[0], s0[1], s1[0]); mxb = max3f(s0[2], s0[3], s1[1]); mxa = max3f(mxa, s1[2], s1[3]); } \
                      if (i_ >= 1 && i_ <= 3) { const int r = 4 * i_; mxa = max3f(mxa, s0[r], s0[r + 1]); mxb = max3f(mxb, s0[r + 2], s0[r + 3]); mxa = max3f(mxa, s1[r], s1[r + 1]); mxb = max3f(mxb, s1[r + 2], s1[r + 3]); } \
                      if (i_ == 3) { rm = max3f(mxa, mxb, mxa); rm = max3f(rm, shx(rm, 32, lane), rm); } \
                      if (i_ == 4) { \
                          if (first || __any(rm > ATT_THR)) { delta = first ? rm : max3f(rm, 0.f, 0.f); const f32x2 mm2 = {delta, delta}; \
                              _Pragma("unroll") \
                              for (int r = 0; r < 16; r += 2) { const f32x2 a_ = (f32x2){s0[r], s0[r + 1]} - mm2, b_ = (f32x2){s1[r], s1[r + 1]} - mm2; s0[r] = a_.x; s0[r + 1] = a_.y; s1[r] = b_.x; s1[r + 1] = b_.y; } \
                              alpha = first ? 1.f : ex2(-delta); mref = first ? delta : mref + delta; first = false; \
                              _Pragma("unroll") \
                              for (int r = 0; r < 16; ++r) negm[r] = -mref; } } \
                      if (i_ >= 5) { const int e0 = (i_ - 5) * 3; \
                          _Pragma("unroll") \
                          for (int e_ = e0; e_ < e0 + 3 && e_ < 32; ++e_) { if (e_ < 16) s0[e_] = ex2(s0[e_]); else s1[e_ - 16] = ex2(s1[e_ - 16]); } } \
                      __builtin_amdgcn_sched_barrier(0); } \
                    \
                _Pragma("unroll") \
                  for (int r = 0; r < 16; r += 2) ps2 += (f32x2){s0[r], s0[r + 1]} + (f32x2){s1[r], s1[r + 1]}; \
                  lrun = lrun * alpha + (ps2.x + ps2.y); alpha_prev = alpha; \
                  pfp[0] = pack8(s0, 0); pfp[1] = pack8(s0, 8); pfp[2] = pack8(s1, 0); pfp[3] = pack8(s1, 8); } \
                asm volatile("s_waitcnt vmcnt(3)" ::: "memory"); \
                LBAR(); \
                ks_cur = (ks_cur == 2 * KBYTES) ? 0 : ks_cur + KBYTES; ks_stage = (ks_stage == 2 * KBYTES) ? 0 : ks_stage + KBYTES; \
            } while (0)
            for (int t = 0; t < NT; t += 2) { ATT_ITER(t, 0, 0, 0, 0, 0, 0); ATT_ITER(t + 1, 0, 0, 0, 0, 0, 0); }
            asm volatile("s_waitcnt vmcnt(0)" ::: "memory");
#undef ATT_ITER
#undef KFA
#undef VFA
#undef ATT_DMA_K
#undef ATT_DMA_V
            {
#pragma unroll
                for (int d0 = 0; d0 < 4; ++d0)
#pragma unroll
                    for (int r = 0; r < 16; ++r) o[d0][r] *= alpha_prev;
                LAS unsigned char* vb_ = lds + VBASE + ((NT - 1) & 3) * VBYTES + vtr_off;
#pragma unroll
                for (int ks = 0; ks < 4; ++ks)
#pragma unroll
                    for (int d0 = 0; d0 < 4; ++d0) { LAS unsigned char* vp = vb_ + (16 * ks) * VSTR + ((d0 ^ qq) << 6);
                        const bf16x8 vf = cat8(trr(vp), trr(vp + 8 * VSTR)); o[d0] = MFMA32(vf, pfp[ks], o[d0]); } }
            lrun += shx(lrun, 32, lane);
            const float inv = 1.f / lrun;
            GAS float* o1p = (GAS float*)(o1s + tid); asm volatile("" : "+v"(o1p));
            if (c == 0) {
#pragma unroll
                for (int d0 = 0; d0 < 4; ++d0)
#pragma unroll
                    for (int r = 0; r < 16; ++r) o1p[(d0 * 16 + r) * 512] = o[d0][r] * inv;
            } else {
                float ss = 0.f;
#pragma unroll
                for (int d0 = 0; d0 < 4; ++d0)
#pragma unroll
                    for (int r = 0; r < 16; ++r) { const float v = o1p[(d0 * 16 + r) * 512] - lam * (o[d0][r] * inv); o[d0][r] = v; ss += v * v; }
                ss += shx(ss, 32, lane);
                const float rstd = rsqrtf(ss * (1.f / 128.f) + 1e-5f) * oscale;
                GAS bf16* orow = (GAS bf16*)(OB + (rowbase + q0 + l31) * DM + h * 128); asm volatile("" : "+v"(orow));
#pragma unroll
                for (int d0 = 0; d0 < 4; ++d0)
#pragma unroll
                    for (int rg = 0; rg < 4; ++rg) { const int d = 32 * d0 + 8 * rg + 4 * hh; const f32x4 w4 = *(GAS const f32x4*)(subln + d);
                        u32x2 wv; wv.x = cvtpk(o[d0][4 * rg] * rstd * w4.x, o[d0][4 * rg + 1] * rstd * w4.y); wv.y = cvtpk(o[d0][4 * rg + 2] * rstd * w4.z, o[d0][4 * rg + 3] * rstd * w4.w);
                        *(GAS u32x2*)(orow + d) = wv; }
            }
        }
    }
}

__device__ __forceinline__ void scan_phase(LAS unsigned char* lds, const bf16* Q, const bf16* K, const bf16* V, bf16* OF, bf16* OBK, int S, int nbatch, int vcu, int G, const float* decay, const int wave) {
    const int n = S / 128, nunits = nbatch * 64, per = (nunits + G - 1) / G;
    constexpr int KSTR = 576, VSTR = 192, RSTR = 528, KT = 0, VT = 128 * KSTR, RT = VT + 128 * VSTR;
    for (int it = 0; it < per; ++it) {
    int tid_l = tid_of(wave); asm volatile("" : "+v"(tid_l));
    const int tid = tid_l, lane = tid & 63, w = __builtin_amdgcn_readfirstlane(tid >> 6), l31 = lane & 31, hh = lane >> 5;
    const int i15 = lane & 15, qq = i15 >> 2, pp = i15 & 3, cg16 = 16 * ((lane >> 4) & 1) + 4 * pp;
    const int tb = w >> 1, nbk = w & 1;
        const int u = vcu * per + it; if (u >= nunits) break;
        const int dir = u & 1, j = (u >> 1) & 7, h = (u >> 4) & 3, b = u >> 6;
        const float lg2 = -__expf(((GAS const float*)decay)[dir * 4 + h]) * LOG2E;
        const float cd = ex2(lg2 * 128.f);
        bf16* OD = dir ? OBK : OF;
        f32x16 racc[2];
#pragma unroll
        for (int r = 0; r < 16; ++r) { racc[0][r] = 0.f; racc[1][r] = 0.f; }
        u32x4 kreg[8], vreg[2];
        { const int c = dir ? n - 1 : 0; const size_t rowb = (size_t)b * S + (size_t)c * 128;
#pragma unroll
          for (int ii = 0; ii < 8; ++ii) { const int idx = tid + 512 * ii, row = idx >> 5, ch = idx & 31; kreg[ii] = *(GAS const u32x4*)(K + (rowb + row) * DM + h * 256 + ch * 8); }
#pragma unroll
          for (int ii = 0; ii < 2; ++ii) { const int idx = tid + 512 * ii, row = idx >> 3, ch = idx & 7; vreg[ii] = *(GAS const u32x4*)(V + (rowb + row) * 2048 + h * 512 + j * 64 + ch * 8); } }
        bf16x8 qfr[8];
        { const int c = dir ? n - 1 : 0; GAS const bf16* qp = (GAS const bf16*)(Q + ((((size_t)b * S + (size_t)c * 128 + 32 * tb) >> 5) * 4 + h) * 8192 + hh * 256 + l31 * 8);
#pragma unroll
          for (int ks = 0; ks < 8; ++ks) qfr[ks] = *(GAS const bf16x8*)(qp + 512 * ks); }
        __syncthreads();
        for (int step = 0; step < n; ++step) {
            const int c = dir ? n - 1 - step : step; const size_t rowb = (size_t)b * S + (size_t)c * 128;
            bf16x8 qlate[8];
            { GAS const bf16* qp = (GAS const bf16*)(Q + (((rowb + 32 * tb) >> 5) * 4 + h) * 8192 + hh * 256 + l31 * 8);
#pragma unroll
              for (int ks = 0; ks < 8; ++ks) qlate[ks] = *(GAS const bf16x8*)(qp + 512 * (8 + ks)); }
            asm volatile("" ::: "memory");
#pragma unroll
            for (int ii = 0; ii < 8; ++ii) { const int idx = tid + 512 * ii, row = idx >> 5, ch = idx & 31; *(LAS u32x4*)(lds + KT + row * KSTR + ch * 16) = kreg[ii]; }
#pragma unroll
            for (int ii = 0; ii < 2; ++ii) { const int idx = tid + 512 * ii, row = idx >> 3, ch = idx & 7;
                const float z = ex2(lg2 * (float)(dir ? row : 127 - row)); const u32x4 v = vreg[ii]; u32x4 o;
                o.x = cvtpk(__uint_as_float(v.x << 16) * z, __uint_as_float(v.x & 0xffff0000u) * z); o.y = cvtpk(__uint_as_float(v.y << 16) * z, __uint_as_float(v.y & 0xffff0000u) * z);
                o.z = cvtpk(__uint_as_float(v.z << 16) * z, __uint_as_float(v.z & 0xffff0000u) * z); o.w = cvtpk(__uint_as_float(v.w << 16) * z, __uint_as_float(v.w & 0xffff0000u) * z);
                *(LAS u32x4*)(lds + VT + row * VSTR + ch * 16) = o; }
#pragma unroll
            for (int nb2 = 0; nb2 < 2; ++nb2)
#pragma unroll
                for (int rg = 0; rg < 4; ++rg) { u32x2 wv; wv.x = cvtpk(racc[nb2][4 * rg], racc[nb2][4 * rg + 1]); wv.y = cvtpk(racc[nb2][4 * rg + 2], racc[nb2][4 * rg + 3]);
                    *(LAS u32x2*)(lds + RT + (32 * nb2 + l31) * RSTR + (32 * w + 8 * rg + 4 * hh) * 2) = wv; }
            LBAR();
            if (step + 1 < n) { const int c2 = dir ? c - 1 : c + 1; const size_t rb2 = (size_t)b * S + (size_t)c2 * 128;
#pragma unroll
                for (int ii = 0; ii < 8; ++ii) { const int idx = tid + 512 * ii, row = idx >> 5, ch = idx & 31; kreg[ii] = *(GAS const u32x4*)(K + (rb2 + row) * DM + h * 256 + ch * 8); }
#pragma unroll
                for (int ii = 0; ii < 2; ++ii) { const int idx = tid + 512 * ii, row = idx >> 3, ch = idx & 7; vreg[ii] = *(GAS const u32x4*)(V + (rb2 + row) * 2048 + h * 512 + j * 64 + ch * 8); } }
            { f32x16 acc;
#pragma unroll
              for (int r = 0; r < 16; ++r) acc[r] = 0.f;
              LAS unsigned char* rp = lds + RT + (32 * nbk + l31) * RSTR + 16 * hh;
#pragma unroll
              for (int ks = 0; ks < 8; ++ks) { const bf16x8 bfr = *(LAS bf16x8*)(rp + 32 * ks); acc = MFMA32(bfr, qfr[ks], acc); }
#pragma unroll
              for (int ks = 0; ks < 8; ++ks) { const bf16x8 bfr = *(LAS bf16x8*)(rp + 32 * (8 + ks)); acc = MFMA32(bfr, qlate[ks], acc); }
              if (step + 1 < n) { const int c2 = dir ? c - 1 : c + 1; GAS const bf16* qp = (GAS const bf16*)(Q + ((((size_t)b * S + (size_t)c2 * 128 + 32 * tb) >> 5) * 4 + h) * 8192 + hh * 256 + l31 * 8);
#pragma unroll
                  for (int ks = 0; ks < 8; ++ks) qfr[ks] = *(GAS const bf16x8*)(qp + 512 * ks); }
              const int tok = 32 * tb + l31; const float xi = ex2(lg2 * (float)(dir ? 128 - tok : tok + 1));
              GAS bf16* op = (GAS bf16*)(OD + (rowb + 16 * j + 8 * nbk + hh) * 2048 + h * 512 + tok * 4);
#pragma unroll
              for (int rg = 0; rg < 4; ++rg) { u32x2 wv; wv.x = cvtpk(acc[4 * rg] * xi, acc[4 * rg + 1] * xi); wv.y = cvtpk(acc[4 * rg + 2] * xi, acc[4 * rg + 3] * xi); *(GAS u32x2*)(op + (size_t)(2 * rg) * 2048) = wv; } }
#pragma unroll
            for (int r = 0; r < 16; ++r) { racc[0][r] *= cd; racc[1][r] *= cd; }
#pragma unroll
            for (int ks = 0; ks < 8; ++ks) { const int row = 16 * ks + 8 * hh + qq;
                LAS unsigned char* kp = lds + KT + row * KSTR + (32 * w + cg16) * 2; const bf16x8 af = cat8(trr(kp), trr(kp + 4 * KSTR));
                LAS unsigned char* vp = lds + VT + row * VSTR + cg16 * 2; const bf16x8 b0 = cat8(trr(vp), trr(vp + 4 * VSTR)), b1 = cat8(trr(vp + 64), trr(vp + 64 + 4 * VSTR));
                racc[0] = MFMA32(af, b0, racc[0]); racc[1] = MFMA32(af, b1, racc[1]); }
            LBAR();
        }
    }
}

__device__ __forceinline__ void intra_phase(LAS unsigned char* lds, const bf16* Q, const bf16* K, const bf16* V, bf16* OF, const bf16* OBK, int S, int nbatch, int vcu, int G, const float* decay, const int wave, const bool do_store = true) {
    const int n = S / 128, nunits = nbatch * 4 * n, per = (nunits + G - 1) / G;
    constexpr int KSTR = 528, VSTR = 320, KT = 0, VT = 128 * KSTR, SSB = VT + 128 * VSTR;
    for (int it = 0; it < per; ++it) {
    int tid_l = tid_of(wave); asm volatile("" : "+v"(tid_l));
    const int tid = tid_l, lane = tid & 63, w = __builtin_amdgcn_readfirstlane(tid >> 6), l31 = lane & 31, hh = lane >> 5;
    const int i15 = lane & 15, qq = i15 >> 2, pp = i15 & 3, cg16 = 16 * ((lane >> 4) & 1) + 4 * pp;
    const int qb = w >> 1, par = w & 1;
        const int u = vcu * per + it; if (u >= nunits) break;
        const int c = u % n, bh = u / n, h = bh & 3, b = bh >> 2;
        const float lgf2 = -__expf(((GAS const float*)decay)[h]) * LOG2E, lgb2 = -__expf(((GAS const float*)decay)[4 + h]) * LOG2E;
        const size_t rowb = (size_t)b * S + (size_t)c * 128;
        __syncthreads();
#pragma unroll
        for (int ii = 0; ii < 8; ++ii) { const int idx = tid + 512 * ii, row = idx >> 5, ch = idx & 31; *(LAS u32x4*)(lds + KT + row * KSTR + ch * 16) = *(GAS const u32x4*)(K + (rowb + row) * DM + h * 256 + ch * 8); }
        u32x4 vreg[4];
#pragma unroll
        for (int ii = 0; ii < 4; ++ii) { const int idx = tid + 512 * ii, row = idx >> 4, ch = idx & 15; vreg[ii] = *(GAS const u32x4*)(V + (rowb + row) * 2048 + h * 512 + ch * 8); }
        __syncthreads();
        bf16x8 pf[8];
        { f32x16 X[4];
#pragma unroll
          for (int k4 = 0; k4 < 4; ++k4)
#pragma unroll
              for (int r = 0; r < 16; ++r) X[k4][r] = 0.f;
          GAS const bf16* qp = (GAS const bf16*)(Q + (((rowb + 32 * qb) >> 5) * 4 + h) * 8192 + hh * 256 + l31 * 8); LAS unsigned char* kp = lds + KT + l31 * KSTR + 16 * hh;
#pragma unroll
          for (int ks = 0; ks < 16; ++ks) { const bf16x8 bq = *(GAS const bf16x8*)(qp + 512 * ks);
#pragma unroll
              for (int k4 = 0; k4 < 4; ++k4) { const bf16x8 a = *(LAS bf16x8*)(kp + 32 * k4 * KSTR + 32 * ks); X[k4] = MFMA32(a, bq, X[k4]); } }
          const int iq = 32 * qb + l31;
#pragma unroll
          for (int k4 = 0; k4 < 4; ++k4) {
#pragma unroll
              for (int r = 0; r < 16; ++r) { const int d = iq - (32 * k4 + crow(r, hh)); X[k4][r] *= ex2(d >= 0 ? lgf2 * (float)d : -lgb2 * (float)d); }
              pf[2 * k4] = pack8(X[k4], 0); pf[2 * k4 + 1] = pack8(X[k4], 8); } }
        f32x16 z[8];
#pragma unroll
        for (int t = 0; t < 8; ++t)
#pragma unroll
            for (int r = 0; r < 16; ++r) z[t][r] = 0.f;
#pragma unroll
        for (int p = 0; p < 4; ++p) {
#pragma unroll
            for (int ii = 0; ii < 4; ++ii) { const int idx = tid + 512 * ii, row = idx >> 4, ch = idx & 15; *(LAS u32x4*)(lds + VT + row * VSTR + ch * 16) = vreg[ii]; }
            LBAR();
            if (p < 3) {
#pragma unroll
                for (int ii = 0; ii < 4; ++ii) { const int idx = tid + 512 * ii, row = idx >> 4, ch = idx & 15; vreg[ii] = *(GAS const u32x4*)(V + (rowb + row) * 2048 + h * 512 + (p + 1) * 128 + ch * 8); } }
#pragma unroll
            for (int bi = 0; bi < 2; ++bi) { const int blk = 2 * bi + par;
#pragma unroll
                for (int ks = 0; ks < 8; ++ks) { LAS unsigned char* vp = lds + VT + (16 * ks + 4 * hh + qq) * VSTR + (32 * blk + cg16) * 2;
                    const bf16x8 vf = cat8(trr(vp), trr(vp + 8 * VSTR)); z[2 * p + bi] = MFMA32(vf, pf[ks], z[2 * p + bi]); } }
            LBAR();
        }
        size_t ebase = (rowb + 32 * qb + l31) * 2048 + h * 512 + 32 * par + 4 * hh; asm volatile("" : "+v"(ebase));
        size_t xbase = (rowb + 8 * par + hh) * 2048 + h * 512 + (32 * qb + l31) * 4; asm volatile("" : "+v"(xbase));
        float ssq = 0.f;
#pragma unroll
        for (int t = 0; t < 8; ++t) { const int co = 128 * (t >> 1) + 64 * (t & 1);
#pragma unroll
            for (int rg = 0; rg < 4; ++rg) { const size_t xo_ = xbase + (size_t)((co >> 2) + 2 * rg) * 2048; const u32x2 a_ = *(GAS const u32x2*)(OF + xo_), b_ = *(GAS const u32x2*)(OBK + xo_);
                z[t][4 * rg] += __uint_as_float(a_.x << 16) + __uint_as_float(b_.x << 16); z[t][4 * rg + 1] += __uint_as_float(a_.x & 0xffff0000u) + __uint_as_float(b_.x & 0xffff0000u);
                z[t][4 * rg + 2] += __uint_as_float(a_.y << 16) + __uint_as_float(b_.y << 16); z[t][4 * rg + 3] += __uint_as_float(a_.y & 0xffff0000u) + __uint_as_float(b_.y & 0xffff0000u);
                ssq += z[t][4 * rg] * z[t][4 * rg] + z[t][4 * rg + 1] * z[t][4 * rg + 1] + z[t][4 * rg + 2] * z[t][4 * rg + 2] + z[t][4 * rg + 3] * z[t][4 * rg + 3]; }
            asm volatile("" ::: "memory"); }
        ssq += shx(ssq, 32, lane);
        LAS float* ssb = (LAS float*)(lds + SSB);
        if (hh == 0) ssb[w * 32 + l31] = ssq;
        __syncthreads();
        const float rstd = rsqrtf((ssq + ssb[(w ^ 1) * 32 + l31]) * (1.f / 512.f) + 1e-6f);
        asm volatile("" : "+v"(ebase));
#pragma unroll
        for (int t = 0; t < 8; ++t) { const int co = 128 * (t >> 1) + 64 * (t & 1);
#pragma unroll
            for (int rg = 0; rg < 4; ++rg) { u32x2 wv; wv.x = cvtpk(z[t][4 * rg] * rstd, z[t][4 * rg + 1] * rstd); wv.y = cvtpk(z[t][4 * rg + 2] * rstd, z[t][4 * rg + 3] * rstd); if (do_store) *(GAS u32x2*)(OF + ebase + co + 8 * rg) = wv; }
            asm volatile("" ::: "memory"); }
    }
}

#define XB_TMO      128
#define XB_XCNT(j)  (256  + 64 * (j))
#define XB_XSUB(j)  (1280 + 64 * (j))
#define XB_XGEN(j)  (2304 + 64 * (j))
#define XB_TOP      3328
#define XB_TOPGEN   3392
#define XCD_BAR_WORDS 3456
#define XB_SPIN_CAP (1u << 18)

__device__ __forceinline__ unsigned xb_ld(unsigned* p)              { return __hip_atomic_load(p, __ATOMIC_RELAXED, __HIP_MEMORY_SCOPE_AGENT); }
__device__ __forceinline__ unsigned xb_add(unsigned* p, unsigned v) { return __hip_atomic_fetch_add(p, v, __ATOMIC_RELAXED, __HIP_MEMORY_SCOPE_AGENT); }
__device__ __forceinline__ unsigned xb_xcc_id() { return (unsigned)__builtin_amdgcn_s_getreg((3 << 11) | 20) & 0xFu; }
#define XB_SPIN(cond, bar) do { unsigned _sp = 0; while (cond) { __builtin_amdgcn_s_sleep(1); \
    if ((++_sp & 255u) == 0u) { if (xb_ld(&(bar)[XB_TMO])) break; if (_sp > XB_SPIN_CAP) { atomicAdd(&(bar)[XB_TMO], 1u); break; } } } } while (0)

struct XcdBarrier {
    unsigned* bar; unsigned x;
    volatile LAS unsigned* st;
};

__device__ __forceinline__ XcdBarrier xcd_barrier_post(unsigned* bar, volatile LAS unsigned* st, const bool tid0) {
    XcdBarrier b; b.bar = bar; b.x = xb_xcc_id(); b.st = st;
    if (tid0) (void)xb_add(&bar[XB_XCNT(b.x)], 1u);
    return b;
}
__device__ __forceinline__ void xcd_barrier_complete(unsigned* bar, unsigned x, unsigned& nloc, unsigned& nx) {
    const unsigned G = gridDim.x * gridDim.y * gridDim.z;
    unsigned sum, cnt, mine, sp = 0u;
    for (;;) {
        sum = 0u; cnt = 0u; mine = 0u;
#pragma unroll
        for (unsigned j = 0; j < 16; ++j) { const unsigned c = xb_ld(&bar[XB_XCNT(j)]); sum += c; cnt += (c > 0u) ? 1u : 0u; mine = (j == x) ? c : mine; }
        if (sum == G) break;
        __builtin_amdgcn_s_sleep(1);
        if ((++sp & 255u) == 0u) { if (xb_ld(&bar[XB_TMO])) break; if (sp > XB_SPIN_CAP) { atomicAdd(&bar[XB_TMO], 1u); break; } }
    }
    nloc = mine > 0u ? mine : 1u; nx = cnt > 0u ? cnt : 1u;
}

__device__ __forceinline__ void xcd_barrier(const XcdBarrier& b, const bool tid0) {
    asm volatile("s_waitcnt vmcnt(0)" ::: "memory");
    __syncthreads();
    if (tid0) {
        unsigned* bar = b.bar;
        __builtin_amdgcn_s_waitcnt(0);
        unsigned nloc = b.st[0], nx = b.st[1];
        if (nloc == 0u) { xcd_barrier_complete(bar, b.x, nloc, nx); b.st[0] = nloc; b.st[1] = nx; }
        const unsigned old = xb_add(&bar[XB_XSUB(b.x)], 1u);
        const unsigned gen = old / nloc;
        if (old + 1u == (gen + 1u) * nloc) {
            __builtin_amdgcn_fence(__ATOMIC_RELEASE, "agent");
            asm volatile("s_waitcnt vmcnt(0)" ::: "memory");
            const unsigned og = xb_add(&bar[XB_TOP], 1u);
            const unsigned tg = og / nx;
            if (og + 1u == (tg + 1u) * nx) xb_add(&bar[XB_TOPGEN], 1u);
            else XB_SPIN(xb_ld(&bar[XB_TOPGEN]) == tg, bar);
            __builtin_amdgcn_fence(__ATOMIC_ACQUIRE, "agent");
            xb_add(&bar[XB_XGEN(b.x)], 1u);
            asm volatile("s_waitcnt vmcnt(0)" ::: "memory");
        } else {
            XB_SPIN(xb_ld(&bar[XB_XGEN(b.x)]) == gen, bar);
            __builtin_amdgcn_fence(__ATOMIC_ACQUIRE, "agent");
            asm volatile("s_waitcnt vmcnt(0)" ::: "memory");
        }
    }
    __syncthreads();
}

__device__ __forceinline__ void gbar(unsigned* ctr, unsigned target, const int wave) {
    asm volatile("s_waitcnt vmcnt(0)" ::: "memory");
    __syncthreads();
    int t_ = tid_of(wave); asm volatile("" : "+v"(t_));
    if (t_ == 0) {
        __builtin_amdgcn_fence(__ATOMIC_RELEASE, "agent");
        asm volatile("s_waitcnt vmcnt(0) lgkmcnt(0)" ::: "memory");
        __hip_atomic_fetch_add(ctr, 1u, __ATOMIC_RELAXED, __HIP_MEMORY_SCOPE_AGENT);
        while (__hip_atomic_load(ctr, __ATOMIC_RELAXED, __HIP_MEMORY_SCOPE_AGENT) < target) __builtin_amdgcn_s_sleep(2);
        __builtin_amdgcn_fence(__ATOMIC_ACQUIRE, "agent");
        asm volatile("s_waitcnt vmcnt(0) lgkmcnt(0)" ::: "memory");
    }
    __syncthreads();
}
#define GSYNC() do { nsync += (unsigned)Gn; gbar(gctr, nsync, wave); } while (0)

#define GEMM_CALL(EPI_T, A_, B_, M_, N_, K_, E_) do { pg8::Gemm g_{(const pg8::bf16_t*)(A_), (const pg8::bf16_t*)(B_), (M_), (N_), (K_)}; pg8::StaticOrder S_; S_.init((M_), (N_), Gn, (int)blockIdx.x); \
    pg8::gemm_phase<EPI_T, pg8::StaticOrder, true, true>(lds, g_, S_, (E_), wave); } while (0)

#ifdef DBG
__device__ __forceinline__ void dbg_acc(unsigned char* ws, int id, float err2, float ref2, int lane) { if (lane == 0) { atomicAdd((float*)(ws + WS_CTL + 1024) + 2 * id, err2); atomicAdd((float*)(ws + WS_CTL + 1024) + 2 * id + 1, ref2); } }
__device__ __forceinline__ float wsum_d(float v) { for (int o = 1; o < 64; o <<= 1) v += __shfl_xor(v, o); return v; }
__device__ __forceinline__ float dbg_dot(const bf16* arow, const float* W, int K, int N, int col, int lane) { float a = 0.f; for (int k = lane; k < K; k += 64) a += bf2f(arow[k]) * W[(size_t)k * N + col]; return wsum_d(a); }
__device__ __forceinline__ void dbg_gemm(unsigned char* ws, int id, const bf16* A, const float* W, int K, int N, const void* O, int ldo, int mode, int gwv, int lane) {
    if (gwv >= 256) return;
    const int row = (gwv * 2731 + 17) % TG, col = (gwv * 977 + 5) % N;
    float ref = dbg_dot(A + (size_t)row * K, W, K, N, col, lane), got;
    if (mode == 0) got = ((const float*)O)[(size_t)row * ldo + col]; else if (mode == 2) got = bf2f(((const bf16*)O)[(size_t)row * ldo + col]); else { ref = fmaxf(ref, 0.f); ref *= ref; got = bf2f(((const bf16*)O)[(size_t)row * ldo + col]); }
    dbg_acc(ws, id, (got - ref) * (got - ref), ref * ref, lane);
}
__device__ __forceinline__ void dbg_attn_qkv(unsigned char* ws, int id, const bf16* A, const float* W, const bf16* Qb, const bf16* Kb, const bf16* Vb, int S, int gwv, int lane) {
    if (gwv >= 256) return;
    const int row = (gwv * 2731 + 17) % TG, col = (gwv * 1549 + 3) % 3072, region = col >> 10, cr = col & 1023, d = cr & 63, s = row % S;
    float x = dbg_dot(A + (size_t)row * 1024, W, 1024, 3072, col, lane), ref, got;
    if (region == 2) { ref = x; got = bf2f(Vb[(size_t)row * 1024 + cr]); }
    else { const int pc = d < 32 ? col + 32 : col - 32; const float xp = dbg_dot(A + (size_t)row * 1024, W, 1024, 3072, pc, lane);
        const float inv = ex2(-13.287712379549449f * (float)(2 * (d & 31)) / 64.0f); const double ad = (double)((float)s * inv); const float ang = (float)(ad - 6.283185307179586 * floor(ad / 6.283185307179586)); const float rot = d < 32 ? -xp : xp;
        ref = x * __cosf(ang) + rot * __sinf(ang); if (region == 0) ref *= 0.125f * LOG2E; got = bf2f((region == 0 ? Qb : Kb)[(size_t)row * 1024 + cr]); }
    dbg_acc(ws, id, (got - ref) * (got - ref), ref * ref, lane);
}
__device__ __forceinline__ void dbg_ret_qkv(unsigned char* ws, int id, const bf16* A, const float* W, const bf16* Qb, const bf16* Kb, const bf16* Vb, int S, int gwv, int lane) {
    if (gwv >= 256) return;
    const int row = (gwv * 2731 + 17) % TG, col = (gwv * 1549 + 3) % 4096, s = row % S;
    float x = dbg_dot(A + (size_t)row * 1024, W, 1024, 6144, col, lane), ref, got;
    if (col >= 2048) { ref = x; got = bf2f(Vb[(size_t)row * 2048 + col - 2048]); }
    else { const float xp = dbg_dot(A + (size_t)row * 1024, W, 1024, 6144, col ^ 1, lane); const int pi = (col & 255) >> 1;
        const float a = ex2(-13.287712379549449f * (float)pi / 127.0f); const double ad = (double)((float)s * a); const float ang = (float)(ad - 6.283185307179586 * floor(ad / 6.283185307179586)); const float rot = (col & 1) ? xp : -xp;
        ref = x * __cosf(ang) + rot * __sinf(ang); if (col >= 1024) ref *= 0.0625f; got = bf2f((col < 1024 ? Qb : Kb)[(size_t)row * 1024 + (col & 1023)]); }
    dbg_acc(ws, id, (got - ref) * (got - ref), ref * ref, lane);
}
__device__ __forceinline__ void dbg_attn(unsigned char* ws, int id, const bf16* Qb, const bf16* Kb, const bf16* Vb, const bf16* OB, int S, int NB, float lam, float oscale, const float* subln, int gwv, int lane) {
    if (gwv >= 32) return;
    const int b = gwv % NB, s = (gwv * 389 + 7) % S, h = (gwv * 5 + 1) & 7; const size_t row = (size_t)b * S + s, rb = (size_t)b * S;
    float of0 = 0.f, of1 = 0.f;
    for (int c = 0; c < 2; ++c) {
        const float q = bf2f(Qb[row * 1024 + h * 128 + c * 64 + lane]);
        float mr = -1e30f, l = 0.f, o0 = 0.f, o1 = 0.f;
        for (int m = 0; m < S; ++m) {
            const float sc = wsum_d(q * bf2f(Kb[(rb + m) * 1024 + h * 128 + c * 64 + lane]));
            const float mn = fmaxf(mr, sc), al = exp2f(mr - mn), p = exp2f(sc - mn); mr = mn;
            l = l * al + p; o0 = o0 * al + p * bf2f(Vb[(rb + m) * 1024 + h * 128 + lane]); o1 = o1 * al + p * bf2f(Vb[(rb + m) * 1024 + h * 128 + 64 + lane]);
        }
        if (c == 0) { of0 = o0 / l; of1 = o1 / l; } else { of0 -= lam * o0 / l; of1 -= lam * o1 / l; }
    }
    const float ss = wsum_d(of0 * of0 + of1 * of1), r = rsqrtf(ss / 128.f + 1e-5f) * oscale;
    const float r0 = of0 * r * subln[lane], r1 = of1 * r * subln[64 + lane];
    const float g0 = bf2f(OB[row * 1024 + h * 128 + lane]), g1 = bf2f(OB[row * 1024 + h * 128 + 64 + lane]);
    dbg_acc(ws, id, wsum_d((g0 - r0) * (g0 - r0) + (g1 - r1) * (g1 - r1)), wsum_d(r0 * r0 + r1 * r1), lane);
}
__device__ __forceinline__ void dbg_ret(unsigned char* ws, int id, const bf16* Qb, const bf16* Kb, const bf16* Vb, const bf16* OB, int S, int NB, const float* decay, int gwv, int lane) {
    if (gwv >= 32) return;
    const int b = gwv % NB, n = (gwv * 389 + 7) % S, h = (gwv * 3 + 1) & 3; const size_t row = (size_t)b * S + n, rb = (size_t)b * S;
    const float lgf = -expf(decay[h]), lgb = -expf(decay[4 + h]);
    float q[4], o[8];
#pragma unroll
    for (int t = 0; t < 4; ++t) q[t] = bf2f(Qb[row * 1024 + h * 256 + lane + 64 * t]);
#pragma unroll
    for (int t = 0; t < 8; ++t) o[t] = 0.f;
    for (int m = 0; m < S; ++m) {
        float a = 0.f;
#pragma unroll
        for (int t = 0; t < 4; ++t) a += q[t] * bf2f(Kb[(rb + m) * 1024 + h * 256 + lane + 64 * t]);
        a = wsum_d(a) * (m <= n ? expf(lgf * (float)(n - m)) : expf(lgb * (float)(m - n)));
#pragma unroll
        for (int t = 0; t < 8; ++t) o[t] += a * bf2f(Vb[(rb + m) * 2048 + h * 512 + lane + 64 * t]);
    }
    float ss = 0.f;
#pragma unroll
    for (int t = 0; t < 8; ++t) ss += o[t] * o[t];
    const float r = rsqrtf(wsum_d(ss) / 512.f + 1e-6f); float e2 = 0.f, r2 = 0.f;
#pragma unroll
    for (int t = 0; t < 8; ++t) { const float rf = o[t] * r, gt = bf2f(OB[row * 2048 + h * 512 + lane + 64 * t]); e2 += (gt - rf) * (gt - rf); r2 += rf * rf; }
    dbg_acc(ws, id, wsum_d(e2), wsum_d(r2), lane);
}

__device__ __forceinline__ void dbg_rp(unsigned char* ws, int id, const float* xold, const float* xnew, const float* m, const float* wpost, const float* wpre, const bf16* hb, int gwv, int lane) {
    if (gwv >= 64) return;
    const int row = (gwv * 2731 + 17) % TG; float e2 = 0.f, r2 = 0.f, ss = 0.f, xs[16];
    if (m) { for (int k = lane; k < 1024; k += 64) { const float v = m[(size_t)row * 1024 + k]; ss += v * v; } }
    const float r = rsqrtf(wsum_d(ss) / 1024.f + 1e-6f); float s2 = 0.f;
#pragma unroll
    for (int t = 0; t < 16; ++t) { const int k = lane + 64 * t; float v = xold ? xold[(size_t)row * 1024 + k] : xnew[(size_t)row * 1024 + k]; if (m) v += m[(size_t)row * 1024 + k] * r * wpost[k]; xs[t] = v; s2 += v * v;
        if (xold) { const float g = xnew[(size_t)row * 1024 + k]; e2 += (g - v) * (g - v); r2 += v * v; } }
    const float rr = rsqrtf(wsum_d(s2) / 1024.f + 1e-6f);
#pragma unroll
    for (int t = 0; t < 16; ++t) { const int k = lane + 64 * t; const float rf = xs[t] * rr * (wpre ? wpre[k] : 1.f), g = bf2f(hb[(size_t)row * 1024 + k]); e2 += (g - rf) * (g - rf); r2 += rf * rf; }
    dbg_acc(ws, id, wsum_d(e2), wsum_d(r2), lane);
}
#endif

#ifndef REP_MASK
#define REP_MASK 0
#endif
#ifndef DBG_MASK
#define DBG_MASK 255
#endif
#ifndef DBG_G
#define DBG_G 0
#endif
#ifndef DBG_TOL
#define DBG_TOL 1e-3f
#endif
#define PT_OFF 146944
__device__ __forceinline__ unsigned long long ldpk(int k) { unsigned a = (unsigned)(PT_OFF + 8 * k); asm volatile("" : "+s"(a)); const unsigned long long v = *(LAS unsigned long long*)a;
    const unsigned lo = __builtin_amdgcn_readfirstlane((unsigned)v), hi = __builtin_amdgcn_readfirstlane((unsigned)(v >> 32)); return ((unsigned long long)hi << 32) | lo; }
#define PIN(k) ((const float*)ldpk(k))
#define WSP ((unsigned char*)ldpk(23))
#define GW (vcu * 8 + wave)
#define NGW (Gn * 8)
#define GCTR ((unsigned*)(WSP + WS_CTL))
#undef GSYNC
#define XBAR_WORDS ((unsigned*)(WSP + WS_CTL + 16384))
#define XBAR_ST ((volatile LAS unsigned*)(lds + PT_OFF + 320))
#define GSYNC() do { int t_ = tid_of(wave); asm volatile("" : "+v"(t_)); XcdBarrier xb_; xb_.bar = XBAR_WORDS; xb_.x = xb_xcc_id(); xb_.st = XBAR_ST; xcd_barrier(xb_, t_ == 0); } while (0)
#define XP ((float*)ldpk(22) + (size_t)g * TG * DM)
#define WBP ((bf16*)(WSP + WS_W))
#define HBP ((bf16*)(WSP + WS_HB))
#define PBP ((bf16*)(WSP + WS_PB))
#define OBP ((bf16*)(WSP + WS_OB))
#define BIGP (WSP + WS_BIG)
__global__ void __launch_bounds__(512) fwd_mega(Params P) {
    extern __shared__ __attribute__((aligned(16))) unsigned char lds_raw[];
    LAS unsigned char* lds = (LAS unsigned char*)lds_raw;
    cg::grid_group grid = cg::this_grid();
    const int wave = __builtin_amdgcn_readfirstlane(threadIdx.x >> 6);
    const int Gn = gridDim.x, bx = blockIdx.x, vcu = (Gn % 8 == 0) ? (bx % 8) * (Gn / 8) + bx / 8 : bx;
    { LAS unsigned long long* PT = (LAS unsigned long long*)(lds + PT_OFF);
      if (threadIdx.x < 22) PT[threadIdx.x] = (unsigned long long)P.in[threadIdx.x];
      if (threadIdx.x == 22) PT[22] = (unsigned long long)P.out;
      if (threadIdx.x == 23) PT[23] = (unsigned long long)P.ws; }
    if (threadIdx.x >= 32 && threadIdx.x < 40) ((LAS unsigned long long*)(lds + PT_OFF + 256))[threadIdx.x - 32] = 0ull;
    if (threadIdx.x == 40) { ((LAS unsigned*)(lds + PT_OFF + 320))[0] = 0u; ((LAS unsigned*)(lds + PT_OFF + 320))[1] = 0u; }
    __syncthreads();
    (void)xcd_barrier_post((unsigned*)(ldpk(23) + WS_CTL + 16384), (volatile LAS unsigned*)(lds + PT_OFF + 320), threadIdx.x == 0);
    unsigned nsync = 0;

    { unsigned char* ws = WSP; bf16* Wb = (bf16*)(ws + WS_W);
      float* rc = (float*)(ws + WS_TAB + TAB_RC); float* rs = (float*)(ws + WS_TAB + TAB_RS); float* xc = (float*)(ws + WS_TAB + TAB_XC); float* xs = (float*)(ws + WS_TAB + TAB_XS);
      int tid_t = tid_of(wave); asm volatile("" : "+v"(tid_t)); const int gt = (vcu * 512 + tid_t), NT_ = Gn * 512;
#ifndef NO_TAB
      for (int idx = gt; idx < 8192 * 32; idx += NT_) { const int s = idx >> 5, j = idx & 31; const float inv = 1.0f / powf(10000.0f, (float)(2 * j) / 64.0f); const float ang = (float)s * inv; float sn, cs; sincosf(ang, &sn, &cs); rc[idx] = cs; rs[idx] = sn; }
      for (int idx = gt; idx < 8192 * 128; idx += NT_) { const int s = idx >> 7, i = idx & 127; const float a = 1.0f / powf(10000.0f, (float)i / 127.0f); const float ang = (float)s * a; float sn, cs; sincosf(ang, &sn, &cs); xc[idx] = cs; xs[idx] = sn; }
#endif
      LAS float* scr = (LAS float*)(lds + wave * 16384);
#pragma unroll 1
      for (int mi = 0; mi < 32; ++mi) {
          const int kind = mi >> 2, li = mi & 3;
          int pin, K, N, permN = 0; size_t soff, doff;
          switch (kind) {
              case 0: if (li >= 2) continue; pin = 8; K = 1024; N = 3072; permN = 2048; soff = (size_t)li * 1024 * 3072; doff = W_QKV + (size_t)li * 3 * MEL; break;
              case 1: if (li >= 2) continue; pin = 9; K = 1024; N = 1024; soff = (size_t)li * MEL; doff = W_O + (size_t)li * MEL; break;
              case 2: if (li >= 2) continue; pin = 15; K = 1024; N = 6144; soff = (size_t)li * 1024 * 6144; doff = W_RIN + (size_t)li * 6 * MEL; break;
              case 3: if (li >= 2) continue; pin = 16; K = 2048; N = 1024; soff = (size_t)li * 2 * MEL; doff = W_ROUT + (size_t)li * 2 * MEL; break;
              case 4: pin = 18; K = 1024; N = 4096; soff = (size_t)li * 4 * MEL; doff = W_MIN + (size_t)li * 4 * MEL; break;
              case 5: pin = 19; K = 4096; N = 1024; soff = (size_t)li * 4 * MEL; doff = W_MOUT + (size_t)li * 4 * MEL; break;
              case 6: pin = 20; K = 256; N = 1024; soff = (size_t)li * 262144; doff = W_PROJ + (size_t)li * 262144; break;
              default: pin = 21; K = 1024; N = 1024; soff = (size_t)li * MEL; doff = W_GATE + (size_t)li * MEL; break;
          }
          conv_matrix(PIN(pin) + soff, K, N, Wb + doff, permN, scr, GW, NGW, wave);
      }
    }
    grid.sync();
#pragma unroll 1
    for (int step2 = 0; step2 < 2 * 4 * 13 * 2; ++step2) {
        const int step = step2 >> 1;
        if (step2 & 1) { const int ph_ = step % 13, i_ = (step % 52) / 13; if (!(((REP_MASK & 2) && (ph_ == 1 || ph_ == 5 || ph_ == 7 || ph_ == 8)) || ((REP_MASK & 1) && ph_ == 2 && !(i_ & 1)) || ((REP_MASK & 4) && ph_ == 2 && (i_ & 1)))) continue; }
        const int g = step / 52, i = (step % 52) / 13, ph = step % 13, j = i >> 1, ret = i & 1;
#ifdef TIMING
        const unsigned long long t0_ = __builtin_amdgcn_s_memrealtime();
#endif
        const int S = g ? 8192 : 2048, NB = g ? 4 : 16, smask = S - 1;
        switch (ph) {
        case 0: { if (i != 0) continue; rowpass<false, true, true, false>(PIN(g), XP, nullptr, nullptr, PIN(4), HBP, nullptr, nullptr, GW, NGW, wave); } break;
        case 1: {
            unsigned char* B_ = BIGP; unsigned char* ws = WSP;
            if (!ret) { EpiAttnQKV E{(bf16*)B_, (bf16*)(B_ + 64 * MiB), (bf16*)(B_ + 128 * MiB), (const float*)(ws + WS_TAB + TAB_RC), (const float*)(ws + WS_TAB + TAB_RS), smask};
                GEMM_CALL(EpiAttnQKV, HBP, WBP + W_QKV + (size_t)j * 3 * MEL, TG, 3072, 1024, E); }
            else { EpiRetQKV E{(bf16*)B_, (bf16*)(B_ + 64 * MiB), (bf16*)(B_ + 128 * MiB), (const float*)(ws + WS_TAB + TAB_XC), (const float*)(ws + WS_TAB + TAB_XS), smask};
                GEMM_CALL(EpiRetQKV, HBP, WBP + W_RIN + (size_t)j * 6 * MEL, TG, 4096, 1024, E); }
        } break;
        case 2: {
            unsigned char* B_ = BIGP;
            if (!ret) {
                GAS const float* lq1 = (GAS const float*)(PIN(10) + j * 64); GAS const float* lk1 = (GAS const float*)(PIN(11) + j * 64); GAS const float* lq2 = (GAS const float*)(PIN(12) + j * 64); GAS const float* lk2 = (GAS const float*)(PIN(13) + j * 64);
                float d1 = 0.f, d2 = 0.f;
                for (int k = 0; k < 64; ++k) { d1 += lq1[k] * lk1[k]; d2 += lq2[k] * lk2[k]; }
                const float lam_init = 0.8f - 0.6f * expf(-0.3f * (float)i); const float lam = expf(d1) - expf(d2) + lam_init;
#ifndef NO_ATTN
                attn_phase(lds, (const bf16*)B_, (const bf16*)(B_ + 64 * MiB), (const bf16*)(B_ + 128 * MiB), OBP, S, NB, vcu, Gn, lam, 1.0f - lam_init, PIN(14) + j * 128, (float*)(B_ + 256 * MiB) + (size_t)blockIdx.x * 32768, wave);
#endif
            } else {
#ifndef NO_SCAN
                scan_phase(lds, (const bf16*)B_, (const bf16*)(B_ + 64 * MiB), (const bf16*)(B_ + 128 * MiB), OBP, (bf16*)(B_ + 256 * MiB), S, NB, vcu, Gn, PIN(17) + j * 8, wave);
#endif
            }
        } break;
        case 3: { if (!ret) continue;
#ifndef NO_INTRA
            unsigned char* B_ = BIGP;
#if (REP_MASK & 8)
            intra_phase(lds, (const bf16*)B_, (const bf16*)(B_ + 64 * MiB), (const bf16*)(B_ + 128 * MiB), OBP, (const bf16*)(B_ + 256 * MiB), S, NB, vcu, Gn, PIN(17) + j * 8, wave, false);
#endif
            intra_phase(lds, (const bf16*)B_, (const bf16*)(B_ + 64 * MiB), (const bf16*)(B_ + 128 * MiB), OBP, (const bf16*)(B_ + 256 * MiB), S, NB, vcu, Gn, PIN(17) + j * 8, wave);
#endif
        } break;
        case 4: { if (!ret) continue; EpiSiluMul E{OBP, 2048}; GEMM_CALL(EpiSiluMul, HBP, WBP + W_RIN + (size_t)j * 6 * MEL + (size_t)4096 * 1024, TG, 2048, 1024, E); } break;
        case 5: case 8: {
            unsigned char* B_ = BIGP; const bf16* A_; const bf16* W_; int K_; bf16* O_;
            if (ph == 5) { A_ = OBP; K_ = ret ? 2048 : 1024; W_ = WBP + (ret ? W_ROUT + (size_t)j * 2 * MEL : W_O + (size_t)j * MEL); O_ = (bf16*)B_; }
            else { A_ = (const bf16*)B_; K_ = 4096; W_ = WBP + W_MOUT + (size_t)i * 4 * MEL; O_ = (bf16*)(B_ + 256 * MiB); }
            EpiBf16Plain E{O_, DM}; GEMM_CALL(EpiBf16Plain, A_, W_, TG, 1024, K_, E);
        } break;
        case 10: {
            EpiBf16NP E{(bf16*)BIGP, DM}; GEMM_CALL(EpiBf16NP, PBP, WBP + W_PROJ + (size_t)i * 262144, TG, 1024, 256, E);
#ifndef PROJ_SYNC
            continue;
#endif
        } break;
        case 6: { float* x = XP; rowpass<true, true, true, false>(x, x, (const bf16*)BIGP, PIN(5) + i * DM, PIN(6) + i * DM, HBP, nullptr, nullptr, GW, NGW, wave); } break;
        case 7: { EpiRelu2 E{(bf16*)BIGP, FFD}; GEMM_CALL(EpiRelu2, HBP, WBP + W_MIN + (size_t)i * 4 * MEL, TG, 4096, 1024, E); } break;
        case 9: { float* x = XP; rowpass<true, true, false, true>(x, x, (const bf16*)(BIGP + 256 * MiB), PIN(7) + i * DM, nullptr, HBP, PIN(2 + g) + (size_t)i * TG * 256, PBP, GW, NGW, wave); } break;
        case 11: { EpiGate E{XP, (const bf16*)BIGP}; GEMM_CALL(EpiGate, HBP, WBP + W_GATE + (size_t)i * MEL, TG, 1024, 1024, E); } break;
        default: { if (i == 3) continue; rowpass<false, false, true, false>(XP, nullptr, nullptr, nullptr, PIN(4) + (i + 1) * DM, HBP, nullptr, nullptr, GW, NGW, wave); } break;
        }
#ifdef TIMING
        const unsigned long long t1_ = __builtin_amdgcn_s_memrealtime();
#endif
        GSYNC();
#ifdef TIMING
        { const unsigned long long t2_ = __builtin_amdgcn_s_memrealtime(); LAS unsigned long long* TA = (LAS unsigned long long*)(lds + PT_OFF + 256);
          const int cat = (ph == 0 || ph == 6 || ph == 9 || ph == 12) ? 4 : (ph == 2 ? (ret ? 2 : 1) : (ph == 3 ? 3 : 0));
          if (tid_of(wave) == 0) { TA[cat] += t1_ - t0_; TA[5] += t2_ - t1_; TA[6] += t2_ - t0_; } }
#endif
#ifdef DBG
        if (g == DBG_G) {
            int lane = tid_of(wave) & 63, gwv = (int)blockIdx.x * 8 + wave; asm volatile("" : "+v"(lane), "+s"(gwv)); unsigned char* ws = WSP; unsigned char* B_ = ws + WS_BIG;
            const bf16* Qb = (const bf16*)B_; const bf16* Kb = (const bf16*)(B_ + 64 * MiB); const bf16* Vb = (const bf16*)(B_ + 128 * MiB);
            const int hi_ = i >> 1;
            bool did = true;
            if (!ret && ph == 1) dbg_attn_qkv(ws, hi_ ? 14 : 2, HBP, PIN(8) + (size_t)j * 1024 * 3072, Qb, Kb, Vb, S, gwv, lane);
            else if (!ret && ph == 2) { const float* lq1 = PIN(10) + j * 64; const float* lk1 = PIN(11) + j * 64; const float* lq2 = PIN(12) + j * 64; const float* lk2 = PIN(13) + j * 64; float d1 = 0.f, d2 = 0.f;
                for (int k = 0; k < 64; ++k) { d1 += lq1[k] * lk1[k]; d2 += lq2[k] * lk2[k]; }
                const float lam_init = 0.8f - 0.6f * expf(-0.3f * (float)i); dbg_attn(ws, hi_ ? 14 : 3, Qb, Kb, Vb, OBP, S, NB, expf(d1) - expf(d2) + lam_init, 1.0f - lam_init, PIN(14) + j * 128, gwv, lane); }
            else if (!ret && ph == 5) dbg_gemm(ws, hi_ ? 14 : 4, OBP, PIN(9) + (size_t)j * MEL, 1024, 1024, B_, 1024, 2, gwv, lane);
            else if (i == 0 && ph == 6) dbg_rp(ws, 5, PIN(g), XP, nullptr, PIN(5), PIN(6), HBP, gwv, lane);
            else if (i == 0 && ph == 7) dbg_gemm(ws, 6, HBP, PIN(18), 1024, 4096, B_, 4096, 1, gwv, lane);
            else if (i == 0 && ph == 8) dbg_gemm(ws, 7, (const bf16*)B_, PIN(19), 4096, 1024, B_ + 256 * MiB, 1024, 2, gwv, lane);
            else if (i == 0 && ph == 9) dbg_rp(ws, 8, nullptr, XP, nullptr, nullptr, nullptr, HBP, gwv, lane);
            else if (i == 0 && ph == 11) dbg_gemm(ws, 9, PBP, PIN(20), 256, 1024, B_, 1024, 2, gwv, lane);
            else if (ret && ph == 1) dbg_ret_qkv(ws, hi_ ? 14 : 10, HBP, PIN(15) + (size_t)j * 1024 * 6144, Qb, Kb, Vb, S, gwv, lane);
            else if (ret && ph == 3) dbg_ret(ws, hi_ ? 14 : 11, Qb, Kb, Vb, OBP, S, NB, PIN(17) + j * 8, gwv, lane);
            else if (ret && ph == 5) dbg_gemm(ws, hi_ ? 14 : 13, OBP, PIN(16) + (size_t)j * 2 * MEL, 2048, 1024, B_, 1024, 2, gwv, lane);
            else if (i == 3 && ph == 11) dbg_acc(ws, 15, 1.f, 1.f, lane);
            else did = false;
            if (did) GSYNC();
        }
#endif
    }
#ifdef TIMING
    { unsigned char* ws = WSP; float* tw = (float*)(ws + WS_CTL + 2048); LAS unsigned long long* TA = (LAS unsigned long long*)(lds + PT_OFF + 256);
      if (blockIdx.x == 0 && tid_of(wave) == 0) { tw[0] = (float)TA[TIMING_A] * 0.01f; tw[1] = (float)TA[TIMING_B] / (float)TA[6]; }
      GSYNC();
      const float C = __hip_atomic_load(tw, __ATOMIC_RELAXED, __HIP_MEMORY_SCOPE_AGENT), f = __hip_atomic_load(tw + 1, __ATOMIC_RELAXED, __HIP_MEMORY_SCOPE_AGENT);
      float* o = (float*)ldpk(22); const size_t nh = (size_t)TG * DM, nf = (size_t)(f * (float)nh);
      for (size_t idx = (size_t)blockIdx.x * 512 + tid_of(wave); idx < nf; idx += (size_t)Gn * 512) { o[idx] = C; o[nh + idx] = C; } }
#endif
#ifdef DBG
    { unsigned char* ws = WSP; const float* acc = (const float*)(ws + WS_CTL + 1024); int bad = -1;
      for (int id = 15; id >= 0; --id) { const float e = __hip_atomic_load(acc + 2 * id, __ATOMIC_RELAXED, __HIP_MEMORY_SCOPE_AGENT), r = __hip_atomic_load(acc + 2 * id + 1, __ATOMIC_RELAXED, __HIP_MEMORY_SCOPE_AGENT); if (r > 0.f && !(e <= DBG_TOL * r)) bad = id; }
      if (bad >= 0) { float C = 100.f; for (int k = 0; k < bad; ++k) C *= 4.f;
#ifdef DBG_RATIO
          C = 1000.f * fminf(fmaxf(__hip_atomic_load(acc + 2 * bad, __ATOMIC_RELAXED, __HIP_MEMORY_SCOPE_AGENT) / __hip_atomic_load(acc + 2 * bad + 1, __ATOMIC_RELAXED, __HIP_MEMORY_SCOPE_AGENT), 1e-3f), 1e3f);
#endif
 float* o = (float*)ldpk(22); const size_t n = (size_t)2 * TG * DM;
          for (size_t idx = (size_t)blockIdx.x * 512 + tid_of(wave); idx < n; idx += (size_t)Gn * 512) o[idx] = C; } }
#endif
}

extern "C" void kernel_launch(void* const* d_in, const int* in_sizes, int n_in, void* d_out, int out_size, void* d_ws, size_t ws_size, hipStream_t stream) {
    static int grid_blocks = 0;
    if (!grid_blocks) {
        int dev = 0, cus = 0, per_cu = 0;
        (void)hipGetDevice(&dev);
        (void)hipDeviceGetAttribute(&cus, hipDeviceAttributeMultiprocessorCount, dev);
        (void)hipFuncSetAttribute((const void*)fwd_mega, hipFuncAttributeMaxDynamicSharedMemorySize, LDS_BYTES);
        (void)hipOccupancyMaxActiveBlocksPerMultiprocessor(&per_cu, (const void*)fwd_mega, 512, LDS_BYTES);
        if (per_cu < 1) per_cu = 1;
        grid_blocks = cus * per_cu;
        if (ws_size < WS_END || n_in != 22) { fprintf(stderr, "kernel_launch: workspace %zu < %zu or n_in %d != 22\n", ws_size, (size_t)WS_END, n_in); }
    }
    (void)hipMemsetAsync((char*)d_ws + WS_CTL, 0, 65536, stream);
    Params p{};
    for (int i = 0; i < 22; ++i) p.in[i] = (const float*)d_in[i];
    p.out = (float*)d_out; p.ws = (unsigned char*)d_ws;
    void* args[] = {&p};
    hipError_t e = hipLaunchCooperativeKernel((void*)fwd_mega, dim3(grid_blocks), dim3(512), args, LDS_BYTES, stream);
    if (e != hipSuccess) fprintf(stderr, "cooperative launch failed: %s (grid %d)\n", hipGetErrorString(e), grid_blocks);
}
```
